# Optimizing an MI355X kernel written in HIP

```python
import math
import jax, jax.numpy as jnp
from jax import lax
import numpy as np

D_MODEL = 1024
BATCH = 2
SEQ = 16384
DEPTH = 2

EPS = 1e-6
D_MIX = D_MODEL
CONV_WIDTH = 4
MLA_HEADS = 4
MLA_Q_RANK = 256
MLA_KV_RANK = 128
MLA_NOPE = 64
MLA_ROPE = 32
MLA_V = 64
ROPE_THETA = 10000.0
Q_BLOCK = 128
MLA_IN = MLA_Q_RANK + MLA_KV_RANK + MLA_ROPE
MLA_OUT = MLA_HEADS * MLA_V
SSD_HEADS = 8
SSD_HEAD_DIM = 64
SSD_GROUPS = 2
SSD_STATE = 64
SSD_CHUNK = 128
SSD_D_INNER = SSD_HEADS * SSD_HEAD_DIM
SSD_CONV_DIM = SSD_D_INNER + 2 * SSD_GROUPS * SSD_STATE
SSD_IN = SSD_D_INNER + SSD_CONV_DIM + SSD_HEADS
GDN_HEADS = 4
GDN_DK = 64
GDN_DV = 64
GDN_CHUNK = 64
GDN_QKV = GDN_HEADS * (2 * GDN_DK + GDN_DV)
GDN_IN = GDN_QKV + GDN_HEADS * GDN_DV + 2 * GDN_HEADS
GDN_OUT = GDN_HEADS * GDN_DV
D_IN = MLA_IN + SSD_IN + GDN_IN
D_FF_DENSE = 2816
N_EXPERTS = 8
TOP_K = 2
D_FF_EXPERT = 3584
MOE_BLOCK = 512
N_DENSE = (DEPTH + 1) // 2
N_MOE = DEPTH // 2

kernel_name = "hybrid_mla_ssd_gdn_moe_block"


def rms_norm(x):
    xf = x.astype(jnp.float32)
    return (xf * lax.rsqrt(jnp.mean(xf * xf, -1, keepdims=True) + EPS)).astype(x.dtype)


def l2_norm(x):
    xf = x.astype(jnp.float32)
    return xf * lax.rsqrt(jnp.sum(xf * xf, -1, keepdims=True) + EPS)


def causal_dwconv(x, w, b):
    y = lax.conv_general_dilated(x, w[:, None, :].astype(x.dtype), window_strides=(1,),
                                 padding=[(CONV_WIDTH - 1, 0)],
                                 dimension_numbers=('NWC', 'WIO', 'NWC'),
                                 feature_group_count=x.shape[-1])
    return y + b


def apply_rope(t, cos, sin):
    t1, t2 = jnp.split(t, 2, axis=-1)
    return jnp.concatenate([t1 * cos - t2 * sin, t2 * cos + t1 * sin], -1).astype(t.dtype)


def segsum(a):
    T = a.shape[-1]
    xs = jnp.where(jnp.tril(jnp.ones((T, T), bool), -1), a[..., :, None], 0.0)
    xs = jnp.cumsum(xs, axis=-2)
    return jnp.where(jnp.tril(jnp.ones((T, T), bool)), xs, -jnp.inf)


def mla_mixer(u, q_norm, w_uq, kv_norm, w_ukv):
    Bsz, S, _ = u.shape
    H = MLA_HEADS
    c_q, c_kv, k_rope = jnp.split(u, [MLA_Q_RANK, MLA_Q_RANK + MLA_KV_RANK], axis=-1)
    q = ((rms_norm(c_q) * q_norm) @ w_uq).reshape(Bsz, S, H, MLA_NOPE + MLA_ROPE)
    q_nope, q_rope = q[..., :MLA_NOPE], q[..., MLA_NOPE:]
    kv = ((rms_norm(c_kv) * kv_norm) @ w_ukv).reshape(Bsz, S, H, MLA_NOPE + MLA_V)
    k_nope, v = kv[..., :MLA_NOPE], kv[..., MLA_NOPE:]
    pos = jnp.arange(S, dtype=jnp.float32)
    inv_freq = ROPE_THETA ** (-jnp.arange(0, MLA_ROPE, 2, dtype=jnp.float32) / MLA_ROPE)
    ang = pos[:, None] * inv_freq[None, :]
    cos, sin = jnp.cos(ang), jnp.sin(ang)
    q_rope = apply_rope(q_rope, cos[None, :, None, :], sin[None, :, None, :])
    k_rope = apply_rope(k_rope, cos[None], sin[None])
    scale = (MLA_NOPE + MLA_ROPE) ** -0.5
    nb = S // Q_BLOCK
    qn_b = jnp.moveaxis(q_nope.reshape(Bsz, nb, Q_BLOCK, H, MLA_NOPE), 1, 0)
    qr_b = jnp.moveaxis(q_rope.reshape(Bsz, nb, Q_BLOCK, H, MLA_ROPE), 1, 0)
    kpos = jnp.arange(S)

    def block(args):
        qn, qr, i = args
        s = (jnp.einsum('bqhd,bkhd->bhqk', qn, k_nope)
             + jnp.einsum('bqhr,bkr->bhqk', qr, k_rope)).astype(jnp.float32) * scale
        qpos = i * Q_BLOCK + jnp.arange(Q_BLOCK)
        s = jnp.where(kpos[None, :] <= qpos[:, None], s, -jnp.inf)
        p = jax.nn.softmax(s, axis=-1).astype(v.dtype)
        return jnp.einsum('bhqk,bkhd->bqhd', p, v)

    o = lax.map(block, (qn_b, qr_b, jnp.arange(nb)))
    return jnp.moveaxis(o, 0, 1).reshape(Bsz, S, MLA_OUT).astype(u.dtype)


def ssd_mixer(u, conv_w, conv_b, dt_bias, a_log, d_skip, norm_w):
    Bsz, S, _ = u.shape
    H, P, G, N, L = SSD_HEADS, SSD_HEAD_DIM, SSD_GROUPS, SSD_STATE, SSD_CHUNK
    nc = S // L
    z, xbc, dt = jnp.split(u, [SSD_D_INNER, SSD_D_INNER + SSD_CONV_DIM], axis=-1)
    xbc = jax.nn.silu(causal_dwconv(xbc, conv_w, conv_b)).astype(jnp.float32)
    x, Bm, Cm = jnp.split(xbc, [SSD_D_INNER, SSD_D_INNER + G * N], axis=-1)
    x = x.reshape(Bsz, S, H, P)
    Bm = jnp.repeat(Bm.reshape(Bsz, S, G, N), H // G, axis=2)
    Cm = jnp.repeat(Cm.reshape(Bsz, S, G, N), H // G, axis=2)
    dt = jax.nn.softplus(dt.astype(jnp.float32) + dt_bias.astype(jnp.float32))
    A = -jnp.exp(a_log.astype(jnp.float32))
    xc = (x * dt[..., None]).reshape(Bsz, nc, L, H, P)
    Bc = Bm.reshape(Bsz, nc, L, H, N)
    Cc = Cm.reshape(Bsz, nc, L, H, N)
    a = (dt * A).reshape(Bsz, nc, L, H).transpose(0, 3, 1, 2)
    a_cum = jnp.cumsum(a, axis=-1)
    scores = jnp.einsum('bclhn,bcshn->bhcls', Cc, Bc) * jnp.exp(segsum(a))
    y_diag = jnp.einsum('bhcls,bcshp->bclhp', scores, xc)
    decay_states = jnp.exp(a_cum[..., -1:] - a_cum)
    states = jnp.einsum('bclhn,bhcl,bclhp->bchpn', Bc, decay_states, xc)
    chunk_decay = jnp.exp(a_cum[..., -1])

    def step(hstate, inp):
        st, dec = inp
        return hstate * dec[..., None, None] + st, hstate

    _, prev = lax.scan(step, jnp.zeros((Bsz, H, P, N), jnp.float32),
                       (jnp.moveaxis(states, 1, 0), jnp.moveaxis(chunk_decay, 2, 0)))
    prev = jnp.moveaxis(prev, 0, 1)
    y_off = jnp.einsum('bclhn,bchpn,bhcl->bclhp', Cc, prev, jnp.exp(a_cum))
    y = (y_diag + y_off).reshape(Bsz, S, H, P) + x * d_skip.astype(jnp.float32)[:, None]
    y = y.reshape(Bsz, S, SSD_D_INNER) * jax.nn.silu(z.astype(jnp.float32))
    y = rms_norm(y.reshape(Bsz, S, G, SSD_D_INNER // G)).reshape(Bsz, S, SSD_D_INNER)
    return (y * norm_w).astype(u.dtype)


def gdn_mixer(u, conv_w, conv_b, dt_bias, a_log, norm_w):
    Bsz, S, _ = u.shape
    H, K, V, L = GDN_HEADS, GDN_DK, GDN_DV, GDN_CHUNK
    nc = S // L
    qkv, z, b, a = jnp.split(u, [GDN_QKV, GDN_QKV + H * V, GDN_QKV + H * V + H], axis=-1)
    qkv = jax.nn.silu(causal_dwconv(qkv, conv_w, conv_b))
    q, k, v = jnp.split(qkv, [H * K, 2 * H * K], axis=-1)
    q = l2_norm(q.reshape(Bsz, S, H, K)) * (K ** -0.5)
    k = l2_norm(k.reshape(Bsz, S, H, K))
    v = v.reshape(Bsz, S, H, V).astype(jnp.float32)
    beta = jax.nn.sigmoid(b.astype(jnp.float32))
    g = -jnp.exp(a_log.astype(jnp.float32)) * jax.nn.softplus(
        a.astype(jnp.float32) + dt_bias.astype(jnp.float32))

    def chunks(t):
        return t.reshape(Bsz, nc, L, H, -1).transpose(0, 3, 1, 2, 4)

    qc, kc, vc = chunks(q), chunks(k), chunks(v)
    bc = beta.reshape(Bsz, nc, L, H).transpose(0, 3, 1, 2)
    gc = jnp.cumsum(g.reshape(Bsz, nc, L, H).transpose(0, 3, 1, 2), axis=-1)
    tril = jnp.tril(jnp.ones((L, L), bool))
    decay = jnp.exp(jnp.where(tril, gc[..., :, None] - gc[..., None, :], -jnp.inf))
    k_beta = kc * bc[..., None]
    v_beta = vc * bc[..., None]
    A = jnp.where(jnp.tril(jnp.ones((L, L), bool), -1),
                  jnp.einsum('bhcik,bhcjk->bhcij', k_beta, kc) * decay, 0.0)
    eye = jnp.eye(L, dtype=jnp.float32)
    T = lax.linalg.triangular_solve(eye + A, jnp.broadcast_to(eye, A.shape),
                                    left_side=True, lower=True, unit_diagonal=True)
    u_val = T @ v_beta
    k_cum = T @ (k_beta * jnp.exp(gc)[..., None])
    qk = jnp.where(tril, jnp.einsum('bhcik,bhcjk->bhcij', qc, kc) * decay, 0.0)
    q_dec = qc * jnp.exp(gc)[..., None]
    k_tail = kc * jnp.exp(gc[..., -1:] - gc)[..., None]
    g_last = jnp.exp(gc[..., -1])

    def step(state, inp):
        qk_i, u_i, kc_i, qd_i, kt_i, gl_i = inp
        v_new = u_i - kc_i @ state
        o = qd_i @ state + qk_i @ v_new
        state = state * gl_i[..., None, None] + jnp.swapaxes(kt_i, -1, -2) @ v_new
        return state, o

    xs = tuple(jnp.moveaxis(t, 2, 0) for t in (qk, u_val, k_cum, q_dec, k_tail, g_last))
    _, o = lax.scan(step, jnp.zeros((Bsz, H, K, V), jnp.float32), xs)
    o = o.transpose(1, 0, 3, 2, 4).reshape(Bsz, S, H, V)
    o = rms_norm(o) * norm_w * jax.nn.silu(z.reshape(Bsz, S, H, V).astype(jnp.float32))
    return o.reshape(Bsz, S, GDN_OUT).astype(u.dtype)


def hybrid_mixer(h, w_in, q_norm, w_uq, kv_norm, w_ukv, ssd_conv_w, ssd_conv_b, ssd_dt_bias,
                 ssd_a_log, ssd_d, ssd_norm, gdn_conv_w, gdn_conv_b, gdn_dt_bias, gdn_a_log,
                 gdn_norm, w_out):
    u = h @ w_in
    u_mla, u_ssd, u_gdn = jnp.split(u, [MLA_IN, MLA_IN + SSD_IN], axis=-1)
    o = jnp.concatenate([
        mla_mixer(u_mla, q_norm, w_uq, kv_norm, w_ukv),
        ssd_mixer(u_ssd, ssd_conv_w, ssd_conv_b, ssd_dt_bias, ssd_a_log, ssd_d, ssd_norm),
        gdn_mixer(u_gdn, gdn_conv_w, gdn_conv_b, gdn_dt_bias, gdn_a_log, gdn_norm),
    ], axis=-1)
    return o @ w_out


def swiglu(h, w_gate, w_up, w_down):
    return (jax.nn.silu(h @ w_gate) * (h @ w_up)) @ w_down


def moe_ffn(h, w_router, w_gate, w_up, w_down):
    Bsz, S, D = h.shape
    T = Bsz * S
    TK = T * TOP_K
    ht = h.reshape(T, D)
    logits = (ht @ w_router).astype(jnp.float32)
    top_v, top_i = lax.top_k(logits, TOP_K)
    top_w = jax.nn.softmax(top_v, axis=-1)
    e_flat = top_i.reshape(-1).astype(jnp.int32)
    w_flat = top_w.reshape(-1)
    tok_flat = jnp.arange(TK, dtype=jnp.int32) // TOP_K
    order = jnp.argsort(e_flat)
    e_s, tok_s, w_s = e_flat[order], tok_flat[order], w_flat[order]
    counts = jnp.bincount(e_flat, length=N_EXPERTS)
    padded = ((counts + MOE_BLOCK - 1) // MOE_BLOCK) * MOE_BLOCK
    start = jnp.cumsum(counts) - counts
    pend = jnp.cumsum(padded)
    pstart = pend - padded
    dest = pstart[e_s] + (jnp.arange(TK, dtype=jnp.int32) - start[e_s])
    n_blocks = (TK + MOE_BLOCK - 1) // MOE_BLOCK + N_EXPERTS
    n_rows = n_blocks * MOE_BLOCK
    row_tok = jnp.zeros((n_rows,), jnp.int32).at[dest].set(tok_s)
    row_w = jnp.zeros((n_rows,), jnp.float32).at[dest].set(w_s)
    block_expert = jnp.minimum(
        jnp.searchsorted(pend, jnp.arange(n_blocks) * MOE_BLOCK, side='right'), N_EXPERTS - 1)
    xb = ht[row_tok].reshape(n_blocks, MOE_BLOCK, D)

    def expert_block(args):
        xblk, e = args
        return swiglu(xblk, w_gate[e], w_up[e], w_down[e])

    yb = lax.map(expert_block, (xb, block_expert)).reshape(n_rows, D)
    out = jnp.zeros((T, D), yb.dtype).at[row_tok].add(yb * row_w[:, None].astype(yb.dtype))
    return out.reshape(Bsz, S, D).astype(h.dtype)


def modulate(x, shift, scale):
    return rms_norm(x) * (1.0 + scale[:, None, :]) + shift[:, None, :]


def setup_inputs(seed: int = 0) -> dict:
    key = jax.random.key(seed)
    ks = iter(jax.random.split(key, 32))
    f32 = jnp.float32

    def nrm(shape, scale):
        return jax.random.normal(next(ks), shape, f32) * scale

    def gain(shape):
        return 1.0 + 0.02 * jax.random.normal(next(ks), shape, f32)

    def dt_bias(shape):
        dt = jnp.exp(jax.random.uniform(next(ks), shape, f32, math.log(1e-3), math.log(1e-1)))
        return dt + jnp.log(-jnp.expm1(-dt))

    def a_log(shape):
        return jnp.log(jax.random.uniform(next(ks), shape, f32, 1.0, 16.0))

    L = DEPTH
    return {
        "x": nrm((BATCH, SEQ, D_MODEL), 1.0),
        "c": nrm((BATCH, D_MODEL), 1.0),
        "ada_w": nrm((L, D_MODEL, 6 * D_MODEL), 0.5 * D_MODEL ** -0.5),
        "ada_b": nrm((L, 6 * D_MODEL), 0.02),
        "w_in": nrm((L, D_MODEL, D_IN), D_MODEL ** -0.5),
        "mla_q_norm": gain((L, MLA_Q_RANK)),
        "mla_w_uq": nrm((L, MLA_Q_RANK, MLA_HEADS * (MLA_NOPE + MLA_ROPE)), MLA_Q_RANK ** -0.5),
        "mla_kv_norm": gain((L, MLA_KV_RANK)),
        "mla_w_ukv": nrm((L, MLA_KV_RANK, MLA_HEADS * (MLA_NOPE + MLA_V)), MLA_KV_RANK ** -0.5),
        "ssd_conv_w": nrm((L, CONV_WIDTH, SSD_CONV_DIM), CONV_WIDTH ** -0.5),
        "ssd_conv_b": nrm((L, SSD_CONV_DIM), 0.02),
        "ssd_dt_bias": dt_bias((L, SSD_HEADS)),
        "ssd_a_log": a_log((L, SSD_HEADS)),
        "ssd_d": gain((L, SSD_HEADS)),
        "ssd_norm": gain((L, SSD_D_INNER)),
        "gdn_conv_w": nrm((L, CONV_WIDTH, GDN_QKV), CONV_WIDTH ** -0.5),
        "gdn_conv_b": nrm((L, GDN_QKV), 0.02),
        "gdn_dt_bias": dt_bias((L, GDN_HEADS)),
        "gdn_a_log": a_log((L, GDN_HEADS)),
        "gdn_norm": gain((L, GDN_DV)),
        "w_out": nrm((L, D_MIX, D_MODEL), D_MIX ** -0.5),
        "ffn_w_gate": nrm((N_DENSE, D_MODEL, D_FF_DENSE), D_MODEL ** -0.5),
        "ffn_w_up": nrm((N_DENSE, D_MODEL, D_FF_DENSE), D_MODEL ** -0.5),
        "ffn_w_down": nrm((N_DENSE, D_FF_DENSE, D_MODEL), D_FF_DENSE ** -0.5),
        "moe_router": nrm((N_MOE, D_MODEL, N_EXPERTS), D_MODEL ** -0.5),
        "moe_w_gate": nrm((N_MOE, N_EXPERTS, D_MODEL, D_FF_EXPERT), D_MODEL ** -0.5),
        "moe_w_up": nrm((N_MOE, N_EXPERTS, D_MODEL, D_FF_EXPERT), D_MODEL ** -0.5),
        "moe_w_down": nrm((N_MOE, N_EXPERTS, D_FF_EXPERT, D_MODEL), D_FF_EXPERT ** -0.5),
        "final_norm": gain((D_MODEL,)),
    }


def reference(x, c, ada_w, ada_b, w_in, mla_q_norm, mla_w_uq, mla_kv_norm, mla_w_ukv,
              ssd_conv_w, ssd_conv_b, ssd_dt_bias, ssd_a_log, ssd_d, ssd_norm,
              gdn_conv_w, gdn_conv_b, gdn_dt_bias, gdn_a_log, gdn_norm, w_out,
              ffn_w_gate, ffn_w_up, ffn_w_down, moe_router, moe_w_gate, moe_w_up, moe_w_down,
              final_norm):
    c_act = jax.nn.silu(c)
    for l in range(DEPTH):
        mod = jnp.einsum('bd,de->be', c_act, ada_w[l]) + ada_b[l]
        sh1, sc1, g1, sh2, sc2, g2 = jnp.split(mod, 6, axis=-1)
        h = modulate(x, sh1, sc1)
        mix = hybrid_mixer(h, w_in[l], mla_q_norm[l], mla_w_uq[l], mla_kv_norm[l], mla_w_ukv[l],
                           ssd_conv_w[l], ssd_conv_b[l], ssd_dt_bias[l], ssd_a_log[l], ssd_d[l],
                           ssd_norm[l], gdn_conv_w[l], gdn_conv_b[l], gdn_dt_bias[l],
                           gdn_a_log[l], gdn_norm[l], w_out[l])
        x = x + g1[:, None, :] * mix
        h = modulate(x, sh2, sc2)
        if l % 2 == 0:
            f = swiglu(h, ffn_w_gate[l // 2], ffn_w_up[l // 2], ffn_w_down[l // 2])
        else:
            f = moe_ffn(h, moe_router[l // 2], moe_w_gate[l // 2], moe_w_up[l // 2],
                        moe_w_down[l // 2])
        x = x + g2[:, None, :] * f
    return rms_norm(x) * final_norm
```

```cpp
#include <hip/hip_runtime.h>
#include <cstdio>
#include <cstdint>
#include <cmath>
#ifndef DUP_MASK
#define DUP_MASK 0
#endif
#define CONV_NY 171
#define DUPN(k) (1 + ((DUP_MASK >> (k)) & 1))
#ifndef PROBE_CHECK
#define PROBE_HEAD 0
#define PROBE_BASE 8
#define PROBE_CHECK 0
#endif
#ifndef PROBE_SKIP
#define PROBE_SKIP 0
#endif
namespace pg8 {
#define PG8_LAS __attribute__((address_space(3)))
typedef unsigned short bf16_t;
typedef short bf16x8 __attribute__((ext_vector_type(8)));
typedef float f32x4 __attribute__((ext_vector_type(4)));
typedef float f32x2 __attribute__((ext_vector_type(2)));
typedef unsigned u32x4 __attribute__((ext_vector_type(4)));
constexpr int BM = 256, BK = 64, HALF = 128, HTB = HALF * BK * 2  , STAGE_BYTES = 8 * HTB, NXCD = 8, WGM = 8;

__host__ __device__ __forceinline__ int lds_byte(int r, int c) { const int st = (r >> 4) * 2 + (c >> 5), rr = r & 15, cc = c & 31, ob = rr * 64 + cc * 2; return st * 1024 + (ob ^ (((ob >> 9) & 1) << 5)); }
__host__ __device__ __forceinline__ void stage_rc(int b, int& R, int& C) { const int st = b / 1024, sb = b % 1024, swz = sb ^ (((sb >> 9) & 1) << 5); R = (st >> 1) * 16 + swz / 64; C = (st & 1) * 32 + (swz % 64) / 2; }
__host__ __device__ __forceinline__ int perm32(int rho) { const int n = rho >> 4, i = rho & 15; return 8 * (i >> 2) + 4 * n + (i & 3); }

struct Unit { int pm, pn, ab, av; };
struct Gemm { const bf16_t* A; const bf16_t* Bt; int lda; int K; };

struct StaticOrder {
    int nM, nN, nwg, G, c;
    __host__ __device__ void init(int M, int N, int G_, int c_) { nM = M / BM; nN = N / BM; nwg = nM * nN; G = G_; c = c_; }
    __host__ __device__ bool next(int i, Unit& u) const {
        const long L = (long)i * G + c; if (L >= nwg) return false;
        int wgid = (int)L; { const int q = nwg / NXCD, r = nwg % NXCD, xcd = wgid % NXCD, off = wgid / NXCD; wgid = (xcd < r ? xcd * (q + 1) : r * (q + 1) + (xcd - r) * q) + off; }
        const int nig = WGM * nN, gid = wgid / nig, fm = gid * WGM, gsz = (nM - fm) < WGM ? (nM - fm) : WGM;
        u.pm = fm + ((wgid % nig) % gsz); u.pn = (wgid % nig) / gsz; u.ab = 0; u.av = 0; return true;
    }
    static constexpr bool GATHER = false;
    __device__ __forceinline__ int arow(const Unit& u, int r) const { return u.pm * BM + r; }
};

struct BatchOrder {
    StaticOrder S; int bsel, rows_per_batch;
    __host__ __device__ void init(int M, int N, int G_, int c_, int bsel_, int rpb_) { S.init(M, N, G_, c_); bsel = bsel_; rows_per_batch = rpb_; }
    __host__ __device__ bool next(int i, Unit& u) const { if (!S.next(i, u)) return false; u.pn += bsel * ((u.pm * BM) / rows_per_batch) * S.nN; return true; }
    static constexpr bool GATHER = false;
    __device__ __forceinline__ int arow(const Unit& u, int r) const { return u.pm * BM + r; }
};
__device__ __forceinline__ unsigned cvt_pk_bf16(float lo, float hi) { unsigned r; asm volatile("v_cvt_pk_bf16_f32 %0, %1, %2" : "=v"(r) : "v"(lo), "v"(hi)); return r; }


typedef int pg8_v8i __attribute__((ext_vector_type(8))); typedef int pg8_v4i __attribute__((ext_vector_type(4)));
__device__ __forceinline__ pg8_v8i pg8_cat(bf16x8 a, bf16x8 b) { return __builtin_shufflevector(__builtin_bit_cast(pg8_v4i, a), __builtin_bit_cast(pg8_v4i, b), 0, 1, 2, 3, 4, 5, 6, 7); }
template <int IMM> __device__ __forceinline__ void glds_sv_t(const char* sbase, unsigned voff, unsigned lds_dst) { unsigned keep;
    asm volatile("s_mov_b32 %0, m0\n\ts_mov_b32 m0, %3\n\ts_nop 0\n\tglobal_load_lds_dwordx4 %1, %2 offset:%c4\n\ts_mov_b32 m0, %0" : "=&s"(keep) : "v"(voff), "s"(sbase), "s"(lds_dst), "i"(IMM) : "memory"); }
#define glds_sv(sbase, voff, ldsdst, IMM) glds_sv_t<IMM>(sbase, voff, ldsdst)
template <class Epi, class Sched, bool ALIGN_EPI, bool FP8 = false>
__device__ __forceinline__ void gemm_phase(PG8_LAS unsigned char* lds, const int tid_in, const Gemm g, const Sched& S, const Epi& E) {
    const int tid = tid_in, wid = __builtin_amdgcn_readfirstlane(tid >> 6), lane = tid & 63, wr = wid >> 2, wc = wid & 3, fr = lane & 15, fq = lane >> 4;
    const int K = g.K, nt = K / BK, lda = g.lda;
    unsigned voffB[2], voffA[2];
#pragma unroll
    for (int i = 0; i < 2; ++i) { int R, C; stage_rc(tid * 16 + i * 8192, R, C); const int Rb = Epi::PERM ? ((R & ~31) + perm32(R & 31)) : R;
        voffB[i] = (unsigned)(Rb * K + C) * 2u; voffA[i] = (unsigned)(R * lda + C) * 2u; }
    const size_t hstepA = (size_t)HALF * lda * 2;
    const size_t kstep = (size_t)(BK * 2);
    const size_t hstep = (size_t)HALF * K * 2;
    const size_t tstep = 2 * hstep;
    const unsigned ldsw = (unsigned)wid * 1024u; const unsigned lds0 = (unsigned)(uintptr_t)lds;
    const int aoff = lds_byte(wr * 64 + fr, fq * 8), boff = lds_byte(wc * 32 + fr, fq * 8);
    const char* Ab = (const char*)g.A;
#define PG8_SA(b, h) (((b) * 2 + (h)) * HTB)
#define PG8_SB(b, h) ((4 + (b) * 2 + (h)) * HTB)
#define PG8_STAGE(bufoff, gbase, voff, IMM) do { _Pragma("unroll") for (int _i = 0; _i < 2; ++_i) \
        glds_sv((const char*)(gbase), (voff)[_i], (unsigned)__builtin_amdgcn_readfirstlane(lds0 + (bufoff) + ldsw + _i * 8192 - (IMM)), IMM); } while (0)
#define PG8_AOFFS(u, o) do { _Pragma("unroll") for (int _i = 0; _i < 2; ++_i) { int R_, C_; stage_rc(tid * 16 + _i * 8192, R_, C_);     \
        _Pragma("unroll") for (int _h = 0; _h < 2; ++_h) o[_h][_i] = ((unsigned)S.arow(u, _h * HALF + R_) * (unsigned)lda + (unsigned)C_) * 2u; } } while (0)
#define PG8_LDA(dst, b, h) do { _Pragma("unroll") for (int m = 0; m < 4; ++m) { if constexpr (FP8) { dst##8[m] = __builtin_shufflevector(*(const PG8_LAS pg8_v4i*)(lds + PG8_SA(b, h) + aoff + m * 2048), *(const PG8_LAS pg8_v4i*)(lds + PG8_SA(b, h) + aoff + m * 2048 + 1024), 0, 1, 2, 3, 4, 5, 6, 7); } \
        else { _Pragma("unroll") for (int k = 0; k < 2; ++k) dst[m][k] = *(const PG8_LAS bf16x8*)(lds + PG8_SA(b, h) + aoff + m * 2048 + k * 1024); } } } while (0)
#define PG8_LDB(dst, b, h) do { _Pragma("unroll") for (int n = 0; n < 2; ++n) { if constexpr (FP8) { dst##8[n] = __builtin_shufflevector(*(const PG8_LAS pg8_v4i*)(lds + PG8_SB(b, h) + boff + n * 2048), *(const PG8_LAS pg8_v4i*)(lds + PG8_SB(b, h) + boff + n * 2048 + 1024), 0, 1, 2, 3, 4, 5, 6, 7); } \
        else { _Pragma("unroll") for (int k = 0; k < 2; ++k) dst[n][k] = *(const PG8_LAS bf16x8*)(lds + PG8_SB(b, h) + boff + n * 2048 + k * 1024); } } } while (0)
#define PG8_MMA(ai, bj, At, Bt) do { __builtin_amdgcn_s_setprio(1); if constexpr (FP8) { \
        _Pragma("unroll") for (int m = 0; m < 4; ++m) _Pragma("unroll") for (int n = 0; n < 2; ++n) \
            asm volatile("v_mfma_scale_f32_16x16x128_f8f6f4 %0, %1, %2, %0, %3, %3 op_sel_hi:[0,0,0]" : "+v"(acc[ai][bj][m][n]) : "v"(Bt##8[n]), "v"(At##8[m]), "v"(sc8));     \
      } else { _Pragma("unroll") for (int m = 0; m < 4; ++m) _Pragma("unroll") for (int n = 0; n < 2; ++n) _Pragma("unroll") for (int k = 0; k < 2; ++k) \
        acc[ai][bj][m][n] = __builtin_amdgcn_mfma_f32_16x16x32_bf16(Bt[n][k], At[m][k], acc[ai][bj][m][n], 0, 0, 0); } __builtin_amdgcn_s_setprio(0); } while (0)
#define PG8_WAIT_V(n) asm volatile("s_waitcnt vmcnt(" #n ")" ::: "memory")
#define PG8_WAIT_L(n) asm volatile("s_waitcnt lgkmcnt(" #n ")" ::: "memory")
#define PG8_BAR __builtin_amdgcn_s_barrier()
#define PG8_SCHED __builtin_amdgcn_sched_barrier(0)
    const int sc8 = 0x7f7f7f7f;
    Unit cur, nxt; int ui = 0;
#define PG8_UNIFORM(u) do { u.pm = __builtin_amdgcn_readfirstlane(u.pm); u.pn = __builtin_amdgcn_readfirstlane(u.pn); u.ab = __builtin_amdgcn_readfirstlane(u.ab); u.av = __builtin_amdgcn_readfirstlane(u.av); } while (0)
    if (!S.next(0, cur)) return;
    PG8_UNIFORM(cur);
    f32x4 acc[2][2][4][2];
#pragma unroll
    for (int a = 0; a < 2; ++a)
#pragma unroll
        for (int b = 0; b < 2; ++b)
#pragma unroll
            for (int m = 0; m < 4; ++m)
#pragma unroll
                for (int n = 0; n < 2; ++n) acc[a][b][m][n] = (f32x4){0.f, 0.f, 0.f, 0.f};
    bf16x8 At[4][2], B0[2][2], B1[2][2]; pg8_v8i At8[4], B08[2], B18[2];
    unsigned oC[2][2], o2[2][2], oN[2][2];
    const char* cA = Ab; const char* nA = Ab; const char* a2 = Ab;
    if constexpr (Sched::GATHER) { PG8_AOFFS(cur, oC); } else { cA = Ab + (size_t)S.arow(cur, 0) * lda * 2; }
#define PG8_STAGE_AC(bufoff, h, kb, IMM) do { if constexpr (Sched::GATHER) { PG8_STAGE(bufoff, Ab + (kb), oC[h], IMM); } else { PG8_STAGE(bufoff, cA + (h) * hstepA + (kb), voffA, IMM); } } while (0)
#define PG8_STAGE_A2(bufoff, h, IMM) do { if constexpr (Sched::GATHER) { PG8_STAGE(bufoff, a2, o2[h], IMM); } else { PG8_STAGE(bufoff, a2 + (h) * hstepA, voffA, IMM); } } while (0)
    const char* cB = (const char*)g.Bt + (size_t)cur.pn * tstep;
    PG8_STAGE(PG8_SB(0, 0), cB, voffB, 0); PG8_STAGE(PG8_SB(0, 1), cB + hstep, voffB, 0); PG8_STAGE_AC(PG8_SA(0, 0), 0, 0, 0); PG8_STAGE_AC(PG8_SA(0, 1), 1, 0, 0);
    if (wr == 1) PG8_BAR;
    PG8_WAIT_V(2); PG8_BAR;
    PG8_STAGE(PG8_SB(1, 0), cB, voffB, 128); PG8_STAGE_AC(PG8_SA(1, 0), 0, 0, 128); PG8_STAGE(PG8_SB(1, 1), cB + hstep, voffB, 128);
    PG8_WAIT_V(6); PG8_BAR;
    for (;;) {
        const bool has_next = S.next(ui + 1, nxt); PG8_UNIFORM(nxt);
        if constexpr (!Sched::GATHER) { nA = has_next ? Ab + (size_t)S.arow(nxt, 0) * lda * 2 : cA; }
        const char* nB = has_next ? (const char*)g.Bt + (size_t)nxt.pn * tstep : cB;
        for (int t = 0; t < nt; t += 2) {
            const bool last = (t == nt - 2);
            const size_t k0 = (size_t)t * kstep;
            const char* b2 = last ? nB : cB + (size_t)(t + 2) * kstep;
            if constexpr (Sched::GATHER) {
                a2 = last ? Ab : Ab + (size_t)(t + 2) * kstep;
                if (t == nt - 4 && has_next) { Unit nq = nxt; asm volatile("" : "+s"(nq.ab), "+s"(nq.av)); PG8_AOFFS(nq, oN); }
#pragma unroll
                for (int h = 0; h < 2; ++h)
#pragma unroll
                    for (int i = 0; i < 2; ++i) o2[h][i] = (last && has_next) ? oN[h][i] : oC[h][i];
            } else { a2 = last ? nA : cA + (size_t)(t + 2) * kstep; }
            PG8_LDB(B0, 0, 0); PG8_LDB(B1, 0, 1); PG8_SCHED; PG8_LDA(At, 0, 0); PG8_STAGE_AC(PG8_SA(1, 1), 1, k0, 128);
            PG8_WAIT_V(8); PG8_WAIT_L(0); PG8_BAR; PG8_MMA(0, 0, At, B0); PG8_MMA(0, 1, At, B1); PG8_BAR; PG8_SCHED;
            PG8_LDA(At, 0, 1); PG8_STAGE(PG8_SB(0, 0), b2, voffB, 0); PG8_STAGE(PG8_SB(0, 1), b2 + hstep, voffB, 0); PG8_STAGE_A2(PG8_SA(0, 0), 0, 0);
            PG8_WAIT_V(8); PG8_WAIT_L(0); PG8_BAR; PG8_MMA(1, 0, At, B0); PG8_MMA(1, 1, At, B1); PG8_BAR; PG8_SCHED;
            PG8_LDB(B0, 1, 0); PG8_LDB(B1, 1, 1); PG8_SCHED; PG8_LDA(At, 1, 0); PG8_STAGE_A2(PG8_SA(0, 1), 1, 0);
            PG8_WAIT_V(8); PG8_WAIT_L(0); PG8_BAR; PG8_MMA(0, 0, At, B0); PG8_MMA(0, 1, At, B1); PG8_BAR; PG8_SCHED;
            PG8_LDA(At, 1, 1); PG8_STAGE(PG8_SB(1, 0), b2, voffB, 128); PG8_STAGE(PG8_SB(1, 1), b2 + hstep, voffB, 128); PG8_STAGE_A2(PG8_SA(1, 0), 0, 128);
            PG8_WAIT_V(8); PG8_WAIT_L(0); PG8_BAR; PG8_MMA(1, 0, At, B0); PG8_MMA(1, 1, At, B1); PG8_BAR; PG8_SCHED;
        }
        if constexpr (FP8) asm volatile("s_nop 15\n\ts_nop 15" ::: "memory");
        if constexpr (ALIGN_EPI) { if (wr == 0) PG8_BAR; }
        { int ln2; asm volatile("v_mbcnt_lo_u32_b32 %0, -1, 0\n\tv_mbcnt_hi_u32_b32 %0, -1, %0" : "=v"(ln2));
          E(acc, cur, wr, wc, ln2 & 15, ln2 >> 4); }
        if (!has_next) break;
#pragma unroll
        for (int a = 0; a < 2; ++a)
#pragma unroll
            for (int b = 0; b < 2; ++b)
#pragma unroll
                for (int m = 0; m < 4; ++m)
#pragma unroll
                    for (int n = 0; n < 2; ++n) acc[a][b][m][n] = (f32x4){0.f, 0.f, 0.f, 0.f};
        cur = nxt; cB = nB; ++ui;
        if constexpr (Sched::GATHER) {
#pragma unroll
            for (int h = 0; h < 2; ++h)
#pragma unroll
                for (int i = 0; i < 2; ++i) oC[h][i] = o2[h][i];
        } else { cA = nA; }
        if constexpr (ALIGN_EPI) { if (wr == 1) PG8_BAR; }
    }
    PG8_WAIT_V(0);
    if constexpr (!ALIGN_EPI) { if (wr == 0) PG8_BAR; }
    PG8_BAR;
#undef PG8_STAGE_AC
#undef PG8_UNIFORM
#undef PG8_STAGE_A2
#undef PG8_SA
#undef PG8_SB
#undef PG8_STAGE
#undef PG8_AOFFS
#undef PG8_LDA
#undef PG8_LDB
#undef PG8_MMA
#undef PG8_WAIT_V
#undef PG8_WAIT_L
#undef PG8_BAR
#undef PG8_SCHED
}
}
namespace pg8 {
__device__ __forceinline__ float fast_silu(float g) { return g * __builtin_amdgcn_rcpf(1.0f + __builtin_amdgcn_exp2f(-1.4426950408889634f * g)); }
struct EpiStoreBf16 {
    static constexpr bool PERM = true;
    bf16_t* O; int ldc; int nN; int row_tile0; float sc; const float* part; const float* bias; int bstride; int rows_per_batch;
    float* rq; float* rkv; PG8_LAS float* red;
    __device__ __forceinline__ void operator()(const f32x4 (&acc)[2][2][4][2], const Unit& u, int wr, int wc, int fr, int fq) const {
        const int row0 = (u.pm - row_tile0) * BM + wr * 64 + fr; const int col0 = (u.pn % nN) * BM + wc * 32 + 8 * fq;
        const int ctile = u.pn % nN; const bool dost = (rq != nullptr) && ctile < 2;
        f32x4 bv[2][2];
#pragma unroll
        for (int bj = 0; bj < 2; ++bj) { bv[bj][0] = (f32x4){0.f, 0.f, 0.f, 0.f}; bv[bj][1] = bv[bj][0]; }
        if (part) { const float* bp = bias + (size_t)((u.pm * BM) / rows_per_batch) * bstride + col0;
#pragma unroll
            for (int bj = 0; bj < 2; ++bj) { bv[bj][0] = *(const f32x4*)(bp + bj * HALF); bv[bj][1] = *(const f32x4*)(bp + bj * HALF + 4); } }
#pragma unroll
        for (int ai = 0; ai < 2; ++ai)
#pragma unroll
            for (int m = 0; m < 4; ++m) { bf16_t* rowp = (bf16_t*)((char*)O + (unsigned)((row0 + ai * HALF + m * 16) * ldc + col0) * 2u);
                float rsc = sc;
                if (part) { const f32x4 p = *(const f32x4*)(part + (size_t)(u.pm * BM + wr * 64 + fr + ai * HALF + m * 16) * 4); rsc = sc * __builtin_amdgcn_rsqf(((p.x + p.y) + (p.z + p.w)) * (1.f / 1024.f) + 1e-6f); }
#pragma unroll
                for (int bj = 0; bj < 2; ++bj) { const f32x4 v0 = acc[ai][bj][m][0] * rsc + bv[bj][0], v1 = acc[ai][bj][m][1] * rsc + bv[bj][1];
                    u32x4 w; w.x = cvt_pk_bf16(v0[0], v0[1]); w.y = cvt_pk_bf16(v0[2], v0[3]); w.z = cvt_pk_bf16(v1[0], v1[1]); w.w = cvt_pk_bf16(v1[2], v1[3]);
                    *(u32x4*)(rowp + bj * HALF) = w; } }
        if (dost) {
#pragma unroll
            for (int ai = 0; ai < 2; ++ai)
#pragma unroll
                for (int m = 0; m < 4; ++m) { float rsc = sc;
                    if (part) { const f32x4 pp = *(const f32x4*)(part + (size_t)(u.pm * BM + wr * 64 + fr + ai * HALF + m * 16) * 4); rsc = sc * __builtin_amdgcn_rsqf(((pp.x + pp.y) + (pp.z + pp.w)) * (1.f / 1024.f) + 1e-6f); }
                    float p = 0.f;
#pragma unroll
                    for (int bj = 0; bj < 2; ++bj) if (ctile == 0 || bj == 0) { const f32x4 v0 = acc[ai][bj][m][0] * rsc + bv[bj][0], v1 = acc[ai][bj][m][1] * rsc + bv[bj][1];
                        p += ((v0[0] * v0[0] + v0[1] * v0[1]) + (v0[2] * v0[2] + v0[3] * v0[3])) + ((v1[0] * v1[0] + v1[1] * v1[1]) + (v1[2] * v1[2] + v1[3] * v1[3])); }
                    p += __builtin_bit_cast(float, __builtin_amdgcn_ds_swizzle(__builtin_bit_cast(int, p), (16 << 10) | 0x1f));
                    if ((fq & 1) == 0) red[(wr * 64 + fr + ai * HALF + m * 16) * 8 + wc * 2 + (fq >> 1)] = p; }
            __syncthreads();
            { int t = (wr * 4 + wc) * 64 + fr + 16 * fq; asm volatile("" : "+v"(t));
              if (t < 256) { PG8_LAS const float* rp = red + t * 8; const float sres = ((rp[0] + rp[1]) + (rp[2] + rp[3])) + ((rp[4] + rp[5]) + (rp[6] + rp[7])); (ctile == 0 ? rq : rkv)[(size_t)u.pm * BM + t] = sres; } }
        }
    }
};
template <bool F8OUT> struct EpiSwigluT {
    static constexpr bool PERM = true;
    bf16_t* Hd; int ldh; int nN; int row_tile0; float sc; float osc;
    const float* part; const float* bias; int bstride; int rows_per_batch;
    __device__ __forceinline__ void operator()(const f32x4 (&acc)[2][2][4][2], const Unit& u, int wr, int wc, int fr, int fq) const {
        const int row0 = (u.pm - row_tile0) * BM + wr * 64 + fr; const int col0 = (u.pn % nN) * HALF + wc * 32 + 8 * fq;
        f32x4 bv[2][2];
#pragma unroll
        for (int bj = 0; bj < 2; ++bj) { bv[bj][0] = (f32x4){0.f, 0.f, 0.f, 0.f}; bv[bj][1] = bv[bj][0]; }
        if (part) { const float* bp = bias + (size_t)((u.pm * BM) / rows_per_batch) * bstride + (u.pn % nN) * BM + wc * 32 + 8 * fq;
#pragma unroll
            for (int bj = 0; bj < 2; ++bj) { bv[bj][0] = *(const f32x4*)(bp + bj * HALF); bv[bj][1] = *(const f32x4*)(bp + bj * HALF + 4); } }
#pragma unroll
        for (int ai = 0; ai < 2; ++ai)
#pragma unroll
            for (int m = 0; m < 4; ++m) {
                float rsc = sc;
                if (part) { const f32x4 p = *(const f32x4*)(part + (size_t)(u.pm * BM + wr * 64 + fr + ai * HALF + m * 16) * 4); rsc = sc * __builtin_amdgcn_rsqf(((p.x + p.y) + (p.z + p.w)) * (1.f / 1024.f) + 1e-6f); }
                const f32x4 g0 = acc[ai][0][m][0] * rsc + bv[0][0], g1 = acc[ai][0][m][1] * rsc + bv[0][1], u0 = acc[ai][1][m][0] * rsc + bv[1][0], u1 = acc[ai][1][m][1] * rsc + bv[1][1];
                float r[8];
#pragma unroll
                for (int i = 0; i < 4; ++i) { r[i] = fast_silu(g0[i]) * u0[i]; r[4 + i] = fast_silu(g1[i]) * u1[i]; }
                if constexpr (F8OUT) { char* rowp = (char*)Hd + (unsigned)((row0 + ai * HALF + m * 16) * ldh + col0);
                    int w0 = 0, w1 = 0; w0 = __builtin_amdgcn_cvt_pk_fp8_f32(r[0] * osc, r[1] * osc, w0, false); w0 = __builtin_amdgcn_cvt_pk_fp8_f32(r[2] * osc, r[3] * osc, w0, true);
                    w1 = __builtin_amdgcn_cvt_pk_fp8_f32(r[4] * osc, r[5] * osc, w1, false); w1 = __builtin_amdgcn_cvt_pk_fp8_f32(r[6] * osc, r[7] * osc, w1, true);
                    f32x2 wv; wv.x = __builtin_bit_cast(float, w0); wv.y = __builtin_bit_cast(float, w1); *(f32x2*)rowp = wv; }
                else { bf16_t* rowp = (bf16_t*)((char*)Hd + (unsigned)((row0 + ai * HALF + m * 16) * ldh + col0) * 2u);
                    u32x4 w; w.x = cvt_pk_bf16(r[0], r[1]); w.y = cvt_pk_bf16(r[2], r[3]); w.z = cvt_pk_bf16(r[4], r[5]); w.w = cvt_pk_bf16(r[6], r[7]);
                    *(u32x4*)rowp = w; } }
    }
};
typedef EpiSwigluT<false> EpiSwiglu;
struct EpiResGate {
    static constexpr bool PERM = true;
    const void* base; bf16_t* out; const float* gate; int gstride; int rows_per_batch; bool bf32;
    unsigned char* x8; float x8scale;
    float* part; PG8_LAS float* red;
    __device__ __forceinline__ void operator()(const f32x4 (&acc)[2][2][4][2], const Unit& u, int wr, int wc, int fr, int fq) const {
        float ssq[2][4];
#pragma unroll
        for (int ai = 0; ai < 2; ++ai)
#pragma unroll
            for (int m = 0; m < 4; ++m) ssq[ai][m] = 0.f;
        const int row0 = u.pm * BM + wr * 64 + fr; const int col0 = u.pn * BM + wc * 32 + 8 * fq;
        const float* gp = gate + (size_t)((u.pm * BM) / rows_per_batch) * gstride + col0;
        f32x4 gv[2][2];
#pragma unroll
        for (int bj = 0; bj < 2; ++bj)
#pragma unroll
            for (int n = 0; n < 2; ++n) gv[bj][n] = *(const f32x4*)(gp + bj * HALF + n * 4);
#pragma unroll
        for (int ai = 0; ai < 2; ++ai)
#pragma unroll
            for (int m = 0; m < 4; ++m) { const unsigned off = (unsigned)((row0 + ai * HALF + m * 16) * 1024 + col0);
#pragma unroll
                for (int bj = 0; bj < 2; ++bj) { f32x4 b0, b1;
                    if (bf32) { b0 = *(const f32x4*)((const char*)base + (size_t)(off + bj * HALF) * 4u); b1 = *(const f32x4*)((const char*)base + (size_t)(off + bj * HALF) * 4u + 16); }
                    else { const u32x4 w = *(const u32x4*)((const char*)base + (off + bj * HALF) * 2u);
                        b0 = (f32x4){__builtin_bit_cast(float, w.x << 16), __builtin_bit_cast(float, w.x & 0xffff0000u), __builtin_bit_cast(float, w.y << 16), __builtin_bit_cast(float, w.y & 0xffff0000u)};
                        b1 = (f32x4){__builtin_bit_cast(float, w.z << 16), __builtin_bit_cast(float, w.z & 0xffff0000u), __builtin_bit_cast(float, w.w << 16), __builtin_bit_cast(float, w.w & 0xffff0000u)}; }
                    const f32x4 v0 = b0 + gv[bj][0] * acc[ai][bj][m][0], v1 = b1 + gv[bj][1] * acc[ai][bj][m][1];
                    ssq[ai][m] += ((v0[0] * v0[0] + v0[1] * v0[1]) + (v0[2] * v0[2] + v0[3] * v0[3])) + ((v1[0] * v1[0] + v1[1] * v1[1]) + (v1[2] * v1[2] + v1[3] * v1[3]));
                    u32x4 o; o.x = cvt_pk_bf16(v0[0], v0[1]); o.y = cvt_pk_bf16(v0[2], v0[3]); o.z = cvt_pk_bf16(v1[0], v1[1]); o.w = cvt_pk_bf16(v1[2], v1[3]);
                    *(u32x4*)((char*)out + (off + bj * HALF) * 2u) = o;
                    if (x8) { int w0 = 0, w1 = 0; w0 = __builtin_amdgcn_cvt_pk_fp8_f32(v0[0] * x8scale, v0[1] * x8scale, w0, false); w0 = __builtin_amdgcn_cvt_pk_fp8_f32(v0[2] * x8scale, v0[3] * x8scale, w0, true);
                        w1 = __builtin_amdgcn_cvt_pk_fp8_f32(v1[0] * x8scale, v1[1] * x8scale, w1, false); w1 = __builtin_amdgcn_cvt_pk_fp8_f32(v1[2] * x8scale, v1[3] * x8scale, w1, true);
                        f32x2 wv; wv.x = __builtin_bit_cast(float, w0); wv.y = __builtin_bit_cast(float, w1); *(f32x2*)(x8 + (off + bj * HALF)) = wv; } } }
        if (part) {
#pragma unroll
            for (int ai = 0; ai < 2; ++ai)
#pragma unroll
                for (int m = 0; m < 4; ++m) { float p = ssq[ai][m]; p += __builtin_bit_cast(float, __builtin_amdgcn_ds_swizzle(__builtin_bit_cast(int, p), (16 << 10) | 0x1f));
                    if ((fq & 1) == 0) red[(wr * 64 + fr + ai * HALF + m * 16) * 8 + wc * 2 + (fq >> 1)] = p; }
            __syncthreads();
            { int t = (wr * 4 + wc) * 64 + fr + 16 * fq; asm volatile("" : "+v"(t));
              if (t < 256) { PG8_LAS const float* rp = red + t * 8; const float sres = ((rp[0] + rp[1]) + (rp[2] + rp[3])) + ((rp[4] + rp[5]) + (rp[6] + rp[7])); part[(size_t)(u.pm * BM + t) * 4 + u.pn] = sres; } }
        }
    }
};
}


namespace pg8 {
struct EpiMlaQ {
    static constexpr bool PERM = false;
    bf16_t* Q; const PG8_LAS float* rs; const float* rope; float qscale; int seq;
    __device__ __forceinline__ void operator()(const f32x4 (&acc)[2][2][4][2], const Unit& u, int wr, int wc, int fr, int fq) const {
#pragma unroll
        for (int bj = 0; bj < 2; ++bj) { const int gidx = u.pn * 8 + bj * 4 + wc; if (gidx >= 12) continue; const int head = gidx / 3, part = gidx % 3;
#pragma unroll
            for (int ai = 0; ai < 2; ++ai)
#pragma unroll
                for (int m = 0; m < 4; ++m) { const int rl = ai * HALF + wr * 64 + m * 16 + fr, row = u.pm * BM + rl, b = row / seq, s = row % seq; const float sc = rs[rl] * qscale;
                    bf16_t* qp = (bf16_t*)((char*)Q + (unsigned)((((b * 4 + head) * seq + s) * 96 + part * 32 + 4 * fq) * 2));
                    const f32x4 v0 = acc[ai][bj][m][0] * sc, v1 = acc[ai][bj][m][1] * sc;
                    if (part < 2) { f32x2 w0, w1; w0.x = __builtin_bit_cast(float, cvt_pk_bf16(v0[0], v0[1])); w0.y = __builtin_bit_cast(float, cvt_pk_bf16(v0[2], v0[3])); w1.x = __builtin_bit_cast(float, cvt_pk_bf16(v1[0], v1[1])); w1.y = __builtin_bit_cast(float, cvt_pk_bf16(v1[2], v1[3]));
                        *(f32x2*)qp = w0; *(f32x2*)(qp + 16) = w1; }
                    else { const char* rp = (const char*)rope + (unsigned)((s * 16 + 4 * fq) * 8); const f32x4 ca = *(const f32x4*)rp, cb = *(const f32x4*)(rp + 16);
                        const float o0 = v0[0] * ca[0] - v1[0] * ca[1], o1 = v0[1] * ca[2] - v1[1] * ca[3], o2 = v0[2] * cb[0] - v1[2] * cb[1], o3 = v0[3] * cb[2] - v1[3] * cb[3];
                        const float p0 = v1[0] * ca[0] + v0[0] * ca[1], p1 = v1[1] * ca[2] + v0[1] * ca[3], p2 = v1[2] * cb[0] + v0[2] * cb[1], p3 = v1[3] * cb[2] + v0[3] * cb[3];
                        f32x2 w0, w1; w0.x = __builtin_bit_cast(float, cvt_pk_bf16(o0, o1)); w0.y = __builtin_bit_cast(float, cvt_pk_bf16(o2, o3)); w1.x = __builtin_bit_cast(float, cvt_pk_bf16(p0, p1)); w1.y = __builtin_bit_cast(float, cvt_pk_bf16(p2, p3));
                        *(f32x2*)qp = w0; *(f32x2*)(qp + 16) = w1; } } }
    }
};
struct EpiMlaKV {
    static constexpr bool PERM = false;
    bf16_t* K; bf16_t* V; const PG8_LAS float* rs; int seq;
    __device__ __forceinline__ void operator()(const f32x4 (&acc)[2][2][4][2], const Unit& u, int wr, int wc, int fr, int fq) const {
#pragma unroll
        for (int bj = 0; bj < 2; ++bj) { const int gidx = u.pn * 8 + bj * 4 + wc, head = gidx >> 2, part = gidx & 3;
#pragma unroll
            for (int ai = 0; ai < 2; ++ai)
#pragma unroll
                for (int m = 0; m < 4; ++m) { const int rl = ai * HALF + wr * 64 + m * 16 + fr, row = u.pm * BM + rl, b = row / seq, s = row % seq; const float sc = rs[256 + rl];
                    bf16_t* dp = (part < 2) ? (bf16_t*)((char*)K + (unsigned)((((b * 4 + head) * seq + s) * 96 + part * 32 + 4 * fq) * 2)) : (bf16_t*)((char*)V + (unsigned)((((b * 4 + head) * seq + s) * 64 + (part - 2) * 32 + 4 * fq) * 2));
                    const f32x4 v0 = acc[ai][bj][m][0] * sc, v1 = acc[ai][bj][m][1] * sc;
                    f32x2 w0, w1; w0.x = __builtin_bit_cast(float, cvt_pk_bf16(v0[0], v0[1])); w0.y = __builtin_bit_cast(float, cvt_pk_bf16(v0[2], v0[3])); w1.x = __builtin_bit_cast(float, cvt_pk_bf16(v1[0], v1[1])); w1.y = __builtin_bit_cast(float, cvt_pk_bf16(v1[2], v1[3]));
                    *(f32x2*)dp = w0; *(f32x2*)(dp + 16) = w1; } }
    }
};
}
#define GAS __attribute__((address_space(1)))
#define LAS __attribute__((address_space(3)))
typedef unsigned short bf16;
typedef unsigned v4u __attribute__((ext_vector_type(4)));
typedef unsigned v2u __attribute__((ext_vector_type(2)));
typedef float f32x4 __attribute__((ext_vector_type(4)));
typedef short bf16x8 __attribute__((ext_vector_type(8)));
typedef GAS unsigned gu32;
typedef GAS unsigned long long gu64;
#define RLX_AGENT __ATOMIC_RELAXED, __HIP_MEMORY_SCOPE_AGENT
#define LDS_WAIT() asm volatile("s_waitcnt lgkmcnt(0)" ::: "memory")
#define VM_WAIT() asm volatile("s_waitcnt vmcnt(0)" ::: "memory")
typedef float pk_f2v __attribute__((ext_vector_type(2))); typedef __bf16 pk_b2v __attribute__((ext_vector_type(2)));
__device__ __forceinline__ unsigned pk2(float lo, float hi) { const pk_f2v v = {lo, hi}; return __builtin_bit_cast(unsigned, __builtin_convertvector(v, pk_b2v)); }
__device__ __forceinline__ unsigned f2bf(float f) { return pk2(f, 0.f) & 0xffffu; }
__device__ __forceinline__ float bf2f(unsigned short v) { return __builtin_bit_cast(float, (unsigned)v << 16); }
__device__ __forceinline__ float bflo(unsigned w) { return __builtin_bit_cast(float, w << 16); }
__device__ __forceinline__ float bfhi(unsigned w) { return __builtin_bit_cast(float, w & 0xffff0000u); }

#define XB_TMO      128
#define XB_XCNT(j)  (256  + 64 * (j))
#define XB_XSUB(j)  (1280 + 64 * (j))
#define XB_XGEN(j)  (2304 + 64 * (j))
#define XB_TOP      3328
#define XB_TOPGEN   3392
#define XCD_BAR_WORDS 3456
#define XB_SPIN_CAP (1u << 23)

__device__ __forceinline__ unsigned xb_ld(unsigned* p)              { return __hip_atomic_load(p, __ATOMIC_RELAXED, __HIP_MEMORY_SCOPE_AGENT); }
__device__ __forceinline__ unsigned xb_add(unsigned* p, unsigned v) { return __hip_atomic_fetch_add(p, v, __ATOMIC_RELAXED, __HIP_MEMORY_SCOPE_AGENT); }
__device__ __forceinline__ unsigned xb_xcc_id() { return (unsigned)__builtin_amdgcn_s_getreg((3 << 11) | 20) & 0xFu; }
#define XB_SPIN(cond, bar) do { unsigned _sp = 0; while (cond) { __builtin_amdgcn_s_sleep(1); \
    if ((++_sp & 255u) == 0u) { if (xb_ld(&(bar)[XB_TMO])) break; if (_sp > XB_SPIN_CAP) { atomicAdd(&(bar)[XB_TMO], 1u); break; } } } } while (0)

struct XcdBarrier {
    unsigned* bar; unsigned x;
    volatile LAS unsigned* st;
};
__device__ __forceinline__ XcdBarrier xcd_barrier_post(unsigned* bar, volatile LAS unsigned* st) {
    XcdBarrier b; b.bar = bar; b.x = xb_xcc_id(); b.st = st;
    if (threadIdx.x == 0) (void)xb_add(&bar[XB_XCNT(b.x)], 1u);
    return b;
}
__device__ __forceinline__ void xcd_barrier_complete(unsigned* bar, unsigned x, unsigned& nloc, unsigned& nx) {
    const unsigned G = gridDim.x * gridDim.y * gridDim.z;
    unsigned sum, cnt, mine, sp = 0u;
    for (;;) {
        sum = 0u; cnt = 0u; mine = 0u;
#pragma unroll
        for (unsigned j = 0; j < 16; ++j) { const unsigned c = xb_ld(&bar[XB_XCNT(j)]); sum += c; cnt += (c > 0u) ? 1u : 0u; mine = (j == x) ? c : mine; }
        if (sum == G) break;
        __builtin_amdgcn_s_sleep(1);
        if ((++sp & 255u) == 0u) { if (xb_ld(&bar[XB_TMO])) break; if (sp > XB_SPIN_CAP) { atomicAdd(&bar[XB_TMO], 1u); break; } }
    }
    nloc = mine > 0u ? mine : 1u; nx = cnt > 0u ? cnt : 1u;
}
__device__ __forceinline__ void xcd_barrier(const XcdBarrier& b) {
    asm volatile("s_waitcnt vmcnt(0)" ::: "memory");
    __syncthreads();
    if (threadIdx.x == 0) {
        unsigned* bar = b.bar;
        __builtin_amdgcn_s_waitcnt(0);
        unsigned nloc = b.st[0], nx = b.st[1];
        if (nloc == 0u) { xcd_barrier_complete(bar, b.x, nloc, nx); b.st[0] = nloc; b.st[1] = nx; }
        const unsigned old = xb_add(&bar[XB_XSUB(b.x)], 1u);
        const unsigned gen = old / nloc;
        if (old + 1u == (gen + 1u) * nloc) {
            __builtin_amdgcn_fence(__ATOMIC_RELEASE, "agent");
            asm volatile("s_waitcnt vmcnt(0)" ::: "memory");
            const unsigned og = xb_add(&bar[XB_TOP], 1u);
            const unsigned tg = og / nx;
            if (og + 1u == (tg + 1u) * nx) xb_add(&bar[XB_TOPGEN], 1u);
            else XB_SPIN(xb_ld(&bar[XB_TOPGEN]) == tg, bar);
            __builtin_amdgcn_fence(__ATOMIC_ACQUIRE, "agent");
            xb_add(&bar[XB_XGEN(b.x)], 1u);
            asm volatile("s_waitcnt vmcnt(0)" ::: "memory");
        } else {
            XB_SPIN(xb_ld(&bar[XB_XGEN(b.x)]) == gen, bar);
            __builtin_amdgcn_fence(__ATOMIC_ACQUIRE, "agent");
            asm volatile("s_waitcnt vmcnt(0)" ::: "memory");
        }
    }
    __syncthreads();
}
#include <hip/hip_bf16.h>
namespace attn_body {
using bf16=__hip_bfloat16;
using bf16x8=__attribute__((ext_vector_type(8)))short;
using s16x4=__attribute__((ext_vector_type(4)))short;
using f32x16=__attribute__((ext_vector_type(16)))float;
using u32x4=__attribute__((ext_vector_type(4)))unsigned;
constexpr int BATCH=2,NHEAD=4,SEQ=16384,DQ=96,DV=64,OPITCH=1024;
constexpr int NW=8,QBLK=32,QB=QBLK*NW,KVBLK=64,NQB=SEQ/QB;
__device__ __forceinline__ int crow(int r,int hi){return (r&3)+8*(r>>2)+4*hi;}
#define SBAR() __builtin_amdgcn_sched_barrier(0)
__device__ __forceinline__ void cmask(f32x16&p0,f32x16&p1,int jb,int qrel,int hi){
  const float NEG=-INFINITY; int qd=qrel-(64*jb+4*hi); asm volatile("":"+v"(qd));
  #pragma unroll
  for(int r=0;r<16;++r){const int c=(r&3)+8*(r>>2); if(c>qd)p0[r]=NEG; if(c+32>qd)p1[r]=NEG;}
}

constexpr int NSLOT=3, NSLOTK=4, KSLOTB=12288, VSLOTB=8192, QOB=4096;
constexpr int LDS_K=0, LDS_V=NSLOTK*KSLOTB, LDS_WS=LDS_V+NSLOT*VSLOTB, LDS_OST=LDS_WS+NW*64*4, LDS_BYTES=LDS_OST+NW*QOB;
__device__ __forceinline__ void glds16(const void*gsrc,unsigned lds_dst){unsigned keep;
  asm volatile("s_mov_b32 %0, m0\n\ts_mov_b32 m0, %2\n\ts_nop 0\n\tglobal_load_lds_dwordx4 %1, off\n\ts_mov_b32 m0, %0":"=&s"(keep):"v"(gsrc),"s"(lds_dst):"memory");}
__device__ __forceinline__ void swap32(float&a,float&b){asm volatile("s_nop 1\n\tv_permlane32_swap_b32 %0, %1\n\ts_nop 1":"+v"(a),"+v"(b));}
__device__ __forceinline__ float max3f(float a,float b,float c){float r;asm("v_max3_f32 %0, %1, %2, %3":"=v"(r):"v"(a),"v"(b),"v"(c));return r;}
__device__ __forceinline__ float max2f(float a,float b){float r;asm("v_max_f32_e32 %0, %1, %2":"=v"(r):"v"(a),"v"(b));return r;}
__device__ __forceinline__ float fadd_s(float a,float b){float r;asm("v_add_f32_e32 %0, %1, %2":"=v"(r):"v"(a),"v"(b));return r;}
__device__ __forceinline__ float fsub_s(float a,float b){float r;asm("v_sub_f32_e32 %0, %1, %2":"=v"(r):"v"(a),"v"(b));return r;}
typedef float f32x2_t __attribute__((ext_vector_type(2))); typedef __bf16 bf16x2_t __attribute__((ext_vector_type(2)));
__device__ __forceinline__ unsigned cvtpk_s(float lo,float hi){f32x2_t v={lo,hi};bf16x2_t b=__builtin_convertvector(v,bf16x2_t);return __builtin_bit_cast(unsigned,b);}
#define WAIT_BAR(N) asm volatile("s_waitcnt vmcnt(" #N ") lgkmcnt(0)\n\ts_barrier":::"memory")
#define WAIT_BAR2(NLO,NHI) do{ if(wid<4){WAIT_BAR(NLO);}else{WAIT_BAR(NHI);} }while(0)

__device__ __forceinline__ void qkt(f32x16&p0,f32x16&p1,const char*Kslot,const bf16x8*qr,int r32,int hi){
  const f32x16 zc=f32x16{};
  const char*kb=Kslot+hi*1024+r32*16;
  #pragma unroll
  for(int d0=0;d0<6;++d0){
    const bf16x8 b0=*reinterpret_cast<const bf16x8*>(kb+d0*2048);
    const bf16x8 b1=*reinterpret_cast<const bf16x8*>(kb+d0*2048+512);
    if(d0==0){p0=__builtin_amdgcn_mfma_f32_32x32x16_bf16(b0,qr[0],zc,0,0,0);p1=__builtin_amdgcn_mfma_f32_32x32x16_bf16(b1,qr[0],zc,0,0,0);}
    else{p0=__builtin_amdgcn_mfma_f32_32x32x16_bf16(b0,qr[d0],p0,0,0,0);p1=__builtin_amdgcn_mfma_f32_32x32x16_bf16(b1,qr[d0],p1,0,0,0);}}
}
typedef __attribute__((address_space(3))) const char* lds_cptr;
typedef short v4i16_t __attribute__((ext_vector_type(4)));
__device__ __forceinline__ void kload8(bf16x8*kf,lds_cptr kp){
  kf[0]=*(const __attribute__((address_space(3))) bf16x8*)(kp);      kf[1]=*(const __attribute__((address_space(3))) bf16x8*)(kp+512);
  kf[2]=*(const __attribute__((address_space(3))) bf16x8*)(kp+2048); kf[3]=*(const __attribute__((address_space(3))) bf16x8*)(kp+2560);
  kf[4]=*(const __attribute__((address_space(3))) bf16x8*)(kp+4096); kf[5]=*(const __attribute__((address_space(3))) bf16x8*)(kp+4608);
  kf[6]=*(const __attribute__((address_space(3))) bf16x8*)(kp+6144); kf[7]=*(const __attribute__((address_space(3))) bf16x8*)(kp+6656);
}
__device__ __forceinline__ void kload2(bf16x8*kf,lds_cptr kp,int j){ kf[2*j]=*(const __attribute__((address_space(3))) bf16x8*)(kp+j*2048); kf[2*j+1]=*(const __attribute__((address_space(3))) bf16x8*)(kp+j*2048+512); }
__device__ __forceinline__ s16x4 vtr(lds_cptr p){ return __builtin_bit_cast(s16x4,__builtin_amdgcn_ds_read_tr16_b64_v4i16((__attribute__((address_space(3))) v4i16_t*)p)); }
__device__ __forceinline__ float rowmax(const f32x16&p0,const f32x16&p1){
  float a=max3f(p0[0],p0[1],p1[0]),b=max3f(p0[2],p0[3],p1[1]);a=max3f(a,p1[2],p1[3]);
  #pragma unroll
  for(int r=4;r<16;r+=4){a=max3f(a,p0[r],p0[r+1]);b=max3f(b,p0[r+2],p0[r+3]);a=max3f(a,p1[r],p1[r+1]);b=max3f(b,p1[r+2],p1[r+3]);}
  float m=max2f(a,b),m2=m; swap32(m,m2);
  return max2f(m,m2);
}
__device__ __forceinline__ void pv(f32x16*o,int vb,bf16x8 pa0,bf16x8 pa1,bf16x8 pa2,bf16x8 pa3){
  #pragma unroll
  for(int d0=0;d0<2;++d0){s16x4 lo[4],hi[4];
    #pragma unroll
    for(int ks=0;ks<4;++ks){
      asm volatile("ds_read_b64_tr_b16 %0,%1 offset:%c2":"=&v"(lo[ks]):"v"(vb),"i"(d0*4096+ks*1024):"memory");
      asm volatile("ds_read_b64_tr_b16 %0,%1 offset:%c2":"=&v"(hi[ks]):"v"(vb),"i"(d0*4096+ks*1024+512):"memory");}
    asm volatile("s_waitcnt lgkmcnt(0)":::"memory");SBAR();
    #define PK(k) (bf16x8){lo[k][0],lo[k][1],lo[k][2],lo[k][3],hi[k][0],hi[k][1],hi[k][2],hi[k][3]}
    o[d0]=__builtin_amdgcn_mfma_f32_32x32x16_bf16(pa0,PK(0),o[d0],0,0,0);
    o[d0]=__builtin_amdgcn_mfma_f32_32x32x16_bf16(pa1,PK(1),o[d0],0,0,0);
    o[d0]=__builtin_amdgcn_mfma_f32_32x32x16_bf16(pa2,PK(2),o[d0],0,0,0);
    o[d0]=__builtin_amdgcn_mfma_f32_32x32x16_bf16(pa3,PK(3),o[d0],0,0,0);
    #undef PK
  }
}

#ifndef ATTN_STORE16
#define ATTN_STORE16(p,v) (*(u32x4*)(p)=(v))
#endif
template<int THRL> __device__ __forceinline__ void attn_unit(const int tid,int b,int h,int qb,const bf16*Q,const bf16*__restrict__ K,const bf16*__restrict__ V,bf16*O,char*shm){
  const int lane=tid&63,r32=lane&31,hi=lane>>5; const int wid=__builtin_amdgcn_readfirstlane(tid>>6);
  const long bhbase=(long)(b*NHEAD+h)*SEQ; const long rowbase=(long)b*SEQ; const int q0=qb*QB;
  const bf16*Qw=Q+(bhbase+q0+wid*QBLK)*DQ;
  const bf16*Kh=K+bhbase*DQ,*Vh=V+bhbase*DV;
  const unsigned lds0=(unsigned)(uintptr_t)shm;
  float*wsf=(float*)(shm+LDS_WS)+wid*64;
  const bf16*ksrc=Kh+(long)lane*DQ+wid*8;
  const bf16*vsrc=Vh+(long)(16*(wid&3)+(lane>>2))*DV+(wid>>2)*32+(lane&3)*8;
  const unsigned kdst=lds0+LDS_K+wid*1024, vdst=lds0+LDS_V+wid*1024;
  #define DMA_K(t,slot) do{ glds16(ksrc+(long)(t)*KVBLK*DQ,(unsigned)__builtin_amdgcn_readfirstlane(kdst+(slot))); if(wid<4) glds16(ksrc+(long)(t)*KVBLK*DQ+64,(unsigned)__builtin_amdgcn_readfirstlane(kdst+8192+(slot))); }while(0)
  #define DMA_V(t,slot) glds16(vsrc+(long)(t)*KVBLK*DV,(unsigned)__builtin_amdgcn_readfirstlane(vdst+(slot)))
  const int vb0=(int)(lds0+LDS_V)+((lane>>4)&1)*32+(lane&3)*8+(4*hi+((lane&15)>>2))*64;
  const char*Kbase=shm+LDS_K; bf16x8 kf[12];
  const lds_cptr shm3=(lds_cptr)shm; const lds_cptr kp0=shm3+LDS_K+hi*1024+r32*16; const lds_cptr vp0=shm3+LDS_V+((lane>>4)&1)*32+(lane&3)*8+(4*hi+((lane&15)>>2))*64;
  const int NT=(q0+QB)/KVBLK;
  DMA_K(0,0);DMA_V(0,0);DMA_K(1,KSLOTB);
  bf16x8 qr[6];
  #pragma unroll
  for(int d0=0;d0<6;++d0)qr[d0]=*reinterpret_cast<const bf16x8*>(&Qw[(long)r32*DQ+d0*16+hi*8]);
  float mhat=0.f,l_reg=0.f;f32x16 o[2];o[0]=f32x16{};o[1]=f32x16{};const f32x16 zc=f32x16{};
  const int qrel=wid*QBLK+r32;
  #define CMASK(P0,P1,t) do{int jb_=(t)-(NT-4); if(jb_>=0)cmask(P0,P1,jb_,qrel,hi);}while(0)
  bool resc=false;
  #define START(P0,P1) do{ const float rm=rowmax(P0,P1); resc=false; \
    { const float dl=rm; mhat=fadd_s(mhat,dl); \
      _Pragma("unroll") for(int r=0;r<16;++r){P0[r]=fsub_s(P0[r],dl);P1[r]=fsub_s(P1[r],dl);} } \
    _Pragma("unroll") for(int r=0;r<16;++r)P0[r]=__builtin_amdgcn_exp2f(P0[r]); }while(0)
  #define RESC() do{ if(resc){ asm volatile("s_waitcnt lgkmcnt(0)":::"memory"); const float*wl_=wsf+4*hi; asm volatile("":"+v"(wl_)); \
      _Pragma("unroll") for(int d_=0;d_<2;++d_) _Pragma("unroll") for(int r=0;r<16;++r)o[d_][r]*=wl_[crow(r,0)]; } }while(0)
  f32x16 pA0,pA1,pB0,pB1;
  int kprev=3*KSLOTB,kcur=0,knext=KSLOTB, vprev=0,vcur=0,vnext=VSLOTB;
  #define ROT() do{kprev=kcur;kcur=knext;knext=(knext==(NSLOTK-1)*KSLOTB)?0:knext+KSLOTB; vprev=vcur;vcur=vnext;vnext=(vnext==(NSLOT-1)*VSLOTB)?0:vnext+VSLOTB;}while(0)
  DMA_K(2,2*KSLOTB);
  WAIT_BAR2(5,3);
  qkt(pA0,pA1,Kbase,qr,r32,hi);asm volatile("s_nop 15\n\ts_nop 7":"+v"(pA0),"+v"(pA1));CMASK(pA0,pA1,0);
  START(pA0,pA1);
  _Pragma("unroll") for(int r=0;r<16;++r)pA1[r]=__builtin_amdgcn_exp2f(pA1[r]);
  WAIT_BAR(0);
  DMA_K(3,3*KSLOTB);DMA_V(1,VSLOTB);
  ROT();
  kload2(kf,kp0+kcur,0); kload2(kf,kp0+kcur,1); kload2(kf,kp0+kcur,2); kload2(kf,kp0+kcur,3); kload2(kf,kp0+kcur,4); kload2(kf,kp0+kcur,5);
  WAIT_BAR2(3,2);
  s16x4 vlo[8],vhi[8]; u32x4 pw0,pw1,pw2,pw3;
  #define PKW(P,B) cvtpk_s(P[B],P[B+1])
  #define PAF(k) __builtin_bit_cast(bf16x8,pw##k)
  #define VFR(i) (bf16x8){vlo[i][0],vlo[i][1],vlo[i][2],vlo[i][3],vhi[i][0],vhi[i][1],vhi[i][2],vhi[i][3]}
  #define PIN(x) asm volatile("":"+v"(x))
  #define MX3(a,b,c) __builtin_fmaxf(__builtin_fmaxf((a),(b)),(c))
  #define GAPA(MF,A0,A1,A2,A3,W0,W1,PW) do{ MF; sacc+=A0; sacc+=A1; sacc+=A2; sacc+=A3; PIN(sacc); W0; W1; PIN(PW); SBAR(); }while(0)
  #define EX(v) __builtin_amdgcn_exp2f(v)
  #define GAPB(MF,X,B) do{ MF; X[B]=EX(X[B]-mhat); X[B+1]=EX(X[B+1]-mhat); X[B+2]=EX(X[B+2]-mhat); X[B+3]=EX(X[B+3]-mhat); PIN(X); SBAR(); }while(0)
  #define VRD(i) do{ vlo[i]=vtr(vp_+(((i)>>2)*4096+((i)&3)*1024)); vhi[i]=vtr(vp_+(((i)>>2)*4096+((i)&3)*1024+512)); }while(0)
  #define KRD(G,j) do{ if(G){ kload2(kf,kp0+knext,j); SBAR(); } }while(0)
  #define STEP(C0,C1,P0,P1,t,GK,GV,GL) do{ SBAR(); \
    const lds_cptr vp_=vp0+vprev; float sacc=(P0[0]+P0[1]); \
    GAPA(C0=__builtin_amdgcn_mfma_f32_32x32x16_bf16(kf[0],qr[0],zc,0,0,0), P0[2],P0[3],P0[4],P0[5],     pw0[0]=PKW(P0,0), pw0[1]=PKW(P0,2), pw0); \
    GAPA(C1=__builtin_amdgcn_mfma_f32_32x32x16_bf16(kf[1],qr[0],zc,0,0,0), P0[6],P0[7],P0[8],P0[9],     pw0[2]=PKW(P0,4), pw0[3]=PKW(P0,6), pw0); \
    GAPA(C0=__builtin_amdgcn_mfma_f32_32x32x16_bf16(kf[2],qr[1],C0,0,0,0),   P0[10],P0[11],P0[12],P0[13], pw1[0]=PKW(P0,8), pw1[1]=PKW(P0,10), pw1); \
    GAPA(C1=__builtin_amdgcn_mfma_f32_32x32x16_bf16(kf[3],qr[1],C1,0,0,0),   P0[14],P0[15],P1[0],P1[1],   pw1[2]=PKW(P0,12),pw1[3]=PKW(P0,14), pw1); \
    GAPA(C0=__builtin_amdgcn_mfma_f32_32x32x16_bf16(kf[4],qr[2],C0,0,0,0),   P1[2],P1[3],P1[4],P1[5],     pw2[0]=PKW(P1,0), pw2[1]=PKW(P1,2), pw2); \
    GAPA(C1=__builtin_amdgcn_mfma_f32_32x32x16_bf16(kf[5],qr[2],C1,0,0,0),   P1[6],P1[7],P1[8],P1[9],     pw2[2]=PKW(P1,4), pw2[3]=PKW(P1,6), pw2); \
    GAPA(C0=__builtin_amdgcn_mfma_f32_32x32x16_bf16(kf[6],qr[3],C0,0,0,0),   P1[10],P1[11],P1[12],P1[13], pw3[0]=PKW(P1,8), pw3[1]=PKW(P1,10), pw3); \
    GAPA(C1=__builtin_amdgcn_mfma_f32_32x32x16_bf16(kf[7],qr[3],C1,0,0,0),   P1[14],P1[15],0.f,0.f,       pw3[2]=PKW(P1,12),pw3[3]=PKW(P1,14), pw3); \
    VRD(0); C0=__builtin_amdgcn_mfma_f32_32x32x16_bf16(kf[8],qr[4],C0,0,0,0); C1=__builtin_amdgcn_mfma_f32_32x32x16_bf16(kf[9],qr[4],C1,0,0,0); SBAR(); \
    VRD(4); C0=__builtin_amdgcn_mfma_f32_32x32x16_bf16(kf[10],qr[5],C0,0,0,0); C1=__builtin_amdgcn_mfma_f32_32x32x16_bf16(kf[11],qr[5],C1,0,0,0); SBAR(); \
    l_reg+=sacc; \
    if(GK){DMA_K((t)+3,kprev);} if(GV){DMA_V((t)+1,vnext);} \
    CMASK(C0,C1,t); \
    { float a=MX3(C0[0],C0[1],C1[0]),b=MX3(C0[2],C0[3],C1[1]); a=MX3(a,C1[2],C1[3]); \
      _Pragma("unroll") for(int r=4;r<16;r+=4){a=MX3(a,C0[r],C0[r+1]);b=MX3(b,C0[r+2],C0[r+3]);a=MX3(a,C1[r],C1[r+1]);b=MX3(b,C1[r+2],C1[r+3]);} \
      float rm=__builtin_fmaxf(a,b), rm2=rm; swap32(rm,rm2); rm=__builtin_fmaxf(rm,rm2)-mhat; \
      resc=false; \
      if(__builtin_expect(__any(rm>(float)THRL),0)){ const float dl=__builtin_fmaxf(rm,0.f); mhat+=dl; \
        const float f=__builtin_amdgcn_exp2f(-dl); l_reg*=f; if(hi==0)wsf[r32]=f; resc=true; } } \
    SBAR(); \
    VRD(1); SBAR(); GAPB(o[0]=__builtin_amdgcn_mfma_f32_32x32x16_bf16(PAF(0),VFR(0),o[0],0,0,0), C0,0); \
    KRD(GL,0); VRD(5); SBAR(); GAPB(o[1]=__builtin_amdgcn_mfma_f32_32x32x16_bf16(PAF(0),VFR(4),o[1],0,0,0), C0,4); \
    KRD(GL,1); VRD(2); SBAR(); GAPB(o[0]=__builtin_amdgcn_mfma_f32_32x32x16_bf16(PAF(1),VFR(1),o[0],0,0,0), C0,8); \
    KRD(GL,2); VRD(6); SBAR(); GAPB(o[1]=__builtin_amdgcn_mfma_f32_32x32x16_bf16(PAF(1),VFR(5),o[1],0,0,0), C0,12); \
    KRD(GL,3); VRD(3); SBAR(); GAPB(o[0]=__builtin_amdgcn_mfma_f32_32x32x16_bf16(PAF(2),VFR(2),o[0],0,0,0), C1,0); \
    KRD(GL,4); VRD(7); SBAR(); GAPB(o[1]=__builtin_amdgcn_mfma_f32_32x32x16_bf16(PAF(2),VFR(6),o[1],0,0,0), C1,4); \
    KRD(GL,5); GAPB(o[0]=__builtin_amdgcn_mfma_f32_32x32x16_bf16(PAF(3),VFR(3),o[0],0,0,0), C1,8); \
    GAPB(o[1]=__builtin_amdgcn_mfma_f32_32x32x16_bf16(PAF(3),VFR(7),o[1],0,0,0), C1,12); \
    }while(0)
  int t=1;
  #undef CMASK
  #define CMASK(P0,P1,t) do{}while(0)
  for(;t+5<NT;t+=2){
    STEP(pB0,pB1,pA0,pA1,t,true,true,true);     WAIT_BAR2(3,2); RESC(); ROT();
    STEP(pA0,pA1,pB0,pB1,t+1,true,true,true);   WAIT_BAR2(3,2); RESC(); ROT();
  }
  #undef CMASK
  #define CMASK(P0,P1,t) do{int jb_=(t)-(NT-4); if(jb_>=0)cmask(P0,P1,jb_,qrel,hi);}while(0)
  #define ENDW(tt) do{ if((tt)+3<NT){WAIT_BAR2(3,2);} else if((tt)+2<NT){WAIT_BAR(1);} else {WAIT_BAR(0);} }while(0)
  for(;t+1<NT;t+=2){
    STEP(pB0,pB1,pA0,pA1,t,(t+3<NT),(t+1<NT),(t+1<NT));       ENDW(t);   RESC(); ROT();
    STEP(pA0,pA1,pB0,pB1,t+1,(t+4<NT),(t+2<NT),(t+2<NT));     ENDW(t+1); RESC(); ROT();
  }
  STEP(pB0,pB1,pA0,pA1,NT-1,false,false,false); RESC();
  { float sacc=pB0[0]+pB0[1]; _Pragma("unroll") for(int r=2;r<16;++r)sacc+=pB0[r]; _Pragma("unroll") for(int r=0;r<16;++r)sacc+=pB1[r]; l_reg+=sacc;
    pw0=(u32x4){PKW(pB0,0),PKW(pB0,2),PKW(pB0,4),PKW(pB0,6)};pw1=(u32x4){PKW(pB0,8),PKW(pB0,10),PKW(pB0,12),PKW(pB0,14)};pw2=(u32x4){PKW(pB1,0),PKW(pB1,2),PKW(pB1,4),PKW(pB1,6)};pw3=(u32x4){PKW(pB1,8),PKW(pB1,10),PKW(pB1,12),PKW(pB1,14)};
    SBAR(); pv(o,vb0+vcur,PAF(0),PAF(1),PAF(2),PAF(3)); }
  #undef PKW
  #undef PAF
  #undef VFR
  #undef PIN
  #undef MX3
  #undef GAPA
  #undef GAPB
  #undef EX
  #undef VRD
  #undef KRD
  #undef STEP
  #undef ENDW
  {float l2=l_reg; swap32(l_reg,l2); l_reg=l_reg+l2;}
  if(hi==0)wsf[32+r32]=l_reg;asm volatile("s_waitcnt lgkmcnt(0)":::"memory");
  float rli[16]; { const float*wl_=wsf+32+4*hi; asm volatile("":"+v"(wl_));
  #pragma unroll
  for(int r=0;r<16;++r)rli[r]=__builtin_amdgcn_rcpf(wl_[crow(r,0)]); }
  bf16*Ow=O+(rowbase+q0+wid*QBLK)*OPITCH+h*DV;
  { bf16*stg=(bf16*)(shm+LDS_OST+wid*QOB);
    { bf16*stw=stg+(4*hi)*64+r32; asm volatile("":"+v"(stw));
    #pragma unroll
    for(int r=0;r<16;++r){const int orow=crow(r,0);
      #pragma unroll
      for(int d0=0;d0<2;++d0)stw[orow*64+d0*32]=__float2bfloat16(o[d0][r]*rli[r]);} }
    asm volatile("s_waitcnt lgkmcnt(0)":::"memory");
    #pragma unroll
    for(int i=0;i<4;++i){const int row=i*8+(lane>>3),ch=lane&7; const u32x4 v=*(const u32x4*)(stg+row*64+ch*8); ATTN_STORE16(Ow+(long)row*OPITCH+ch*8,v);} }
  asm volatile("s_waitcnt lgkmcnt(0)\n\ts_barrier":::"memory");
  #undef DMA_K
  #undef DMA_V
  #undef CMASK
  #undef START
  #undef RESC
  #undef ROT
}
constexpr int ATTN_LDS_BYTES=LDS_BYTES;
#undef SBAR
#undef WAIT_BAR
#undef WAIT_BAR2
}

constexpr int NWAVES = 8, NTHR = 512;
constexpr int BATCH = 2, SEQ = 16384, DM = 1024, T = BATCH * SEQ;
constexpr int D_IN = 2736, D_INP = 2816;
constexpr int U_CQ = 0, U_CKV = 256, U_KR = 384, U_Z = 416, U_XBC = 928, U_DT = 1696;
constexpr int U_GQKV = 1704, U_GZ = 2472, U_GB = 2728, U_GA = 2732;
constexpr int DFF = 2816, DFFE = 3584, NEXP = 8;
constexpr float EPS = 1e-6f;
constexpr float QSCALE = 0.10206207261596577f * 1.4426950408889634f;

constexpr size_t MiB = 1u << 20;
constexpr size_t WS_CTL = 0, CTL_ZERO_BYTES = 32 * 1024;
constexpr size_t WS_MODP = 1 * MiB;
constexpr size_t WS_PARTA = WS_MODP, WS_PARTB = WS_MODP + 512 * 1024;
constexpr size_t WS_RQ = WS_MODP + 1 * MiB + 128 * 1024, WS_RKV = WS_RQ + 128 * 1024;
constexpr size_t WS_BIASF = WS_MODP + 1 * MiB, WS_BIASW = WS_BIASF + 64 * 1024;
constexpr size_t WS_MOD = 2 * MiB + 512 * 1024;
constexpr size_t WS_ROWTOK = 3 * MiB;
constexpr size_t WS_TOKSLOT = 4 * MiB;
constexpr size_t WS_TOKW = 4 * MiB + 256 * 1024;
constexpr size_t WS_DT = 5 * MiB;
constexpr size_t WS_BG = 6 * MiB;
constexpr size_t WS_W = 8 * MiB;
constexpr size_t WS_WIN = WS_W;
constexpr size_t WS_WOUT = WS_WIN + 11 * MiB;
constexpr size_t WS_FUP = WS_WOUT + 4 * MiB;
constexpr size_t WS_FDN = WS_FUP + 11 * MiB;
constexpr size_t WS_WQ = WS_FDN + 5 * MiB + 512 * 1024;
constexpr size_t WS_WKV = WS_WQ + 512 * 1024;
constexpr size_t WS_O = 42 * MiB;
constexpr size_t WS_U = 106 * MiB;
constexpr size_t WS_HID = WS_U + 51 * MiB;
constexpr size_t WS_Y = WS_W;
constexpr size_t WS_H = 282 * MiB;
constexpr size_t WS_M = 346 * MiB;
constexpr size_t WS_MUP = WS_M, WS_MDN = WS_M + 112 * MiB;
constexpr size_t WS_H8 = WS_MUP + 56 * MiB;
constexpr float FP8_SA = 8.0f, FP8_SW = 64.0f;
constexpr size_t WS_Q = WS_M;
constexpr size_t WS_FUPS = WS_M, WS_WINS = WS_M + 22 * MiB;
constexpr size_t WS_K = WS_Q + 24 * MiB;
constexpr size_t WS_V = WS_K + 24 * MiB;
constexpr size_t WS_XS = WS_V + 16 * MiB;
constexpr size_t WS_SST = WS_XS, WS_CS = WS_XS + 32 * MiB;
constexpr size_t WS_GF = WS_XS + 48 * MiB;
constexpr size_t WS_OR = WS_GF + 80 * MiB;
constexpr size_t WS_ROPE = WS_OR + 32 * MiB;
constexpr size_t WS_END = WS_ROPE + 2 * MiB;
static_assert(WS_Y + (size_t)264 * 256 * 1024 * 2 <= WS_HID, "y vs hid");
constexpr size_t HID_STRIDE = 62 * MiB + 512 * 1024;
static_assert((size_t)71 * 256 * 3584 <= HID_STRIDE && WS_HID + 2 * HID_STRIDE <= WS_H, "hid vs h");
static_assert(WS_FDN + (size_t)1024 * 2816 * 2 <= WS_WQ && WS_WKV + 256 * 1024 <= WS_O, "weights vs o");
constexpr int CW_TMO = 0, CW_MOECNT = 64, CW_ATTQ = 640, CW_BAR = 4096;

constexpr int LDS_BYTES = 147456, RING_BYTES = 131072, MISC_OFF = RING_BYTES + 320;

struct Args { const float* in[29]; float* out; unsigned char* ws; int ph_lo, ph_hi; };

struct Frame { LAS unsigned char* lds; volatile LAS unsigned* MISC; int tid, lane, wave, vcu, G, gw, NGW; };
__device__ __forceinline__ const float* P(const Frame& F, int i) { const unsigned lo = __builtin_amdgcn_readfirstlane(F.MISC[64 + 2 * i]), hi = __builtin_amdgcn_readfirstlane(F.MISC[65 + 2 * i]);
    return (const float*)(const GAS float*)(((unsigned long long)hi << 32) | lo); }
__device__ __forceinline__ unsigned char* WSP(const Frame& F) { return (unsigned char*)P(F, 29); }
__device__ __forceinline__ float* OUTP(const Frame& F) { return (float*)P(F, 30); }


__device__ __forceinline__ Frame reframe(const Frame& F0) { Frame F = F0; int ln; unsigned lb = 0;
    asm volatile("v_mbcnt_lo_u32_b32 %0, -1, 0\n\tv_mbcnt_hi_u32_b32 %0, -1, %0" : "=v"(ln));
    asm volatile("" : "+s"(lb));
    F.lds = F0.lds + lb; F.MISC = (volatile LAS unsigned*)(F.lds + MISC_OFF);
    int vcv = F0.vcu; asm volatile("" : "+s"(vcv)); F.vcu = vcv;
    int gwv = F.vcu * NWAVES + F.wave; asm volatile("" : "+s"(gwv));
    F.lane = ln; F.tid = F.wave * 64 + ln; F.gw = gwv; return F; }
__device__ __forceinline__ int opq(int v) { asm volatile("" : "+s"(v)); return v; }
#define SWZ(v, k) __builtin_bit_cast(float, __builtin_amdgcn_ds_swizzle(__builtin_bit_cast(int, (v)), ((k) << 10) | 0x1f))
template <int CTRL> __device__ __forceinline__ float dppf(float v) { return __builtin_bit_cast(float, __builtin_amdgcn_update_dpp(0, __builtin_bit_cast(int, v), CTRL, 0xf, 0xf, true)); }
__device__ __forceinline__ float sum16(float v) { v += dppf<0xB1>(v); v += dppf<0x4E>(v); v += dppf<0x141>(v); v += dppf<0x140>(v); return v; }
__device__ __forceinline__ float max16(float v) { v = fmaxf(v, dppf<0xB1>(v)); v = fmaxf(v, dppf<0x4E>(v)); v = fmaxf(v, dppf<0x141>(v)); v = fmaxf(v, dppf<0x140>(v)); return v; }
#define RDL(v, k) __builtin_bit_cast(float, __builtin_amdgcn_readlane(__builtin_bit_cast(int, (v)), (k)))
__device__ __forceinline__ float wave_sum(float v) { v = sum16(v); return (RDL(v, 0) + RDL(v, 16)) + (RDL(v, 32) + RDL(v, 48)); }
__device__ __forceinline__ float wave_max(float v) { v = max16(v); return fmaxf(fmaxf(RDL(v, 0), RDL(v, 16)), fmaxf(RDL(v, 32), RDL(v, 48))); }
__device__ __forceinline__ float rcp_f(float x) { return __builtin_amdgcn_rcpf(x); }
__device__ __forceinline__ float rsq_f(float x) { return __builtin_amdgcn_rsqf(x); }
__device__ __forceinline__ float exp_f(float x) { return __builtin_amdgcn_exp2f(x * 1.4426950408889634f); }
__device__ __forceinline__ float silu_f(float x) { return x * rcp_f(1.f + exp_f(-x)); }
__device__ __forceinline__ float sigmoid_f(float x) { return rcp_f(1.f + exp_f(-x)); }
__device__ __forceinline__ float softplus_f(float x) { const float e = exp_f(-fabsf(x));
    const float l = (e < 0.01f) ? e * (1.f - e * (0.5f - e * 0.33333334f)) : __builtin_amdgcn_logf(1.f + e) * 0.6931471805599453f;
    return fmaxf(x, 0.f) + l; }

__device__ __forceinline__ void tr_block(const float* W, int ldw, int nvalid, int k0, int n0, bf16* WT, int ldt, int drow0, LAS float* scr, int lane, const float* kscale = nullptr) {
    const int col = n0 + (lane & 31);
#pragma unroll 8
    for (int i = 0; i < 32; ++i) { const int kk = 2 * i + (lane >> 5); float v = (col < nvalid) ? W[(size_t)(k0 + kk) * ldw + col] : 0.f; if (kscale) v *= kscale[k0 + kk]; scr[kk * 33 + (lane & 31)] = v; }
    LDS_WAIT(); asm volatile("" ::: "memory");
    const int c = lane & 7;
#pragma unroll
    for (int j = 0; j < 4; ++j) { const int n = (lane >> 3) + 8 * j; const LAS float* s = scr + (8 * c) * 33 + n;
        v4u o; o.x = pk2(s[0 * 33], s[1 * 33]); o.y = pk2(s[2 * 33], s[3 * 33]); o.z = pk2(s[4 * 33], s[5 * 33]); o.w = pk2(s[6 * 33], s[7 * 33]);
        *(GAS v4u*)(WT + (size_t)(drow0 + n) * ldt + k0 + 8 * c) = o; }
    LDS_WAIT(); asm volatile("" ::: "memory");
}

__device__ __forceinline__ void ph_prologue(const Frame& F, const Args& a) {
    unsigned char* const ws = WSP(F);
    const float* c = P(F, 1); const float* ada_w = P(F, 2);
    { float* mod = (float*)(ws + WS_MOD); const float* ada_b = P(F, 3); LAS float* red = (LAS float*)(F.lds + 131072 - 8192);
      for (int it = F.vcu; it < 2 * 96; it += F.G) { const int l = it / 96, cb = it % 96, col = cb * 64 + F.lane;
        const float* w = ada_w + (size_t)l * 1024 * 6144 + (size_t)(F.wave * 128) * 6144 + col;
        float a0 = 0.f, a1 = 0.f;
#pragma unroll 8
        for (int k = 0; k < 128; ++k) { const float wv = w[(size_t)k * 6144]; const int kk = F.wave * 128 + k; a0 += silu_f(c[kk]) * wv; a1 += silu_f(c[1024 + kk]) * wv; }
        red[(F.wave * 2 + 0) * 64 + F.lane] = a0; red[(F.wave * 2 + 1) * 64 + F.lane] = a1;
        __syncthreads();
        if (F.tid < 128) { const int b = F.tid >> 6, cl = F.tid & 63; float sacc = ada_b[l * 6144 + cb * 64 + cl];
#pragma unroll
            for (int wv = 0; wv < 8; ++wv) sacc += red[(wv * 2 + b) * 64 + cl];
            mod[(size_t)(l * 2 + b) * 6144 + cb * 64 + cl] = sacc; }
        __syncthreads(); } }
    LAS float* scr = (LAS float*)(F.lds + F.wave * 16384);
    bf16* WIN = (bf16*)(ws + WS_WIN); bf16* WOUT = (bf16*)(ws + WS_WOUT); bf16* FUP = (bf16*)(ws + WS_FUP); bf16* FDN = (bf16*)(ws + WS_FDN);
    constexpr int NB_IN = 16 * 88, NB_OUT = 16 * 32, NB_F = 16 * 88, NB_FD = 44 * 32;
    constexpr int NB_Q = 4 * 16, NB_KV = 2 * 16;
    constexpr int NITEMS = 2 * NB_IN + 2 * NB_OUT + 2 * NB_F + NB_FD + 2 * NB_Q + 2 * NB_KV;
    for (int it = F.gw; it < NITEMS; it += F.NGW) {
        int r = it;
        if (r < 2 * NB_IN) { const int l = r / NB_IN; r %= NB_IN; const int kb = r / 88, nb = r % 88;
            tr_block(P(F, 4) + (size_t)l * 1024 * D_IN, D_IN, D_IN, kb * 64, nb * 32, WIN + (size_t)l * D_INP * 1024, 1024, nb * 32, scr, F.lane); continue; }
        r -= 2 * NB_IN;
        if (r < 2 * NB_OUT) { const int l = r / NB_OUT; r %= NB_OUT; const int kb = r / 32, nb = r % 32;
            tr_block(P(F, 20) + (size_t)l * 1024 * 1024, 1024, 1024, kb * 64, nb * 32, WOUT + (size_t)l * 1024 * 1024, 1024, nb * 32, scr, F.lane); continue; }
        r -= 2 * NB_OUT;
        if (r < 2 * NB_F) { const int which = r / NB_F; r %= NB_F; const int kb = r / 88, nb = r % 88, n0 = nb * 32;
            tr_block(P(F, 21 + which), DFF, DFF, kb * 64, n0, FUP, 1024, 256 * (n0 / 128) + 128 * which + (n0 % 128), scr, F.lane); continue; }
        r -= 2 * NB_F;
        if (r < NB_FD) { const int kb = r / 32, nb = r % 32; tr_block(P(F, 23), 1024, 1024, kb * 64, nb * 32, FDN, DFF, nb * 32, scr, F.lane); continue; }
        r -= NB_FD;
        if (r < 2 * NB_Q) { const int l = r / NB_Q; r %= NB_Q; const int kb = r / 16, nb = r % 16;
            tr_block(P(F, 6) + (size_t)l * 256 * 384, 384, 384, kb * 64, nb * 32, (bf16*)(ws + WS_WQ) + (size_t)l * 512 * 256, 256, nb * 32, scr, F.lane, P(F, 5) + l * 256); continue; }
        r -= 2 * NB_Q;
        { const int l = r / NB_KV; r %= NB_KV; const int kb = r / 16, nb = r % 16;
            tr_block(P(F, 8) + (size_t)l * 128 * 512, 512, 512, kb * 64, nb * 32, (bf16*)(ws + WS_WKV) + (size_t)l * 512 * 128, 128, nb * 32, scr, F.lane, P(F, 7) + l * 128); }
    }
    { float* RT = (float*)(ws + WS_ROPE);
      for (int id = F.vcu * NTHR + F.tid; id < SEQ * 16; id += F.G * NTHR) { const int s = id >> 4, sub = id & 15;
        const float inv_freq = sub == 0 ? 1.0f : sub == 1 ? 0.5623413251903491f : sub == 2 ? 0.31622776601683794f : sub == 3 ? 0.1778279410038923f : sub == 4 ? 0.1f : sub == 5 ? 0.05623413251903491f
            : sub == 6 ? 0.031622776601683794f : sub == 7 ? 0.01778279410038923f : sub == 8 ? 0.01f : sub == 9 ? 0.005623413251903491f : sub == 10 ? 0.0031622776601683794f : sub == 11 ? 0.001778279410038923f
            : sub == 12 ? 0.001f : sub == 13 ? 0.0005623413251903491f : sub == 14 ? 0.00031622776601683794f : 0.0001778279410038923f;
        const float ang = (float)s * inv_freq; double rev = (double)ang * 0.15915494309189535; rev -= floor(rev); const float rf = (float)rev;
        RT[2 * id] = __builtin_amdgcn_cosf(rf); RT[2 * id + 1] = __builtin_amdgcn_sinf(rf); } }
}
__device__ __forceinline__ void ph_modreduce(const Frame& F, const Args& a) {
    unsigned char* const ws = WSP(F);
    const float* modp = (const float*)(ws + WS_MODP); float* mod = (float*)(ws + WS_MOD); const float* ada_b = P(F, 3);
    for (int idx = F.vcu * NTHR + F.tid; idx < 2 * 2 * 6144; idx += F.G * NTHR) {
        const int l = idx / 12288, r = idx % 12288, col = r % 6144;
        float s = ada_b[l * 6144 + col];
#pragma unroll
        for (int ks = 0; ks < 16; ++ks) s += modp[(size_t)(l * 16 + ks) * 12288 + r];
        mod[idx] = s;
    }
}
__device__ __forceinline__ void norm_row_load(const void* xbase, size_t row, bool isbf, int lane, f32x4 (&v)[4]) {
    if (isbf) { const GAS v2u* xr = (const GAS v2u*)((const bf16*)xbase + row * DM) + lane;
#pragma unroll
        for (int j = 0; j < 4; ++j) { const v2u w = xr[64 * j]; v[j] = (f32x4){bflo(w.x), bfhi(w.x), bflo(w.y), bfhi(w.y)}; } }
    else { const GAS f32x4* xr = (const GAS f32x4*)((const float*)xbase + row * DM) + lane;
#pragma unroll
        for (int j = 0; j < 4; ++j) v[j] = xr[64 * j]; }
}
template <bool STORE = true> __device__ __forceinline__ void norm_mod_apply(const f32x4 (&v)[4], bf16* hrow, const float* sh, const float* sc, int lane, f32x4 (&hv)[4]) {
    float s = 0.f;
#pragma unroll
    for (int j = 0; j < 4; ++j) s += (v[j].x * v[j].x + v[j].y * v[j].y) + (v[j].z * v[j].z + v[j].w * v[j].w);
    const float rstd = rsq_f(wave_sum(s) * (1.f / 1024.f) + EPS);
    GAS v2u* o8 = (GAS v2u*)hrow + lane;
#pragma unroll
    for (int j = 0; j < 4; ++j) { const f32x4 s4 = ((const GAS f32x4*)sh)[lane + 64 * j], c4 = ((const GAS f32x4*)sc)[lane + 64 * j];
        const f32x4 h = v[j] * rstd * (c4 + 1.0f) + s4; hv[j] = h; if (STORE) { v2u w; w.x = pk2(h.x, h.y); w.y = pk2(h.z, h.w); o8[64 * j] = w; } }
}
__device__ __forceinline__ void ph_normmod(const Frame& F, const Args& a, const void* src, bool isbf, int l, int which  ) {
    unsigned char* const ws = WSP(F);
    const float* mod = (const float*)(ws + WS_MOD) + (size_t)l * 12288; bf16* H = (bf16*)(ws + WS_H);
    const int lane = F.lane, m0 = F.gw, st = F.NGW;
    f32x4 va[4], vb[4], vc[4];
    if (m0 < T) norm_row_load(src, (size_t)m0, isbf, lane, va);
    if (m0 + st < T) norm_row_load(src, (size_t)(m0 + st), isbf, lane, vb);
#pragma unroll 1
    for (int m = m0; m < T; m += st) { const int b = m / SEQ; f32x4 hv[4];
        if (m + 2 * st < T) norm_row_load(src, (size_t)(m + 2 * st), isbf, lane, vc);
        norm_mod_apply(va, H + (size_t)m * DM, mod + b * 6144 + which * 3072, mod + b * 6144 + which * 3072 + 1024, lane, hv);
#pragma unroll
        for (int j = 0; j < 4; ++j) { va[j] = vb[j]; vb[j] = vc[j]; } }
}

__device__ __forceinline__ void ph_mla(const Frame& F, const Args& a, int l) {
    unsigned char* const ws = WSP(F);
    const bf16* U = (const bf16*)(ws + WS_U); bf16* Qb = (bf16*)(ws + WS_Q); bf16* Kb = (bf16*)(ws + WS_K); bf16* Vb = (bf16*)(ws + WS_V); const float* RT = (const float*)(ws + WS_ROPE);
    LAS float* rs = (LAS float*)(F.lds + RING_BYTES + 4096);
    pg8::StaticOrder S; S.init(T, 512, F.G, (int)blockIdx.x);
    for (int ui = 0; ; ++ui) {
        pg8::Unit u; if (!S.next(ui, u)) break;
        { const int r = F.tid >> 1, hf = F.tid & 1, row = u.pm * 256 + r, b = row / SEQ, s = row % SEQ; const bf16* ur = U + (size_t)row * D_INP;
          if (hf == 0) { rs[r] = rsq_f(((const float*)(ws + WS_RQ))[row] * (1.f / 256.f) + EPS); rs[256 + r] = rsq_f(((const float*)(ws + WS_RKV))[row] * (1.f / 128.f) + EPS); }
          const v4u wa = *(const v4u*)(ur + U_KR + hf * 8), wb = *(const v4u*)(ur + U_KR + 16 + hf * 8);
          float t1[8] = {bflo(wa.x), bfhi(wa.x), bflo(wa.y), bfhi(wa.y), bflo(wa.z), bfhi(wa.z), bflo(wa.w), bfhi(wa.w)}, t2[8] = {bflo(wb.x), bfhi(wb.x), bflo(wb.y), bfhi(wb.y), bflo(wb.z), bfhi(wb.z), bflo(wb.w), bfhi(wb.w)};
          float o1[8], o2[8];
          f32x4 tb[4];
#pragma unroll
          for (int q = 0; q < 4; ++q) tb[q] = *(const f32x4*)(RT + ((size_t)s * 16 + hf * 8) * 2 + 4 * q);
#pragma unroll
          for (int j = 0; j < 8; ++j) { const float cc = tb[j >> 1][(j & 1) * 2], sn = tb[j >> 1][(j & 1) * 2 + 1]; o1[j] = t1[j] * cc - t2[j] * sn; o2[j] = t2[j] * cc + t1[j] * sn; }
          v4u p1, p2; p1.x = pk2(o1[0], o1[1]); p1.y = pk2(o1[2], o1[3]); p1.z = pk2(o1[4], o1[5]); p1.w = pk2(o1[6], o1[7]); p2.x = pk2(o2[0], o2[1]); p2.y = pk2(o2[2], o2[3]); p2.z = pk2(o2[4], o2[5]); p2.w = pk2(o2[6], o2[7]);
#pragma unroll
          for (int h = 0; h < 4; ++h) { bf16* kp = Kb + ((size_t)(b * 4 + h) * SEQ + s) * 96 + 64 + hf * 8; *(v4u*)kp = p1; *(v4u*)(kp + 16) = p2; } }
        __syncthreads();
        if (ui > 0) break;
    }
    { pg8::Gemm g{U + U_CQ, (const bf16*)(ws + WS_WQ) + (size_t)l * 512 * 256, D_INP, 256};
      pg8::EpiMlaQ E{Qb, rs, RT, QSCALE, SEQ}; const Frame F2 = reframe(F);
      pg8::gemm_phase<pg8::EpiMlaQ, pg8::StaticOrder, true>(F2.lds, F2.tid, g, S, E); }
    { pg8::Gemm g{U + U_CKV, (const bf16*)(ws + WS_WKV) + (size_t)l * 512 * 128, D_INP, 128};
      pg8::EpiMlaKV E{Kb, Vb, rs, SEQ}; const Frame F3 = reframe(F);
      pg8::gemm_phase<pg8::EpiMlaKV, pg8::StaticOrder, true>(F3.lds, F3.tid, g, S, E); }
    __syncthreads();
}
__device__ __forceinline__ void ph_mla_prep_naive(const Frame& F, const Args& a, int l) {
    unsigned char* const ws = WSP(F);
    LAS float* xq = (LAS float*)F.lds;
    LAS float* xkv = xq + 32 * 256;
    LAS float* kr = xkv + 32 * 128;
    LAS float* cs = kr + 32 * 32;
    LAS float* qr = cs + 32 * 32;
    const bf16* U = (const bf16*)(ws + WS_U);
    bf16* Qb = (bf16*)(ws + WS_Q); bf16* Kb = (bf16*)(ws + WS_K); bf16* Vb = (bf16*)(ws + WS_V);
    const float* qn = P(F, 5) + l * 256; const float* wuq = P(F, 6) + (size_t)l * 256 * 384;
    const float* kvn = P(F, 7) + l * 128; const float* wukv = P(F, 8) + (size_t)l * 128 * 512;
    const int tid = F.tid;
    for (int blk = F.vcu; blk < T / 32; blk += F.G) {
        const int row0 = blk * 32, b = row0 / SEQ, s0 = row0 % SEQ;
        { const int r = tid >> 4, sub = tid & 15; const bf16* ur = U + (size_t)(row0 + r) * D_INP;
          float q[16]; float ss = 0.f;
#pragma unroll
          for (int i = 0; i < 16; ++i) { q[i] = bf2f(ur[U_CQ + sub * 16 + i]); ss += q[i] * q[i]; }
          ss = sum16(ss); float rs = rsq_f(ss * (1.f / 256.f) + EPS);
#pragma unroll
          for (int i = 0; i < 16; ++i) xq[r * 256 + sub * 16 + i] = q[i] * rs * qn[sub * 16 + i];
          float kv[8]; ss = 0.f;
#pragma unroll
          for (int i = 0; i < 8; ++i) { kv[i] = bf2f(ur[U_CKV + sub * 8 + i]); ss += kv[i] * kv[i]; }
          ss = sum16(ss); rs = rsq_f(ss * (1.f / 128.f) + EPS);
#pragma unroll
          for (int i = 0; i < 8; ++i) xkv[r * 128 + sub * 8 + i] = kv[i] * rs * kvn[sub * 8 + i];
          kr[r * 32 + sub * 2] = bf2f(ur[U_KR + sub * 2]); kr[r * 32 + sub * 2 + 1] = bf2f(ur[U_KR + sub * 2 + 1]);
          const float inv_freq = sub == 0 ? 1.0f : sub == 1 ? 0.5623413251903491f : sub == 2 ? 0.31622776601683794f : sub == 3 ? 0.1778279410038923f : sub == 4 ? 0.1f : sub == 5 ? 0.05623413251903491f
              : sub == 6 ? 0.031622776601683794f : sub == 7 ? 0.01778279410038923f : sub == 8 ? 0.01f : sub == 9 ? 0.005623413251903491f : sub == 10 ? 0.0031622776601683794f : sub == 11 ? 0.001778279410038923f
              : sub == 12 ? 0.001f : sub == 13 ? 0.0005623413251903491f : sub == 14 ? 0.00031622776601683794f : 0.0001778279410038923f;
          const float ang = (float)(s0 + r) * inv_freq;
          double rev = (double)ang * 0.15915494309189535; rev -= floor(rev); const float rf = (float)rev;
          cs[r * 32 + sub * 2] = __builtin_amdgcn_cosf(rf); cs[r * 32 + sub * 2 + 1] = __builtin_amdgcn_sinf(rf); }
        __syncthreads();
        float acc[32];
        if (tid < 384) {
#pragma unroll
            for (int r = 0; r < 32; ++r) acc[r] = 0.f;
            for (int k = 0; k < 256; k += 4) { const float w0 = wuq[(size_t)k * 384 + tid], w1 = wuq[(size_t)(k + 1) * 384 + tid], w2 = wuq[(size_t)(k + 2) * 384 + tid], w3 = wuq[(size_t)(k + 3) * 384 + tid];
#pragma unroll
                for (int r = 0; r < 32; ++r) { const f32x4 x4 = *(const LAS f32x4*)(xq + r * 256 + k); acc[r] += x4.x * w0 + x4.y * w1 + x4.z * w2 + x4.w * w3; } }
            const int h = tid / 96, d = tid % 96;
            if (d < 64) {
#pragma unroll
                for (int r = 0; r < 32; ++r) Qb[((size_t)(b * 4 + h) * SEQ + s0 + r) * 96 + d] = (bf16)f2bf(acc[r] * QSCALE);
            } else {
#pragma unroll
                for (int r = 0; r < 32; ++r) qr[r * 128 + h * 32 + (d - 64)] = acc[r];
            }
        }
        {
#pragma unroll
            for (int r = 0; r < 32; ++r) acc[r] = 0.f;
            for (int k = 0; k < 128; k += 4) { const float w0 = wukv[(size_t)k * 512 + tid], w1 = wukv[(size_t)(k + 1) * 512 + tid], w2 = wukv[(size_t)(k + 2) * 512 + tid], w3 = wukv[(size_t)(k + 3) * 512 + tid];
#pragma unroll
                for (int r = 0; r < 32; ++r) { const f32x4 x4 = *(const LAS f32x4*)(xkv + r * 128 + k); acc[r] += x4.x * w0 + x4.y * w1 + x4.z * w2 + x4.w * w3; } }
            const int h = tid / 128, d = tid % 128;
            if (d < 64) {
#pragma unroll
                for (int r = 0; r < 32; ++r) Kb[((size_t)(b * 4 + h) * SEQ + s0 + r) * 96 + d] = (bf16)f2bf(acc[r]);
            } else {
#pragma unroll
                for (int r = 0; r < 32; ++r) Vb[((size_t)(b * 4 + h) * SEQ + s0 + r) * 64 + (d - 64)] = (bf16)f2bf(acc[r]);
            }
        }
        __syncthreads();
        for (int p = tid; p < 2048; p += NTHR) { const int r = p >> 6, h = (p >> 4) & 3, i = p & 15;
            const float t1 = qr[r * 128 + h * 32 + i], t2 = qr[r * 128 + h * 32 + i + 16], cc = cs[r * 32 + 2 * i], sn = cs[r * 32 + 2 * i + 1];
            bf16* qp = Qb + ((size_t)(b * 4 + h) * SEQ + s0 + r) * 96 + 64;
            qp[i] = (bf16)f2bf((t1 * cc - t2 * sn) * QSCALE); qp[i + 16] = (bf16)f2bf((t2 * cc + t1 * sn) * QSCALE); }
        { const int r = tid >> 4, i = tid & 15; const float t1 = kr[r * 32 + i], t2 = kr[r * 32 + i + 16], cc = cs[r * 32 + 2 * i], sn = cs[r * 32 + 2 * i + 1];
          const bf16 k1 = (bf16)f2bf(t1 * cc - t2 * sn), k2 = (bf16)f2bf(t2 * cc + t1 * sn);
#pragma unroll
          for (int h = 0; h < 4; ++h) { bf16* kp = Kb + ((size_t)(b * 4 + h) * SEQ + s0 + r) * 96 + 64; kp[i] = k1; kp[i + 16] = k2; } }
        __syncthreads();
    }
}
__device__ __forceinline__ f32x4 conv4_silu(const bf16* U, int m, int s, int ucol, int c, const float* cw  , const float* cb) {
    f32x4 acc = *(const f32x4*)(cb + c);
#pragma unroll
    for (int j = 0; j < 4; ++j) { const int ds = 3 - j; if (s - ds >= 0) { const v2u w = *(const v2u*)(U + (size_t)(m - ds) * D_INP + ucol + c);
            const f32x4 wv = *(const f32x4*)(cw + j * 768 + c);
            acc.x += wv.x * bflo(w.x); acc.y += wv.y * bfhi(w.x); acc.z += wv.z * bflo(w.y); acc.w += wv.w * bfhi(w.y); } }
    acc.x = silu_f(acc.x); acc.y = silu_f(acc.y); acc.z = silu_f(acc.z); acc.w = silu_f(acc.w);
    return acc;
}
constexpr size_t GF_UNIT = 40960;
__device__ __forceinline__ int gfrag_off(int row, int col) { return ((((row >> 4) * 2 + (col >> 5)) * 64 + (((col & 15) >> 2) * 16) + (row & 15)) * 8) + ((col & 31) >> 4) * 4 + (col & 3); }
__device__ __forceinline__ constexpr int gf_rp_r(int row) { return ((row >> 4) * 128 + (row & 15)) * 8; }
__device__ __forceinline__ constexpr int gf_lp_c(int col) { return ((col >> 5) * 64 + ((col & 15) >> 2) * 16) * 8 + ((col & 31) >> 4) * 4 + (col & 3); }
typedef float f32x16 __attribute__((ext_vector_type(16)));
__device__ __forceinline__ int crow16(int r, int hi) { return (r & 3) + 8 * (r >> 2) + 4 * hi; }

__device__ __forceinline__ void ph_gdn_prep(const Frame& F, const Args& a, int l) {
    unsigned char* const ws = WSP(F);
    const bf16* U = (const bf16*)(ws + WS_U); unsigned char* GF = ws + WS_GF; float* GL = (float*)(ws + WS_BG);
    const float* gcw = P(F, 15) + (size_t)l * 4 * 768; const float* gcb = P(F, 16) + l * 768; const float* gdtb = P(F, 17) + l * 4; const float* galog = P(F, 18) + l * 4;
    LAS unsigned char* Kc = F.lds + F.wave * 16384;
    LAS unsigned char* Qc = Kc + 8192;
    LAS float* sm = (LAS float*)(F.lds + RING_BYTES + 4096 + F.wave * 1024);
    LAS float* bet = sm; LAS float* gcs = sm + 64; LAS float* tmp = sm + 128;
    for (int unit = F.gw; unit < BATCH * 4 * (SEQ / 64); unit += F.NGW) {
        int lane = F.lane; asm volatile("" : "+v"(lane));
        const int r32 = lane & 31, hi = lane >> 5, fn = lane & 15, fg = lane >> 4;
        const int bh = unit / (SEQ / 64), c = unit % (SEQ / 64), b = bh >> 2, h = bh & 3; const int m0 = b * SEQ + c * 64;
        bf16* KCp = (bf16*)(GF + (size_t)unit * GF_UNIT);
        bf16* fragp = KCp + lane * 8; asm volatile("" : "+v"(fragp));
        { const bf16* ur = U + (size_t)(m0 + lane) * D_INP; const float bb = bf2f(ur[U_GB + h]), aa = bf2f(ur[U_GA + h]);
          const float g = -exp_f(galog[h]) * softplus_f(aa + gdtb[h]);
          bet[lane] = sigmoid_f(bb); tmp[lane] = g; LDS_WAIT(); asm volatile("" ::: "memory");
          float gc = 0.f;
#pragma unroll 8
          for (int j = 0; j < 64; ++j) { const float gj = tmp[j]; gc += (j <= lane) ? gj : 0.f; }
          gcs[lane] = gc; LDS_WAIT(); asm volatile("" ::: "memory"); }
        const float gc63 = gcs[63];
        if (lane == 0) GL[unit] = exp_f(gc63);
#define GDN_CONV(x, chan) do { const int ch_ = (chan); const float c0_ = gcw[ch_], c1_ = gcw[768 + ch_], c2_ = gcw[2 * 768 + ch_], c3_ = gcw[3 * 768 + ch_], cb_ = gcb[ch_]; \
            const bf16* ub_ = U + (size_t)m0 * D_INP + U_GQKV; float h0_ = 0.f, h1_ = 0.f, h2_ = 0.f;        \
            _Pragma("unroll") for (int i_ = 63; i_ >= 0; --i_) x[i_] = bf2f((ub_ + (size_t)i_ * D_INP)[ch_]);        \
            if (c > 0) { h2_ = bf2f((ub_ - 1 * D_INP)[ch_]); h1_ = bf2f((ub_ - 2 * D_INP)[ch_]); h0_ = bf2f((ub_ - 3 * D_INP)[ch_]); } \
            _Pragma("unroll") for (int i_ = 63; i_ >= 0; --i_) { const float a_ = (i_ >= 3) ? x[i_ - 3] : (i_ == 2 ? h2_ : i_ == 1 ? h1_ : h0_), b_ = (i_ >= 2) ? x[i_ - 2] : (i_ == 1 ? h2_ : h1_), d_ = (i_ >= 1) ? x[i_ - 1] : h2_; \
                x[i_] = silu_f(cb_ + c0_ * a_ + c1_ * b_ + c2_ * d_ + c3_ * x[i_]); } } while (0)
#define GDN_ROWNORM(img, scale, rn) do { const LAS unsigned char* rp_ = (img) + lane * 16; float ss_ = 0.f; bf16x8 v_[8]; \
            _Pragma("unroll") for (int ck_ = 0; ck_ < 8; ++ck_) { v_[ck_] = *(const LAS bf16x8*)(rp_ + ck_ * 1024); _Pragma("unroll") for (int e_ = 0; e_ < 8; ++e_) { const float t_ = bf2f((unsigned short)v_[ck_][e_]); ss_ += t_ * t_; } } \
            rn = rsq_f(ss_ + EPS) * (scale); \
            _Pragma("unroll") for (int ck_ = 0; ck_ < 8; ++ck_) { v4u o_; \
                o_.x = pk2(bf2f((unsigned short)v_[ck_][0]) * rn, bf2f((unsigned short)v_[ck_][1]) * rn); o_.y = pk2(bf2f((unsigned short)v_[ck_][2]) * rn, bf2f((unsigned short)v_[ck_][3]) * rn); \
                o_.z = pk2(bf2f((unsigned short)v_[ck_][4]) * rn, bf2f((unsigned short)v_[ck_][5]) * rn); o_.w = pk2(bf2f((unsigned short)v_[ck_][6]) * rn, bf2f((unsigned short)v_[ck_][7]) * rn); \
                *(LAS v4u*)((img) + lane * 16 + ck_ * 1024) = o_; } } while (0)
        { float x[64]; GDN_CONV(x, h * 64 + lane);
          { LAS bf16* qw = (LAS bf16*)(Qc + (lane >> 3) * 1024 + (lane & 7) * 2); asm volatile("" : "+v"(qw));
#pragma unroll
            for (int i = 0; i < 64; ++i) qw[i * 8] = (bf16)f2bf(x[i]); }
          LDS_WAIT(); asm volatile("" ::: "memory");
          float rn; GDN_ROWNORM(Qc, 0.125f, rn); (void)rn;
          LDS_WAIT(); asm volatile("" ::: "memory"); }
        const float gcj0 = gcs[r32], gcj1 = gcs[32 + r32];
#pragma unroll 1
        for (int half = 0; half < 2; ++half) {
            LAS float* gcs_l = gcs; LAS float* bet_l = bet; asm volatile("" : "+v"(gcs_l), "+v"(bet_l));
            float w[64];
            GDN_CONV(w, (1 + half) * 256 + h * 64 + lane);
            if (half == 0) {
                { LAS bf16* kw = (LAS bf16*)(Kc + (lane >> 3) * 1024 + (lane & 7) * 2); asm volatile("" : "+v"(kw));
#pragma unroll
                  for (int i = 0; i < 64; ++i) kw[i * 8] = (bf16)f2bf(w[i]); }
                LDS_WAIT(); asm volatile("" ::: "memory");
                float rnk; GDN_ROWNORM(Kc, 1.0f, rnk);
                tmp[lane] = bet_l[lane] * exp_f(gcs_l[lane]) * rnk;
                LDS_WAIT(); asm volatile("" ::: "memory");
                { LAS float* tp = tmp; asm volatile("" : "+v"(tp));
#pragma unroll
                  for (int i = 0; i < 64; ++i) w[i] *= tp[i]; }
            } else {
#pragma unroll
                for (int i = 0; i < 64; ++i) w[i] *= bet_l[i];
            }
            if (half == 0) {
                LDS_WAIT(); asm volatile("" ::: "memory");
                bf16* fqd = fragp + 4096; bf16* fkt = fragp + 12288;
#pragma unroll
                for (int f = 0; f < 8; ++f) { const int mt = f >> 1, ks = f & 1; asm volatile("" : "+v"(fqd), "+v"(fkt));
                    { const int row = 16 * mt + fn; const float e = exp_f(gcs_l[row]); const LAS unsigned char* qp = Qc + (4 * ks + (fg >> 1)) * 1024 + row * 16 + (fg & 1) * 8;
                      const v2u lo = *(const LAS v2u*)qp, hh2 = *(const LAS v2u*)(qp + 2048);
                      v4u o; o.x = pk2(bflo(lo.x) * e, bfhi(lo.x) * e); o.y = pk2(bflo(lo.y) * e, bfhi(lo.y) * e); o.z = pk2(bflo(hh2.x) * e, bfhi(hh2.x) * e); o.w = pk2(bflo(hh2.y) * e, bfhi(hh2.y) * e);
                      *(v4u*)fqd = o; fqd += 512; }
                    { const int ch = 16 * mt + fn, L0 = 32 * ks + 4 * fg; const LAS unsigned char* kp = Kc + (ch >> 3) * 1024 + (ch & 7) * 2 + L0 * 16;
                      const f32x4 ga = *(const LAS f32x4*)(gcs_l + L0), gb = *(const LAS f32x4*)(gcs_l + L0 + 16);
                      float v[8];
#pragma unroll
                      for (int j = 0; j < 4; ++j) { v[j] = bf2f(*(const LAS bf16*)(kp + j * 16)) * exp_f(gc63 - ga[j]); v[4 + j] = bf2f(*(const LAS bf16*)(kp + (16 + j) * 16)) * exp_f(gc63 - gb[j]); }
                      v4u o; o.x = pk2(v[0], v[1]); o.y = pk2(v[2], v[3]); o.z = pk2(v[4], v[5]); o.w = pk2(v[6], v[7]);
                      *(v4u*)fkt = o; fkt += 512; } }
#pragma unroll
                for (int which = 0; which < 2; ++which) {
                    const LAS unsigned char* Am = which ? Kc : Qc; f32x16 acc[3];
#pragma unroll
                    for (int t = 0; t < 3; ++t) { const int it = (t + 1) >> 1, jt = t >> 1; acc[t] = f32x16{};
#pragma unroll
                        for (int d0 = 0; d0 < 4; ++d0) { const bf16x8 af = *(const LAS bf16x8*)(Am + (2 * d0 + hi) * 1024 + (32 * it + r32) * 16), bfr = *(const LAS bf16x8*)(Kc + (2 * d0 + hi) * 1024 + (32 * jt + r32) * 16);
                            acc[t] = __builtin_amdgcn_mfma_f32_32x32x16_bf16(af, bfr, acc[t], 0, 0, 0); } }
                    LDS_WAIT(); asm volatile("" ::: "memory");
                    {
                        LAS bf16* dst = (LAS bf16*)(which ? Kc : Qc) + 4 * hi * 64 + r32; LAS float* gr = gcs_l + 4 * hi; LAS float* br = bet_l + 4 * hi; int dd = r32 - 4 * hi;
                        asm volatile("" : "+v"(dst), "+v"(gr), "+v"(br), "+v"(dd));
#pragma unroll
                        for (int t = 0; t < 3; ++t) { const int it = (t + 1) >> 1, jt = t >> 1; const float gcj = jt ? gcj1 : gcj0;
#pragma unroll
                            for (int r = 0; r < 16; ++r) { const int c0 = crow16(r, 0), i0 = 32 * it + c0; const float dec = exp_f(gr[i0] - gcj);
                                const bool keep = (it != jt) || (which ? (c0 > dd) : (c0 >= dd));
                                const float v = which ? br[i0] * acc[t][r] * dec : acc[t][r] * dec;
                                dst[i0 * 64 + 32 * jt] = (bf16)(keep ? f2bf(v) : 0u); } }
                        if (which == 0) {
#pragma unroll
                            for (int r = 0; r < 16; ++r) dst[crow16(r, 0) * 64 + 32] = (bf16)0; }
                    }
                }
                LDS_WAIT(); asm volatile("" ::: "memory");
                { bf16* fqk = fragp + 8192;
#pragma unroll
                for (int f = 0; f < 8; ++f) { const int mt = f >> 1, ks = f & 1; const LAS unsigned char* sp = Qc + ((16 * mt + fn) * 64 + 32 * ks + 4 * fg) * 2; asm volatile("" : "+v"(fqk));
                    const v2u lo = *(const LAS v2u*)sp, hh2 = *(const LAS v2u*)(sp + 32); v4u o; o.x = lo.x; o.y = lo.y; o.z = hh2.x; o.w = hh2.y; *(v4u*)fqk = o; fqk += 512; } }
                LDS_WAIT(); asm volatile("" ::: "memory");
            }
            { unsigned wp[32];
#pragma unroll
              for (int i = 1; i < 64; ++i) { float s0 = 0.f, s1 = 0.f;
                if ((i & 1) == 1) wp[i >> 1] = pk2(w[i - 1], 0.f);
#pragma unroll
                for (int j = 0; j < i; j += 4) { const v2u a2 = *(const LAS v2u*)(Kc + (i * 64 + j) * 2); float& s = ((j >> 2) & 1) ? s1 : s0;
                    const unsigned ax = a2.x, ay = a2.y;
                    s = __builtin_amdgcn_fdot2_f32_bf16(__builtin_bit_cast(pk_b2v, ax), __builtin_bit_cast(pk_b2v, wp[j >> 1]), s, false);
                    if (j + 2 < i) s = __builtin_amdgcn_fdot2_f32_bf16(__builtin_bit_cast(pk_b2v, ay), __builtin_bit_cast(pk_b2v, wp[(j >> 1) + 1]), s, false); }
                w[i] -= s0 + s1;
                if ((i & 1) == 1) wp[i >> 1] = pk2(w[i - 1], w[i]);
                if ((i & 7) == 7) __builtin_amdgcn_sched_barrier(0); } }
            { LAS bf16* stw = (LAS bf16*)Qc + lane; asm volatile("" : "+v"(stw));
#pragma unroll
              for (int i = 0; i < 64; ++i) stw[i * 64] = (bf16)f2bf(half == 0 ? -w[i] : w[i]); }
            LDS_WAIT(); asm volatile("" ::: "memory");
            if (half == 0) {
                bf16* fkc = fragp;
#pragma unroll
                for (int f = 0; f < 8; ++f) { const int mt = f >> 1, ks = f & 1; const LAS unsigned char* sp = Qc + ((16 * mt + fn) * 64 + 32 * ks + 4 * fg) * 2; asm volatile("" : "+v"(fkc));
                    const v2u lo = *(const LAS v2u*)sp, hh2 = *(const LAS v2u*)(sp + 32); v4u o; o.x = lo.x; o.y = lo.y; o.z = hh2.x; o.w = hh2.y; *(v4u*)fkc = o; fkc += 512; }
            } else {
                bf16* uvp = KCp + 16384 + lane * 4; asm volatile("" : "+v"(uvp));
#pragma unroll
                for (int q = 0; q < 16; ++q) { const int vs = q >> 2, mt = q & 3; const LAS bf16* sp = (const LAS bf16*)Qc + (16 * mt + 4 * fg) * 64 + 16 * vs + fn; asm volatile("" : "+v"(uvp));
                    v2u o; o.x = (unsigned)sp[0] | ((unsigned)sp[64] << 16); o.y = (unsigned)sp[128] | ((unsigned)sp[192] << 16); *(v2u*)uvp = o; uvp += 256; }
            }
            LDS_WAIT(); asm volatile("" ::: "memory");
        }
    }
}
__device__ __forceinline__ void gdn_chain(const Frame& F, int bh) {
    typedef float f4 __attribute__((ext_vector_type(4)));
    unsigned char* const ws = WSP(F);
    const unsigned char* GF = ws + WS_GF; const float* GL = (const float*)(ws + WS_BG); float* OR = (float*)(ws + WS_OR);
    const int lane = F.lane, n = lane & 15, g = lane >> 4, b = bh >> 2, h = bh & 3, vs = F.wave & 3; const bool comp = F.wave < 4;
    constexpr int NC = SEQ / 64, SLOT = 40960;
    const char* ub = (const char*)GF + (size_t)bh * NC * GF_UNIT + (size_t)F.wave * 5120;
    const unsigned lds0 = (unsigned)(uintptr_t)F.lds, ldw = lds0 + F.wave * 5120;
#define GDN_DMA(cc) do { const int cu_ = (cc) < NC ? (cc) : NC - 1; const unsigned sl_ = ldw + ((cc) % 3) * SLOT; const char* src_ = ub + (size_t)cu_ * GF_UNIT; \
        _Pragma("unroll") for (int i_ = 0; i_ < 5; ++i_) pg8::glds_sv_t<0>(src_ + i_ * 1024, (unsigned)lane * 16u, (unsigned)__builtin_amdgcn_readfirstlane(sl_ + i_ * 1024)); } while (0)
    LAS float* gls = (LAS float*)(F.lds + 3 * SLOT);
    if (F.tid < NC) gls[F.tid] = GL[bh * NC + F.tid];
    asm volatile("s_waitcnt vmcnt(0) lgkmcnt(0)\n\ts_barrier" ::: "memory");
    GDN_DMA(0); GDN_DMA(1);
    asm volatile("s_waitcnt vmcnt(5)" ::: "memory");
    f4 S[4];
#pragma unroll
    for (int mt = 0; mt < 4; ++mt) S[mt] = (f4){0.f, 0.f, 0.f, 0.f};
    for (int c = 0; c < NC; ++c) {
        if (comp) asm volatile("s_waitcnt vmcnt(21) lgkmcnt(0)\n\ts_barrier" ::: "memory"); else asm volatile("s_waitcnt vmcnt(5) lgkmcnt(0)\n\ts_barrier" ::: "memory");
        GDN_DMA(c + 2);
        if (comp) {
            const LAS unsigned char* sl = F.lds + (c % 3) * SLOT + lane * 16;
            const float gl = gls[c];
#define GDN_FR(moff, f) (*(const LAS bf16x8*)(sl + (moff) + (f) * 1024))
            bf16x8 sf[2], vf[2]; f4 vn[4], o[4];
#pragma unroll
            for (int ks = 0; ks < 2; ++ks) { v4u w; w.x = pk2(S[2 * ks][0], S[2 * ks][1]); w.y = pk2(S[2 * ks][2], S[2 * ks][3]); w.z = pk2(S[2 * ks + 1][0], S[2 * ks + 1][1]); w.w = pk2(S[2 * ks + 1][2], S[2 * ks + 1][3]); sf[ks] = __builtin_bit_cast(bf16x8, w); }
#pragma unroll
            for (int mt = 0; mt < 4; ++mt) { const v2u uv = *(const LAS v2u*)(F.lds + (c % 3) * SLOT + 32768 + ((vs * 4 + mt) * 64 + lane) * 8);
                vn[mt] = (f4){bflo(uv.x), bfhi(uv.x), bflo(uv.y), bfhi(uv.y)}; o[mt] = (f4){0.f, 0.f, 0.f, 0.f}; }
            bf16x8 fa[8], fb[8];
#pragma unroll
            for (int f = 0; f < 8; ++f) fa[f] = GDN_FR(0, f);
#pragma unroll
            for (int f = 0; f < 8; ++f) fb[f] = GDN_FR(8192, f);
#pragma unroll
            for (int mt = 0; mt < 4; ++mt)
#pragma unroll
                for (int ks = 0; ks < 2; ++ks) vn[mt] = __builtin_amdgcn_mfma_f32_16x16x32_bf16(fa[mt * 2 + ks], sf[ks], vn[mt], 0, 0, 0);
#pragma unroll
            for (int f = 0; f < 8; ++f) fa[f] = GDN_FR(24576, f);
#pragma unroll
            for (int mt = 0; mt < 4; ++mt)
#pragma unroll
                for (int ks = 0; ks < 2; ++ks) o[mt] = __builtin_amdgcn_mfma_f32_16x16x32_bf16(fb[mt * 2 + ks], sf[ks], o[mt], 0, 0, 0);
#pragma unroll
            for (int f = 0; f < 8; ++f) fb[f] = GDN_FR(16384, f);
#pragma unroll
            for (int ks = 0; ks < 2; ++ks) { v4u w; w.x = pk2(vn[2 * ks][0], vn[2 * ks][1]); w.y = pk2(vn[2 * ks][2], vn[2 * ks][3]); w.z = pk2(vn[2 * ks + 1][0], vn[2 * ks + 1][1]); w.w = pk2(vn[2 * ks + 1][2], vn[2 * ks + 1][3]); vf[ks] = __builtin_bit_cast(bf16x8, w); }
#pragma unroll
            for (int mt = 0; mt < 4; ++mt) { S[mt] = S[mt] * gl;
#pragma unroll
                for (int ks = 0; ks < 2; ++ks) S[mt] = __builtin_amdgcn_mfma_f32_16x16x32_bf16(fa[mt * 2 + ks], vf[ks], S[mt], 0, 0, 0); }
#pragma unroll
            for (int mt = 0; mt < 4; ++mt)
#pragma unroll
                for (int ks = 0; ks < 2; ++ks) o[mt] = __builtin_amdgcn_mfma_f32_16x16x32_bf16(fb[mt * 2 + ks], vf[ks], o[mt], 0, 0, 0);
            { float* op = OR + ((size_t)b * SEQ + c * 64 + 4 * g) * 256 + h * 64 + vs * 16 + n;
#pragma unroll
              for (int mt = 0; mt < 4; ++mt)
#pragma unroll
                  for (int i = 0; i < 4; ++i) op[(size_t)(mt * 16 + i) * 256] = o[mt][i]; }
#undef GDN_FR
        }
    }
    asm volatile("s_waitcnt vmcnt(0) lgkmcnt(0)\n\ts_barrier" ::: "memory");
#undef GDN_DMA
}
__device__ __forceinline__ void ph_ssd_chunk(const Frame& F, const Args& a, int l) {
    unsigned char* const ws = WSP(F);
    const bf16* U = (const bf16*)(ws + WS_U); float* Y = (float*)(ws + WS_H); float* ST = (float*)(ws + WS_SST); float* EA = (float*)(ws + WS_DT); bf16* CS = (bf16*)(ws + WS_CS);
    const float* cw = P(F, 9) + (size_t)l * 4 * 768; const float* cb = P(F, 10) + l * 768; const float* dtb = P(F, 11) + l * 8;
    LAS float* Bs = (LAS float*)F.lds;
    LAS float* Cs = Bs + 2 * 128 * 64;
    LAS float* dts = (LAS float*)(F.lds + RING_BYTES + 4096);
    const int lane = F.lane, h = F.wave;
    for (int unit = F.vcu; unit < BATCH * (SEQ / 128); unit += F.G) {
        const int b = unit / (SEQ / 128), c = unit % (SEQ / 128); const int m0 = b * SEQ + c * 128, s0 = c * 128;
        for (int qd = F.tid; qd < 128 * 64; qd += NTHR) { const int r = qd >> 6, cc = (qd & 63) * 4;
            const f32x4 v = conv4_silu(U, m0 + r, s0 + r, U_XBC, 512 + cc, cw, cb);
            const int which = cc >> 7, g = (cc >> 6) & 1, n = cc & 63;
            *(LAS f32x4*)((which ? Cs : Bs) + (g * 128 + r) * 64 + n) = v;
            if (which) { v2u w; w.x = pk2(v.x, v.y); w.y = pk2(v.z, v.w); *(v2u*)(CS + (size_t)(m0 + r) * 128 + (cc - 128)) = w; } }
        for (int i = F.tid; i < 8 * 128; i += NTHR) { const int hh = i >> 7, r = i & 127; dts[i] = softplus_f(bf2f(U[(size_t)(m0 + r) * D_INP + U_DT + hh]) + dtb[hh]); }
        __syncthreads();
        {
            const int ch = h * 64 + lane, g = h >> 2; const float A = -exp_f(P(F, 12)[l * 8 + h]), Dh = P(F, 13)[l * 8 + h];
            const float w0 = cw[ch], w1 = cw[768 + ch], w2 = cw[2 * 768 + ch], w3 = cw[3 * 768 + ch], bb = cb[ch];
            const bf16* up = U + (size_t)m0 * D_INP + U_XBC + ch;
            float x0 = 0.f, x1 = 0.f, x2 = 0.f;
            if (s0 > 0) { x0 = bf2f(up[-3 * D_INP]); x1 = bf2f(up[-2 * D_INP]); x2 = bf2f(up[-1 * D_INP]); }
            float hn[64];
#pragma unroll
            for (int n = 0; n < 64; ++n) hn[n] = 0.f;
            float acum = 0.f;
            const LAS float* Bg = Bs + g * 128 * 64; const LAS float* Cg = Cs + g * 128 * 64;
            for (int lb = 0; lb < 128; lb += 16) {
                float xr[16];
#pragma unroll
                for (int i = 0; i < 16; ++i) xr[i] = bf2f(up[(size_t)(lb + i) * D_INP]);
#pragma unroll
                for (int i = 0; i < 16; ++i) { const float xin = xr[i]; const int r = lb + i;
                    const float cv = bb + w0 * x0 + w1 * x1 + w2 * x2 + w3 * xin; x0 = x1; x1 = x2; x2 = xin;
                    const float xs = silu_f(cv), dtv = dts[h * 128 + r], da = dtv * A, dA = exp_f(da), coef = dtv * xs; acum += da; float y = 0.f;
#pragma unroll
                    for (int n = 0; n < 64; n += 4) { const f32x4 b4 = *(const LAS f32x4*)(Bg + r * 64 + n), c4 = *(const LAS f32x4*)(Cg + r * 64 + n);
                        hn[n] = hn[n] * dA + coef * b4.x; y += c4.x * hn[n]; hn[n + 1] = hn[n + 1] * dA + coef * b4.y; y += c4.y * hn[n + 1];
                        hn[n + 2] = hn[n + 2] * dA + coef * b4.z; y += c4.z * hn[n + 2]; hn[n + 3] = hn[n + 3] * dA + coef * b4.w; y += c4.w * hn[n + 3]; }
                    Y[(size_t)(m0 + r) * 512 + ch] = y + Dh * xs;
                    if (lane == 0) EA[(size_t)(m0 + r) * 8 + h] = exp_f(acum); }
            }
            float* sp = ST + ((size_t)(unit * 8 + h) * 64 + lane) * 64;
#pragma unroll
            for (int n = 0; n < 64; n += 4) *(f32x4*)(sp + n) = (f32x4){hn[n], hn[n + 1], hn[n + 2], hn[n + 3]};
        }
        __syncthreads();
    }
}
__device__ __forceinline__ void ph_ssd_scan(const Frame& F, const Args& a, bool dummy = false) {
    unsigned char* const ws = WSP(F);
    float* ST = (float*)(ws + (dummy ? WS_H : WS_SST)); const float* EA = (const float*)(ws + WS_DT);
    for (int id = F.vcu * NTHR + F.tid; id < BATCH * 8 * 4096; id += F.G * NTHR) {
        const int b = id / (8 * 4096), r = id % (8 * 4096), h = r / 4096, e = r % 4096;
        float* sp = ST + ((size_t)(b * 128) * 8 + h) * 4096 + e; const float* ep = EA + ((size_t)b * SEQ + 127) * 8 + h;
        float hp = 0.f;
        for (int c0 = 0; c0 < 128; c0 += 8) { float st[8], dc[8];
#pragma unroll
            for (int i = 0; i < 8; ++i) { st[i] = sp[(size_t)(c0 + i) * 8 * 4096]; dc[i] = ep[(size_t)(c0 + i) * 128 * 8]; }
#pragma unroll
            for (int i = 0; i < 8; ++i) { sp[(size_t)(c0 + i) * 8 * 4096] = hp; hp = hp * dc[i] + st[i]; } }
    }
}
__device__ __forceinline__ void ph_ssd_out(const Frame& F, const Args& a, int l) {
    unsigned char* const ws = WSP(F);
    const bf16* U = (const bf16*)(ws + WS_U); float* Y = (float*)(ws + WS_H); const float* ST = (const float*)(ws + WS_SST); const float* EA = (const float*)(ws + WS_DT);
    const bf16* CS = (const bf16*)(ws + WS_CS); bf16* O = (bf16*)(ws + WS_O); const float* nw = P(F, 14) + l * 512;
    LAS float* Cs = (LAS float*)F.lds;
    LAS float* ssq = Cs + 2 * 128 * 64;
    const int lane = F.lane, h = F.wave;
    for (int unit = F.vcu; unit < BATCH * (SEQ / 128); unit += F.G) {
        const int b = unit / (SEQ / 128), c = unit % (SEQ / 128); const int m0 = b * SEQ + c * 128;
        for (int qd = F.tid; qd < 128 * 32; qd += NTHR) { const int r = qd >> 5, cc = (qd & 31) * 4; const v2u w = *(const v2u*)(CS + (size_t)(m0 + r) * 128 + cc);
            *(LAS f32x4*)(Cs + ((cc >> 6) * 128 + r) * 64 + (cc & 63)) = (f32x4){bflo(w.x), bfhi(w.x), bflo(w.y), bfhi(w.y)}; }
        if (F.tid < 256) ssq[F.tid] = 0.f;
        __syncthreads();
        {
            const int ch = h * 64 + lane, g = h >> 2; float pv[64];
            const float* sp = ST + ((size_t)(unit * 8 + h) * 64 + lane) * 64;
#pragma unroll
            for (int n = 0; n < 64; n += 4) { const f32x4 v = *(const f32x4*)(sp + n); pv[n] = v.x; pv[n + 1] = v.y; pv[n + 2] = v.z; pv[n + 3] = v.w; }
            const LAS float* Cg = Cs + g * 128 * 64;
            for (int lb = 0; lb < 128; lb += 8) { float yd[8], zz[8], ea[8];
#pragma unroll
                for (int i = 0; i < 8; ++i) { const size_t m = (size_t)(m0 + lb + i); yd[i] = Y[m * 512 + ch]; zz[i] = bf2f(U[m * D_INP + U_Z + ch]); ea[i] = EA[m * 8 + h]; }
#pragma unroll
                for (int i = 0; i < 8; ++i) { const int r = lb + i; float yo = 0.f;
#pragma unroll
                    for (int n = 0; n < 64; n += 4) { const f32x4 c4 = *(const LAS f32x4*)(Cg + r * 64 + n); yo += c4.x * pv[n] + c4.y * pv[n + 1] + c4.z * pv[n + 2] + c4.w * pv[n + 3]; }
                    const float y = (yd[i] + ea[i] * yo) * silu_f(zz[i]);
                    Y[(size_t)(m0 + r) * 512 + ch] = y;
                    const float s2 = wave_sum(y * y);
                    if (lane == 0) atomicAdd((float*)(ssq + g * 128 + r), s2); }
            }
        }
        __syncthreads();
        for (int qd = F.tid; qd < 128 * 128; qd += NTHR) { const int r = qd >> 7, cc = (qd & 127) * 4; const size_t m = (size_t)(m0 + r);
            f32x4 y = *(const f32x4*)(Y + m * 512 + cc); const float rs = rsq_f(ssq[(cc >> 8) * 128 + r] * (1.f / 256.f) + EPS); const f32x4 n4 = *(const f32x4*)(nw + cc);
            y = y * rs * n4; v2u w; w.x = pk2(y.x, y.y); w.y = pk2(y.z, y.w); *(v2u*)(O + m * DM + 256 + cc) = w; }
        __syncthreads();
    }
}

#define CONV_ROWS_BEGIN(NR_, U_, m0_, s0_, ch_, cw_, cb_, r0_, r1_) { \
    const f32x4 w0_ = *(const f32x4*)((cw_) + (ch_)), w1_ = *(const f32x4*)((cw_) + 768 + (ch_)), w2_ = *(const f32x4*)((cw_) + 2 * 768 + (ch_)), w3_ = *(const f32x4*)((cw_) + 3 * 768 + (ch_)), bb_ = *(const f32x4*)((cb_) + (ch_)); \
    const bf16* up_ = (U_) + (size_t)((m0_) + (r0_)) * D_INP + U_XBC + (ch_); v2u raw_[NR_ + 3]; \
    _Pragma("unroll") for (int k_ = 0; k_ < NR_ + 3; ++k_) { const int rr_ = (r0_) - 3 + k_; raw_[k_] = ((s0_) + rr_ >= 0 && rr_ < (r1_)) ? *(const v2u*)(up_ + (long)(k_ - 3) * D_INP) : (v2u){0u, 0u}; }     \
    f32x4 x0_ = {bflo(raw_[0].x), bfhi(raw_[0].x), bflo(raw_[0].y), bfhi(raw_[0].y)}, x1_ = {bflo(raw_[1].x), bfhi(raw_[1].x), bflo(raw_[1].y), bfhi(raw_[1].y)}, x2_ = {bflo(raw_[2].x), bfhi(raw_[2].x), bflo(raw_[2].y), bfhi(raw_[2].y)}; \
    _Pragma("unroll") for (int k_ = 0; k_ < NR_; ++k_) { const int r = (r0_) + k_; if (r < (r1_)) { const v2u w_ = raw_[k_ + 3]; const f32x4 xin_ = {bflo(w_.x), bfhi(w_.x), bflo(w_.y), bfhi(w_.y)}; \
        f32x4 v = bb_ + w0_ * x0_ + w1_ * x1_ + w2_ * x2_ + w3_ * xin_; x0_ = x1_; x1_ = x2_; x2_ = xin_; v.x = silu_f(v.x); v.y = silu_f(v.y); v.z = silu_f(v.z); v.w = silu_f(v.w);
#define CONV_ROWS_END } } }
#define CONV_ROWS_LOAD(NR_, raw_, U_, m0_, s0_, ch_, r0_, r1_) { const bf16* up_ = (U_) + (size_t)((m0_) + (r0_)) * D_INP + U_XBC + (ch_); \
    _Pragma("unroll") for (int k_ = 0; k_ < NR_ + 3; ++k_) { const int rr_ = (r0_) - 3 + k_; raw_[k_] = ((s0_) + rr_ >= 0 && rr_ < (r1_)) ? *(const v2u*)(up_ + (long)(k_ - 3) * D_INP) : (v2u){0u, 0u}; } }
#define CONV_ROWS_COMPUTE_BEGIN(NR_, raw_, ch_, cw_, cb_, r0_, r1_) { \
    const f32x4 w0_ = *(const f32x4*)((cw_) + (ch_)), w1_ = *(const f32x4*)((cw_) + 768 + (ch_)), w2_ = *(const f32x4*)((cw_) + 2 * 768 + (ch_)), w3_ = *(const f32x4*)((cw_) + 3 * 768 + (ch_)), bb_ = *(const f32x4*)((cb_) + (ch_)); \
    f32x4 x0_ = {bflo(raw_[0].x), bfhi(raw_[0].x), bflo(raw_[0].y), bfhi(raw_[0].y)}, x1_ = {bflo(raw_[1].x), bfhi(raw_[1].x), bflo(raw_[1].y), bfhi(raw_[1].y)}, x2_ = {bflo(raw_[2].x), bfhi(raw_[2].x), bflo(raw_[2].y), bfhi(raw_[2].y)}; \
    _Pragma("unroll") for (int k_ = 0; k_ < NR_; ++k_) { const int r = (r0_) + k_; if (r < (r1_)) { const v2u w_ = raw_[k_ + 3]; const f32x4 xin_ = {bflo(w_.x), bfhi(w_.x), bflo(w_.y), bfhi(w_.y)}; \
        f32x4 v = bb_ + w0_ * x0_ + w1_ * x1_ + w2_ * x2_ + w3_ * xin_; x0_ = x1_; x1_ = x2_; x2_ = xin_; v.x = silu_f(v.x); v.y = silu_f(v.y); v.z = silu_f(v.z); v.w = silu_f(v.w);
namespace ssdm {
typedef __attribute__((address_space(3))) const char* lcp;
typedef float f32x16 __attribute__((ext_vector_type(16)));
typedef short s16x4 __attribute__((ext_vector_type(4)));
constexpr int XI_OFF = 0, BK_OFF = 65536, CK_OFF = 81920, SM_OFF = 98304, PV_OFF = 106496, PV3_OFF = 132096;
constexpr int XI_OFF_UNUSED = 0;
__device__ __forceinline__ int crow(int r, int hi) { return (r & 3) + 8 * (r >> 2) + 4 * hi; }
__device__ __forceinline__ s16x4 vtr(lcp p) { return __builtin_bit_cast(s16x4, __builtin_amdgcn_ds_read_tr16_b64_v4i16((__attribute__((address_space(3))) attn_body::v4i16_t*)p)); }
__device__ __forceinline__ bf16x8 join(s16x4 lo, s16x4 hi) { return (bf16x8){lo[0], lo[1], lo[2], lo[3], hi[0], hi[1], hi[2], hi[3]}; }
template <int CTRL, int RMASK> __device__ __forceinline__ float dpp0f(float v) { return __builtin_bit_cast(float, __builtin_amdgcn_update_dpp(0, __builtin_bit_cast(int, v), CTRL, RMASK, 0xf, false)); }
__device__ __forceinline__ float wave_incl_scan(float v) {
    v += dpp0f<0x111, 0xf>(v); v += dpp0f<0x112, 0xf>(v); v += dpp0f<0x114, 0xf>(v); v += dpp0f<0x118, 0xf>(v);
    v += dpp0f<0x142, 0xa>(v); v += dpp0f<0x143, 0xc>(v); return v; }
__device__ __forceinline__ void dt_cumsum(const Frame& F, const bf16* U, int m0, int g, const float* dtb, const float* alog, LAS float* dts, LAS float* acs) {
    const int hh = F.tid >> 7, r = F.tid & 127, h = g * 4 + hh;
    const float dtv = softplus_f(bf2f(U[(size_t)(m0 + r) * D_INP + U_DT + h]) + dtb[h]); const float x = dtv * -exp_f(alog[h]);
    LAS float* tot = acs + 512 + 128;
    float sc = wave_incl_scan(x);
    if ((F.wave & 1) == 0 && F.lane == 63) tot[hh] = sc;
    dts[F.tid] = dtv;
    __syncthreads();
    if (F.wave & 1) sc += tot[hh];
    acs[F.tid] = sc;
    __syncthreads();
}
}

__device__ __forceinline__ void ph_ssd_states(const Frame& F, const Args& a, int l) {
    using namespace ssdm;
    unsigned char* const ws = WSP(F);
    const bf16* U = (const bf16*)(ws + WS_U); float* ST = (float*)(ws + WS_SST); float* EA = (float*)(ws + WS_DT);
    const float* cw = P(F, 9) + (size_t)l * 4 * 768; const float* cb = P(F, 10) + l * 768; const float* dtb = P(F, 11) + l * 8; const float* alog = P(F, 12) + l * 8;
    LAS unsigned char* XI = F.lds + XI_OFF; LAS unsigned char* BT = F.lds + BK_OFF; LAS float* dts = (LAS float*)(F.lds + SM_OFF); LAS float* acs = dts + 512;
    const int lane = F.lane, r32 = lane & 31, hi = lane >> 5, hh = F.wave & 3, ph = F.wave >> 2;
    for (int unit = F.vcu; unit < BATCH * (SEQ / 128) * 2; unit += F.G) {
        const int g = unit & 1, bc = unit >> 1, b = bc / (SEQ / 128), c = bc % (SEQ / 128); const int m0 = b * SEQ + c * 128, s0 = c * 128;
        dt_cumsum(F, U, m0, g, dtb, alog, dts, acs);
        if (F.tid < 480) { const int j = F.tid % 80, rg = F.tid / 80, r0 = rg * 22, r1 = (r0 + 22 < 128) ? r0 + 22 : 128;
            if (j < 64) { const int cc = j * 4, hx = cc >> 6; const float aend = acs[hx * 128 + 127]; LAS unsigned char* xp = XI + (cc >> 5) * 8192 + (cc & 31) * 2;
                CONV_ROWS_BEGIN(22, U, m0, s0, g * 256 + cc, cw, cb, r0, r1)
                    v = v * (dts[hx * 128 + r] * exp_f(aend - acs[hx * 128 + r])); v2u pk; pk.x = pk2(v.x, v.y); pk.y = pk2(v.z, v.w); *(LAS v2u*)(xp + r * 64) = pk;
                CONV_ROWS_END }
            else { const int n = (j - 64) * 4; LAS unsigned char* bp = BT + (n >> 5) * 8192 + (n & 31) * 2;
                CONV_ROWS_BEGIN(22, U, m0, s0, 512 + g * 64 + n, cw, cb, r0, r1)
                    v2u pk; pk.x = pk2(v.x, v.y); pk.y = pk2(v.z, v.w); *(LAS v2u*)(bp + r * 64) = pk;
                CONV_ROWS_END } }
        if (F.tid < 4) EA[(size_t)(m0 + 127) * 8 + g * 4 + F.tid] = exp_f(acs[F.tid * 128 + 127]);
        __syncthreads();
        {
            f32x16 acc[2]; acc[0] = f32x16{}; acc[1] = f32x16{};
            const int trl = (8 * hi + ((lane & 15) >> 2)) * 64 + ((lane >> 4) & 1) * 32 + (lane & 3) * 8;
            const lcp xa = (lcp)(XI + (hh * 2 + ph) * 8192 + trl); const lcp b0p = (lcp)(BT + trl), b1p = (lcp)(BT + 8192 + trl);
#pragma unroll
            for (int ks = 0; ks < 8; ++ks) { const bf16x8 af = join(vtr(xa + ks * 1024), vtr(xa + ks * 1024 + 256)), bf0 = join(vtr(b0p + ks * 1024), vtr(b0p + ks * 1024 + 256)), bf1 = join(vtr(b1p + ks * 1024), vtr(b1p + ks * 1024 + 256));
                acc[0] = __builtin_amdgcn_mfma_f32_32x32x16_bf16(af, bf0, acc[0], 0, 0, 0); acc[1] = __builtin_amdgcn_mfma_f32_32x32x16_bf16(af, bf1, acc[1], 0, 0, 0); }
            float* sp = ST + ((size_t)(bc * 8 + g * 4 + hh) * 64 + 32 * ph) * 64 + r32;
#pragma unroll
            for (int nt = 0; nt < 2; ++nt)
#pragma unroll
                for (int r = 0; r < 16; ++r) sp[crow(r, hi) * 64 + 32 * nt] = acc[nt][r];
        }
        __syncthreads();
    }
}
__device__ __forceinline__ void ph_ssd_y(const Frame& F, const Args& a, int l) {
    using namespace ssdm;
    unsigned char* const ws = WSP(F);
    const bf16* U = (const bf16*)(ws + WS_U); const float* ST = (const float*)(ws + WS_SST); bf16* O = (bf16*)(ws + WS_O);
    const float* cw = P(F, 9) + (size_t)l * 4 * 768; const float* cb = P(F, 10) + l * 768; const float* dtb = P(F, 11) + l * 8; const float* alog = P(F, 12) + l * 8; const float* nw = P(F, 14) + l * 512;
    LAS unsigned char* XI = F.lds + XI_OFF; LAS unsigned char* BK = F.lds + BK_OFF; LAS unsigned char* CK = F.lds + CK_OFF;
    LAS float* dts = (LAS float*)(F.lds + SM_OFF); LAS float* acs = dts + 512; LAS float* ssq = acs + 512;
    const int lane = F.lane, r32 = lane & 31, hi = lane >> 5, hh = F.wave & 3, half = F.wave >> 2;
    for (int unit = F.vcu; unit < BATCH * (SEQ / 128) * 2; unit += F.G) {
        const int g = unit & 1, bc = unit >> 1, b = bc / (SEQ / 128), c = bc % (SEQ / 128); const int m0 = b * SEQ + c * 128, s0 = c * 128, h = g * 4 + hh;
        f32x4 pv[8];
        { const float* pp = ST + ((size_t)(bc * 8 + g * 4 + (F.tid >> 7)) * 64 + ((F.tid & 127) >> 1)) * 64 + 32 * (F.tid & 1);
#pragma unroll
          for (int q = 0; q < 8; ++q) pv[q] = *(const f32x4*)(pp + 4 * q); }
        dt_cumsum(F, U, m0, g, dtb, alog, dts, acs);
        if (F.tid < 128) ssq[F.tid] = 0.f;
        if (F.tid < 480) { const int j = F.tid % 96, rg = F.tid / 96, r0 = rg * 26, r1 = (r0 + 26 < 128) ? r0 + 26 : 128;
            if (j < 64) { const int cc = j * 4; LAS unsigned char* xp = XI + (cc >> 5) * 8192 + (cc & 31) * 2;
                CONV_ROWS_BEGIN(26, U, m0, s0, g * 256 + cc, cw, cb, r0, r1)
                    v2u pk; pk.x = pk2(v.x, v.y); pk.y = pk2(v.z, v.w); *(LAS v2u*)(xp + r * 64) = pk;
                CONV_ROWS_END }
            else { const int n = ((j < 80) ? (j - 64) : (j - 80)) * 4; LAS unsigned char* kp = ((j < 80) ? BK : CK) + (n >> 3) * 2048 + (n & 7) * 2;
                CONV_ROWS_BEGIN(26, U, m0, s0, ((j < 80) ? 512 : 640) + g * 64 + n, cw, cb, r0, r1)
                    v2u pk; pk.x = pk2(v.x, v.y); pk.y = pk2(v.z, v.w); *(LAS v2u*)(kp + r * 16) = pk;
                CONV_ROWS_END } }
        { const int hq = F.tid >> 7, p = (F.tid & 127) >> 1, nh = F.tid & 1;
          LAS unsigned char* pd = F.lds + ((hq < 3) ? PV_OFF + hq * 8192 : PV3_OFF) + ((4 * nh) * 64 + p) * 16;
#pragma unroll
          for (int q = 0; q < 4; ++q) { v4u o; o.x = pk2(pv[2 * q].x, pv[2 * q].y); o.y = pk2(pv[2 * q].z, pv[2 * q].w); o.z = pk2(pv[2 * q + 1].x, pv[2 * q + 1].y); o.w = pk2(pv[2 * q + 1].z, pv[2 * q + 1].w);
              *(LAS v4u*)(pd + q * 1024) = o; } }
        __syncthreads();
        const float Dh = P(F, 13)[l * 8 + h];
        f32x16 yk[2][2];
        const int trv = (4 * hi + ((lane & 15) >> 2)) * 64 + ((lane >> 4) & 1) * 32 + (lane & 3) * 8;
#pragma unroll
        for (int li = 0; li < 2; ++li) { const int lt = half ? 1 + li : 3 * li;
            bf16x8 cq[4];
#pragma unroll
            for (int d0 = 0; d0 < 4; ++d0) cq[d0] = *(const LAS bf16x8*)(CK + (2 * d0 + hi) * 2048 + (32 * lt + r32) * 16);
            f32x16 o[2]; o[0] = f32x16{}; o[1] = f32x16{};
            const float al = acs[hh * 128 + 32 * lt + r32];
            for (int st = 0; st <= lt; ++st) {
                f32x16 gt = f32x16{};
#pragma unroll
                for (int d0 = 0; d0 < 4; ++d0) { const bf16x8 kf = *(const LAS bf16x8*)(BK + (2 * d0 + hi) * 2048 + (32 * st + r32) * 16); gt = __builtin_amdgcn_mfma_f32_32x32x16_bf16(kf, cq[d0], gt, 0, 0, 0); }
                unsigned pw[8];
                int dd = r32 - 4 * hi; LAS float* ap = acs + hh * 128 + 32 * st + 4 * hi; LAS float* dp = dts + hh * 128 + 32 * st + 4 * hi;
                asm volatile("" : "+v"(dd), "+v"(ap), "+v"(dp));
#pragma unroll
                for (int r = 0; r < 16; r += 2) { float pv[2];
#pragma unroll
                    for (int e = 0; e < 2; ++e) { const int c0 = crow(r + e, 0); const float as = ap[c0], dv = dp[c0];
                        float v = gt[r + e] * exp_f(al - as) * dv;
                        if (st == lt) { v = (c0 <= dd) ? v : 0.f; v += (c0 == dd) ? Dh : 0.f; }
                        pv[e] = v; }
                    pw[r >> 1] = pk2(pv[0], pv[1]); }
                const bf16x8 pa0 = __builtin_bit_cast(bf16x8, (v4u){pw[0], pw[1], pw[2], pw[3]}), pa1 = __builtin_bit_cast(bf16x8, (v4u){pw[4], pw[5], pw[6], pw[7]});
#pragma unroll
                for (int pt = 0; pt < 2; ++pt) { const lcp vp = (lcp)(XI + (hh * 2 + pt) * 8192 + (32 * st) * 64 + trv);
                    const bf16x8 v0 = join(vtr(vp), vtr(vp + 512)), v1 = join(vtr(vp + 1024), vtr(vp + 1024 + 512));
                    o[pt] = __builtin_amdgcn_mfma_f32_32x32x16_bf16(pa0, v0, o[pt], 0, 0, 0); o[pt] = __builtin_amdgcn_mfma_f32_32x32x16_bf16(pa1, v1, o[pt], 0, 0, 0); }
            }
            f32x16 o2[2]; o2[0] = f32x16{}; o2[1] = f32x16{};
            { const LAS unsigned char* pvh = F.lds + ((hh < 3) ? PV_OFF + hh * 8192 : PV3_OFF) + r32 * 16 + hi * 1024;
#pragma unroll
              for (int pt = 0; pt < 2; ++pt)
#pragma unroll
                for (int d0 = 0; d0 < 4; ++d0) { const bf16x8 pb = *(const LAS bf16x8*)(pvh + (2 * d0) * 1024 + pt * 512);
                    o2[pt] = __builtin_amdgcn_mfma_f32_32x32x16_bf16(cq[d0], pb, o2[pt], 0, 0, 0); } }
            { LAS float* ep = acs + hh * 128 + 32 * lt + 4 * hi; LAS float* qp = ssq + 32 * lt + 4 * hi; const bf16* zb = U + (size_t)(m0 + 32 * lt + 4 * hi) * D_INP + U_Z + h * 64 + r32;
              asm volatile("" : "+v"(ep), "+v"(qp), "+v"(zb));
#pragma unroll
              for (int r = 0; r < 16; ++r) { const int c0 = crow(r, 0); const float ea = exp_f(ep[c0]); const bf16* zp = zb + (size_t)c0 * D_INP;
                const float y0 = (o[0][r] + ea * o2[0][r]) * silu_f(bf2f(zp[0])), y1 = (o[1][r] + ea * o2[1][r]) * silu_f(bf2f(zp[32]));
                yk[li][0][r] = y0; yk[li][1][r] = y1; }
              float s2[16];
#pragma unroll
              for (int r = 0; r < 16; ++r) s2[r] = sum16(yk[li][0][r] * yk[li][0][r] + yk[li][1][r] * yk[li][1][r]);
              if ((lane & 15) == 0) {
#pragma unroll
                  for (int r = 0; r < 16; ++r) atomicAdd((float*)(qp + crow(r, 0)), s2[r]); } }
        }
        __syncthreads();
#pragma unroll
        for (int li = 0; li < 2; ++li) { const int lt = half ? 1 + li : 3 * li;
            LAS float* qp = ssq + 32 * lt + 4 * hi; LAS bf16* ot = (LAS bf16*)XI + (32 * lt + 4 * hi) * 256 + hh * 64 + r32; asm volatile("" : "+v"(qp), "+v"(ot));
            const float n0 = nw[h * 64 + r32], n1 = nw[h * 64 + 32 + r32];
#pragma unroll
            for (int r = 0; r < 16; ++r) { const int c0 = crow(r, 0); const float rs = rsq_f(qp[c0] * (1.f / 256.f) + EPS);
                ot[c0 * 256] = (bf16)f2bf(yk[li][0][r] * rs * n0); ot[c0 * 256 + 32] = (bf16)f2bf(yk[li][1][r] * rs * n1); } }
        __syncthreads();
        { const LAS unsigned char* ot = XI + (F.tid >> 5) * 512 + (F.tid & 31) * 16; bf16* ob = O + (size_t)(m0 + (F.tid >> 5)) * DM + 256 + g * 256 + (F.tid & 31) * 8; asm volatile("" : "+v"(ot), "+v"(ob));
#pragma unroll
          for (int i = 0; i < 8; ++i) { const v4u v = *(const LAS v4u*)(ot + i * 16 * 512); *(GAS v4u*)(ob + (size_t)(16 * i) * DM) = v; } }
        __syncthreads();
    }
}
__device__ __forceinline__ void ph_seq_naive(const Frame& F, const Args& a, int l, int qsel, int parts = 3) {
    unsigned char* const ws = WSP(F);
    const int lane = F.lane;
    if ((parts & 1) && F.vcu < 8) gdn_chain(F, F.vcu);
    __syncthreads();
    if (parts & 2) {
        const Frame Fa = reframe(F);
        const attn_body::bf16* Qb = (const attn_body::bf16*)(ws + WS_Q); const attn_body::bf16* Kb = (const attn_body::bf16*)(ws + WS_K); const attn_body::bf16* Vb = (const attn_body::bf16*)(ws + WS_V);
        attn_body::bf16* O = (attn_body::bf16*)(ws + WS_O);
        unsigned* qhead = (unsigned*)(ws + WS_CTL) + CW_ATTQ + 64 * l + 128 * qsel;
        for (;;) {
            if (F.tid == 0) F.MISC[48] = __hip_atomic_fetch_add(qhead, 1u, RLX_AGENT);
            __syncthreads();
            const int it = (int)F.MISC[48];
            __syncthreads();
            if (it >= 8 * 64) break;
            const int qb = 63 - (it >> 3), bh = it & 7;
            attn_body::attn_unit<8>(Fa.tid, bh >> 2, bh & 3, qb, Qb, Kb, Vb, O, (char*)Fa.lds);
        }
    }
}
__device__ __forceinline__ void ph_post_naive(const Frame& F, const Args& a, int l) {
    unsigned char* const ws = WSP(F);
    const bf16* U = (const bf16*)(ws + WS_U); const float* Y = (const float*)(ws + WS_H); const float* OR = (const float*)(ws + WS_OR); bf16* O = (bf16*)(ws + WS_O);
    const float* snw = P(F, 14) + l * 512; const float* gnw = P(F, 19) + l * 64; const int lane = F.lane;
    for (int m = F.gw; m < T; m += F.NGW) {
        { const int c = 4 * lane; f32x4 o = *(const f32x4*)(OR + (size_t)m * 256 + c); const float ss = sum16((o.x * o.x + o.y * o.y) + (o.z * o.z + o.w * o.w));
          const float rs = rsq_f(ss * (1.f / 64.f) + EPS); const f32x4 nw = *(const f32x4*)(gnw + (c & 63)); const v2u zw = *(const v2u*)(U + (size_t)m * D_INP + U_GZ + c);
          o = o * rs * nw; o.x *= silu_f(bflo(zw.x)); o.y *= silu_f(bfhi(zw.x)); o.z *= silu_f(bflo(zw.y)); o.w *= silu_f(bfhi(zw.y));
          v2u w; w.x = pk2(o.x, o.y); w.y = pk2(o.z, o.w); if ((PROBE_SKIP >> (4 + 3 * l)) & 4) { w.x = 0; w.y = 0; } *(v2u*)(O + (size_t)m * DM + 768 + c) = w;
          if ((PROBE_SKIP >> (4 + 3 * l)) & 1) { v2u z; z.x = 0; z.y = 0; *(v2u*)(O + (size_t)m * DM + c) = z; } }
    }
}

constexpr int CW_CHK = 1024;
__device__ __forceinline__ int chk_row(int i) { return i == 0 ? 0 : i == 1 ? 1 : i == 2 ? 255 : i == 3 ? 256 : i == 4 ? 16383 : i == 5 ? 16384 : i == 6 ? 24999 : 32767; }
__device__ __forceinline__ void chk_commit(const Frame& F, int k, float err, float nrm) {
    LAS float* red = (LAS float*)(F.lds + 120000);
    if (F.tid < 2) red[F.tid] = 0.f;
    __syncthreads();
    atomicAdd((float*)(red + 0), err); atomicAdd((float*)(red + 1), nrm);
    __syncthreads();
    if (F.tid == 0) { float* slot = (float*)(WSP(F) + WS_CTL) + CW_CHK + 2 * k; slot[0] = red[0]; slot[1] = red[1]; }
    __syncthreads();
}
__device__ __forceinline__ void chk_rows(const Frame& F, int k, int mode, const bf16* A, int lda, int K, const float* W, const float* W2, int N, const bf16* C, int ldc,
                                         const float* outp, const float* base, int base_ld, bool base_sampled, const float* gate) {
    if (F.vcu != 0) return;
    float err = 0.f, nrm = 0.f;
    for (int col = F.tid; col < N; col += NTHR)
        for (int i = 0; i < 8; ++i) { const int row = chk_row(i); const bf16* ar = A + (size_t)row * lda; float d = 0.f, d2 = 0.f;
            for (int kk = 0; kk < K; ++kk) { const float av = bf2f(ar[kk]); d += av * W[(size_t)kk * N + col]; if (mode == 2) d2 += av * W2[(size_t)kk * N + col]; }
            float ref, got;
            if (mode == 0) { ref = d; got = bf2f(C[(size_t)row * ldc + col]); }
            else if (mode == 1) { const float bs = base_sampled ? base[(size_t)i * base_ld + col] : base[(size_t)row * base_ld + col]; ref = bs + gate[(row / SEQ) * 6144 + col] * d; got = outp[(size_t)row * 1024 + col]; ref -= bs; got -= bs; }
            else { ref = silu_f(d) * d2; got = bf2f(C[(size_t)row * ldc + col]); }
            err += (ref - got) * (ref - got); nrm += ref * ref; }
    chk_commit(F, k, err, nrm);
}

#if PROBE_CHECK
__device__ __forceinline__ void chk_gdn(const Frame& F, int l, int hh) {
    if (F.vcu != 0) return;
    unsigned char* const ws = WSP(F);
    const bf16* U = (const bf16*)(ws + WS_U); const float* OR = (const float*)(ws + WS_OR);
    const float* gcw = P(F, 15) + (size_t)l * 4 * 768; const float* gcb = P(F, 16) + l * 768; const float* gdtb = P(F, 17) + l * 4; const float* galog = P(F, 18) + l * 4;
    LAS float* ks = (LAS float*)(F.lds + 4096); LAS float* qs = ks + 64;
    float e0 = 0.f, n0 = 0.f, e1 = 0.f, n1 = 0.f;
    if (F.wave == 0) {
        const int lane = F.lane; float S[64];
#pragma unroll
        for (int k = 0; k < 64; ++k) S[k] = 0.f;
        float xw[3][3], cwt[3][5];
#pragma unroll
        for (int pz = 0; pz < 3; ++pz) { xw[pz][0] = 0.f; xw[pz][1] = 0.f; xw[pz][2] = 0.f; const int ch = pz * 256 + hh * 64 + lane;
            cwt[pz][0] = gcw[ch]; cwt[pz][1] = gcw[768 + ch]; cwt[pz][2] = gcw[2 * 768 + ch]; cwt[pz][3] = gcw[3 * 768 + ch]; cwt[pz][4] = gcb[ch]; }
        const float gA = -exp_f(galog[hh]), gB = gdtb[hh];
#pragma unroll 1
        for (int t = 0; t < 128; ++t) { const bf16* ur = U + (size_t)t * D_INP; float cvv[3];
#pragma unroll
            for (int pz = 0; pz < 3; ++pz) { const int ch = pz * 256 + hh * 64 + lane; const float xin = bf2f(ur[U_GQKV + ch]);
                const float cv = cwt[pz][4] + cwt[pz][0] * xw[pz][0] + cwt[pz][1] * xw[pz][1] + cwt[pz][2] * xw[pz][2] + cwt[pz][3] * xin;
                xw[pz][0] = xw[pz][1]; xw[pz][1] = xw[pz][2]; xw[pz][2] = xin; cvv[pz] = silu_f(cv); }
            const float qn = cvv[0] * rsq_f(wave_sum(cvv[0] * cvv[0]) + EPS) * 0.125f, kn = cvv[1] * rsq_f(wave_sum(cvv[1] * cvv[1]) + EPS);
            const float beta = sigmoid_f(bf2f(ur[U_GB + hh])), al = exp_f(gA * softplus_f(bf2f(ur[U_GA + hh]) + gB));
            ks[lane] = kn; qs[lane] = qn; LDS_WAIT(); asm volatile("" ::: "memory");
            float kS = 0.f; LAS float* ksv = ks; asm volatile("" : "+v"(ksv));
#pragma unroll
            for (int k = 0; k < 64; k += 4) { const f32x4 k4 = *(const LAS f32x4*)(ksv + k);
                S[k] *= al; kS += k4.x * S[k]; S[k + 1] *= al; kS += k4.y * S[k + 1]; S[k + 2] *= al; kS += k4.z * S[k + 2]; S[k + 3] *= al; kS += k4.w * S[k + 3]; }
            const float vn = beta * (cvv[2] - kS); float o = 0.f;
#pragma unroll
            for (int k = 0; k < 64; k += 4) { const f32x4 k4 = *(const LAS f32x4*)(ksv + k), q4 = *(const LAS f32x4*)(ksv + 64 + k);
                S[k] += k4.x * vn; o += q4.x * S[k]; S[k + 1] += k4.y * vn; o += q4.y * S[k + 1]; S[k + 2] += k4.z * vn; o += q4.z * S[k + 2]; S[k + 3] += k4.w * vn; o += q4.w * S[k + 3]; }
            LDS_WAIT(); asm volatile("" ::: "memory");
            const float got = OR[(size_t)t * 256 + hh * 64 + lane];
            if (t < 64) { e0 += (o - got) * (o - got); n0 += o * o; } else { e1 += (o - got) * (o - got); n1 += o * o; }
        }
    }
    chk_commit(F, 6, e0, n0); chk_commit(F, 7, e1, n1);
}
#endif

#if PROBE_CHECK
__device__ __forceinline__ void chk_gdn2(const Frame& F, int l, int hh) {
    if (F.vcu != 0) return;
    unsigned char* const ws = WSP(F);
    const bf16* U = (const bf16*)(ws + WS_U);
    const bf16* KCp = (const bf16*)(ws + WS_GF + (size_t)(hh * (SEQ / 64)) * GF_UNIT); const bf16* QDp = KCp + 4096; const bf16* QKp = KCp + 8192; const bf16* KTp = KCp + 12288; const bf16* UVp = KCp + 16384;
    const float* gcw = P(F, 15) + (size_t)l * 4 * 768; const float* gcb = P(F, 16) + l * 768; const float* gdtb = P(F, 17) + l * 4; const float* galog = P(F, 18) + l * 4;
    LAS float* qs = (LAS float*)F.lds; LAS float* ks = qs + 4096; LAS float* vs = ks + 4096; LAS float* W1 = vs + 4096; LAS float* W2 = W1 + 4096; LAS float* bt = W2 + 4096; LAS float* gcm = bt + 64;
    float e[5] = {0.f, 0.f, 0.f, 0.f, 0.f}, nn[5] = {0.f, 0.f, 0.f, 0.f, 0.f};
    if (F.wave == 0) {
        int lane = F.lane; asm volatile("" : "+v"(lane));
        float xw[3][3], cwt[3][5];
#pragma unroll
        for (int pz = 0; pz < 3; ++pz) { xw[pz][0] = 0.f; xw[pz][1] = 0.f; xw[pz][2] = 0.f; const int ch = pz * 256 + hh * 64 + lane;
            cwt[pz][0] = gcw[ch]; cwt[pz][1] = gcw[768 + ch]; cwt[pz][2] = gcw[2 * 768 + ch]; cwt[pz][3] = gcw[3 * 768 + ch]; cwt[pz][4] = gcb[ch]; }
        const float gA = -exp_f(galog[hh]), gB = gdtb[hh]; float gsum = 0.f;
#pragma unroll 1
        for (int t = 0; t < 64; ++t) { const bf16* ur = U + (size_t)t * D_INP; float cvv[3];
#pragma unroll
            for (int pz = 0; pz < 3; ++pz) { const int ch = pz * 256 + hh * 64 + lane; const float xin = bf2f(ur[U_GQKV + ch]);
                const float cv = cwt[pz][4] + cwt[pz][0] * xw[pz][0] + cwt[pz][1] * xw[pz][1] + cwt[pz][2] * xw[pz][2] + cwt[pz][3] * xin;
                xw[pz][0] = xw[pz][1]; xw[pz][1] = xw[pz][2]; xw[pz][2] = xin; cvv[pz] = silu_f(cv); }
            qs[t * 64 + lane] = cvv[0] * rsq_f(wave_sum(cvv[0] * cvv[0]) + EPS) * 0.125f; ks[t * 64 + lane] = cvv[1] * rsq_f(wave_sum(cvv[1] * cvv[1]) + EPS); vs[t * 64 + lane] = cvv[2];
            gsum += gA * softplus_f(bf2f(ur[U_GA + hh]) + gB);
            if (lane == 0) { bt[t] = sigmoid_f(bf2f(ur[U_GB + hh])); gcm[t] = gsum; } }
        LDS_WAIT(); asm volatile("" ::: "memory");
        const float g63 = gcm[63];
#pragma unroll 1
        for (int i = 0; i < 64; ++i) { const float gi = gcm[i], bi = bt[i];
            { const float ref = qs[i * 64 + lane] * exp_f(gi), got = bf2f(QDp[gfrag_off(i, lane)]); e[0] += (ref - got) * (ref - got); nn[0] += ref * ref; }
            { const float ref = ks[i * 64 + lane] * exp_f(g63 - gi), got = bf2f(KTp[gfrag_off(lane, i)]); e[1] += (ref - got) * (ref - got); nn[1] += ref * ref; }
            { float d = 0.f; for (int k = 0; k < 64; ++k) d += qs[i * 64 + k] * ks[lane * 64 + k];
              const float ref = (lane <= i) ? d * exp_f(gi - gcm[lane]) : 0.f, got = bf2f(QKp[gfrag_off(i, lane)]); e[2] += (ref - got) * (ref - got); nn[2] += ref * ref; }
            float w1 = bi * vs[i * 64 + lane], w2 = bi * exp_f(gi) * ks[i * 64 + lane];
#pragma unroll 1
            for (int j = 0; j < i; ++j) { const float aij = bi * wave_sum(ks[i * 64 + lane] * ks[j * 64 + lane]) * exp_f(gi - gcm[j]); w1 -= aij * W1[j * 64 + lane]; w2 -= aij * W2[j * 64 + lane]; }
            W1[i * 64 + lane] = w1; W2[i * 64 + lane] = w2; LDS_WAIT(); asm volatile("" ::: "memory");
            { const float got = bf2f(UVp[(((lane >> 4) * 4 + (i >> 4)) * 64 + ((i & 15) >> 2) * 16 + (lane & 15)) * 4 + (i & 3)]); e[3] += (w1 - got) * (w1 - got); nn[3] += w1 * w1; }
            { const float got = -bf2f(KCp[gfrag_off(i, lane)]); e[4] += (w2 - got) * (w2 - got); nn[4] += w2 * w2; } }
    }
#pragma unroll
    for (int k = 0; k < 5; ++k) chk_commit(F, 8 + k, e[k], nn[k]);
}
#endif
__device__ __forceinline__ void moe_load_tstart(const Frame& F, const Args& a) {
    unsigned char* const ws = WSP(F);
    if (F.tid == 0) { unsigned* ctl = (unsigned*)(ws + WS_CTL); unsigned acc = 0;
        for (int e = 0; e < 8; ++e) { const unsigned c = __hip_atomic_load(ctl + CW_MOECNT + 64 * e, RLX_AGENT); F.MISC[16 + e] = acc; F.MISC[32 + e] = c; acc += (c + 255u) >> 8; }
        F.MISC[16 + 8] = acc; }
    __syncthreads();
}
__device__ __forceinline__ void ph_moe_route(const Frame& F, const Args& a, int l) {
    unsigned char* const ws = WSP(F);
    const float* mod = (const float*)(ws + WS_MOD) + (size_t)l * 12288; bf16* H = (bf16*)(ws + WS_H);
    const float* Wr = P(F, 24); const void* src = ws + WS_H;
    int* ROWTOK = (int*)(ws + WS_ROWTOK); int* TOKSLOT = (int*)(ws + WS_TOKSLOT); float* TOKW = (float*)(ws + WS_TOKW);
    unsigned* ctl = (unsigned*)(ws + WS_CTL);
    LAS int* lcnt = (LAS int*)(F.lds + 65536); LAS int* lbase = lcnt + 8; LAS int* se = lcnt + 16; LAS float* sw = (LAS float*)(lcnt + 16 + 256);
    const int lane = F.lane;
    f32x4 wr[4][4][2];
#pragma unroll
    for (int j = 0; j < 4; ++j)
#pragma unroll
        for (int i = 0; i < 4; ++i) { const int col = 4 * lane + 256 * j + i; wr[j][i][0] = *(const f32x4*)(Wr + (size_t)col * 8); wr[j][i][1] = *(const f32x4*)(Wr + (size_t)col * 8 + 4); }
    for (int blk = F.vcu; blk < T / 128; blk += F.G) {
        if (F.tid < 8) lcnt[F.tid] = 0;
        __syncthreads();
        f32x4 xa[4], xb[4];
        norm_row_load(src, (size_t)(blk * 128 + F.wave * 16), true, lane, xa);
#pragma unroll 1
        for (int rr = 0; rr < 16; ++rr) { const int r = F.wave * 16 + rr, m = blk * 128 + r, b = m / SEQ; f32x4 hv[4];
            if (rr + 1 < 16) norm_row_load(src, (size_t)(m + 1), true, lane, xb);
            norm_mod_apply<false>(xa, H + (size_t)m * DM, mod + b * 6144 + 3072, mod + b * 6144 + 4096, lane, hv);
            { unsigned* h8 = (unsigned*)(ws + WS_H8 + (size_t)m * DM) + lane;
#pragma unroll
              for (int j = 0; j < 4; ++j) { int w8 = 0; w8 = __builtin_amdgcn_cvt_pk_fp8_f32(hv[j].x * FP8_SA, hv[j].y * FP8_SA, w8, false); w8 = __builtin_amdgcn_cvt_pk_fp8_f32(hv[j].z * FP8_SA, hv[j].w * FP8_SA, w8, true); h8[64 * j] = (unsigned)w8; } }
            float lg[8];
#pragma unroll
            for (int e = 0; e < 8; ++e) lg[e] = 0.f;
#pragma unroll
            for (int j = 0; j < 4; ++j)
#pragma unroll
                for (int i = 0; i < 4; ++i) { const f32x4 wa = wr[j][i][0], wb = wr[j][i][1]; const float x = hv[j][i];
                    lg[0] += x * wa.x; lg[1] += x * wa.y; lg[2] += x * wa.z; lg[3] += x * wa.w; lg[4] += x * wb.x; lg[5] += x * wb.y; lg[6] += x * wb.z; lg[7] += x * wb.w; }
#pragma unroll
            for (int j = 0; j < 4; ++j) xa[j] = xb[j];
#pragma unroll
            for (int e = 0; e < 8; ++e) lg[e] = wave_sum(lg[e]);
            int e0 = 0; float v0 = lg[0];
#pragma unroll
            for (int e = 1; e < 8; ++e) if (lg[e] > v0) { v0 = lg[e]; e0 = e; }
            int e1 = -1; float v1 = -INFINITY;
#pragma unroll
            for (int e = 0; e < 8; ++e) if (e != e0 && lg[e] > v1) { v1 = lg[e]; e1 = e; }
            const float w0 = rcp_f(1.0f + exp_f(v1 - v0)), w1 = 1.0f - w0;
            if (lane == 0) { const int s0 = atomicAdd((int*)(lcnt + e0), 1), s1 = atomicAdd((int*)(lcnt + e1), 1);
                se[r * 2] = (e0 << 16) | s0; se[r * 2 + 1] = (e1 << 16) | s1; sw[r * 2] = w0; sw[r * 2 + 1] = w1; }
        }
        __syncthreads();
        if (F.tid < 8) lbase[F.tid] = (int)__hip_atomic_fetch_add(ctl + CW_MOECNT + 64 * F.tid, (unsigned)lcnt[F.tid], RLX_AGENT);
        __syncthreads();
        if (F.tid < 256) { const int r = F.tid >> 1, k = F.tid & 1, v = se[F.tid], e = v >> 16, idx = lbase[e] + (v & 0xffff), m = blk * 128 + r;
            ROWTOK[e * 32768 + idx] = m; TOKSLOT[m * 2 + k] = (e << 20) | idx; TOKW[m * 2 + k] = sw[F.tid]; }
        __syncthreads();
    }
}
__device__ __forceinline__ void ph_scale_w(const Frame& F, const float* modl, int which, const bf16* Wt, int N, bf16* Wo, float* bias, bool f8) {
    const int lane = F.lane;
    for (int n = F.gw; n < N; n += F.NGW) {
        const v4u wa = *(const v4u*)(Wt + (size_t)n * 1024 + lane * 16), wb = *(const v4u*)(Wt + (size_t)n * 1024 + lane * 16 + 8);
        float w[16] = {bflo(wa.x), bfhi(wa.x), bflo(wa.y), bfhi(wa.y), bflo(wa.z), bfhi(wa.z), bflo(wa.w), bfhi(wa.w), bflo(wb.x), bfhi(wb.x), bflo(wb.y), bfhi(wb.y), bflo(wb.z), bfhi(wb.z), bflo(wb.w), bfhi(wb.w)};
#pragma unroll
        for (int b = 0; b < 2; ++b) { const float* sh = modl + b * 6144 + which * 3072 + lane * 16; const float* sc = sh + 1024; float dot = 0.f; float o[16];
#pragma unroll
            for (int q = 0; q < 4; ++q) { const f32x4 s4 = *(const f32x4*)(sh + 4 * q), c4 = *(const f32x4*)(sc + 4 * q);
#pragma unroll
                for (int e = 0; e < 4; ++e) { o[4 * q + e] = w[4 * q + e] * (1.0f + c4[e]); dot += s4[e] * w[4 * q + e]; } }
            v4u oa, ob; oa.x = pk2(o[0], o[1]); oa.y = pk2(o[2], o[3]); oa.z = pk2(o[4], o[5]); oa.w = pk2(o[6], o[7]); ob.x = pk2(o[8], o[9]); ob.y = pk2(o[10], o[11]); ob.z = pk2(o[12], o[13]); ob.w = pk2(o[14], o[15]);
            if (f8) { v4u o8;
#pragma unroll
                for (int q = 0; q < 4; ++q) { int w8 = 0; w8 = __builtin_amdgcn_cvt_pk_fp8_f32(o[4 * q] * FP8_SW, o[4 * q + 1] * FP8_SW, w8, false); w8 = __builtin_amdgcn_cvt_pk_fp8_f32(o[4 * q + 2] * FP8_SW, o[4 * q + 3] * FP8_SW, w8, true); o8[q] = (unsigned)w8; }
                *(v4u*)((unsigned char*)Wo + ((size_t)b * N + n) * 1024 + lane * 16) = o8; }
            else { bf16* dst = Wo + ((size_t)b * N + n) * 1024 + lane * 16; *(v4u*)dst = oa; *(v4u*)(dst + 8) = ob; }
            dot = wave_sum(dot); if (lane == 0) bias[b * N + n] = dot; }
    }
}
__device__ __forceinline__ void ph_moe_conv(const Frame& F, const Args& a, int ci, int cn) {
    _Pragma("unroll 1") for (int r2 = 0; r2 < DUPN(13); ++r2) {
        unsigned char* const ws = WSP(F); const int lane = F.lane;
        constexpr int NBLK = 8 * 3 * 112;
        const int rh = lane >> 5, n4 = lane & 31;
        f32x4 cur[16], nxt[16];
#define MOE_BLK(b_, Wp_, ldw_, WTp_, ldt_) \
        const int e_ = (b_) / 336; int r_ = (b_) % 336; const int which_ = r_ / 112; r_ %= 112; \
        const float* Wp_; int ldw_, ldt_; unsigned char* WTp_; \
        if (which_ < 2) { const int kb_ = r_ / 28, nb_ = r_ % 28; Wp_ = P(F, 25 + which_) + (size_t)e_ * 1024 * DFFE + (size_t)(kb_ * 256) * DFFE + nb_ * 128; ldw_ = DFFE; \
            WTp_ = ws + WS_MUP + (size_t)e_ * 7168 * 1024 + (size_t)(256 * nb_ + 128 * which_) * 1024 + kb_ * 256; ldt_ = 1024; } \
        else { const int kb_ = r_ / 8, nb_ = r_ % 8; Wp_ = P(F, 27) + (size_t)e_ * DFFE * 1024 + (size_t)(kb_ * 256) * 1024 + nb_ * 128; ldw_ = 1024; \
            WTp_ = ws + WS_MDN + (size_t)e_ * 1024 * DFFE + (size_t)(nb_ * 128) * DFFE + kb_ * 256; ldt_ = DFFE; }
        int blkc = ci, buf = 0;
        if (blkc < NBLK) { MOE_BLK(blkc, W0, ldw0, WT0, ldt0) (void)WT0; (void)ldt0;
            const float* wp = W0 + (size_t)(32 * F.wave + 16 * rh) * ldw0 + 4 * n4;
#pragma unroll
            for (int j = 0; j < 16; ++j) cur[j] = *(const f32x4*)(wp + (size_t)j * ldw0); }
        for (; blkc < NBLK; blkc += cn) {
            const int bn = blkc + cn;
            if (bn < NBLK) { MOE_BLK(bn, W1, ldw1, WT1, ldt1) (void)WT1; (void)ldt1;
                const float* wp = W1 + (size_t)(32 * F.wave + 16 * rh) * ldw1 + 4 * n4;
#pragma unroll
                for (int j = 0; j < 16; ++j) nxt[j] = *(const f32x4*)(wp + (size_t)j * ldw1); }
            MOE_BLK(blkc, Wc, ldwc, WTc, ldtc) (void)Wc; (void)ldwc;
            LAS unsigned char* img = F.lds + buf * 32768;
#pragma unroll
            for (int i = 0; i < 4; ++i) { v4u o;
#pragma unroll
                for (int q = 0; q < 4; ++q) { int w8 = 0; w8 = __builtin_amdgcn_cvt_pk_fp8_f32(cur[4 * q][i] * FP8_SW, cur[4 * q + 1][i] * FP8_SW, w8, false); w8 = __builtin_amdgcn_cvt_pk_fp8_f32(cur[4 * q + 2][i] * FP8_SW, cur[4 * q + 3][i] * FP8_SW, w8, true); o[q] = (unsigned)w8; }
                *(LAS v4u*)(img + (4 * n4 + i) * 256 + (((2 * F.wave + rh) ^ (n4 & 15)) << 4)) = o; }
            __syncthreads();
            { const int chunk = F.tid & 15, rb = F.tid >> 4;
#pragma unroll
              for (int i = 0; i < 4; ++i) { const int row = rb + 32 * i; const v4u v = *(const LAS v4u*)(img + row * 256 + ((chunk ^ ((row >> 2) & 15)) << 4));
                  *(GAS v4u*)(WTc + (size_t)row * ldtc + chunk * 16) = v; } }
#pragma unroll
            for (int j = 0; j < 16; ++j) cur[j] = nxt[j];
            buf ^= 1;
        }
#undef MOE_BLK
        __syncthreads();
    }
}
template <bool GATHER_> struct MoeOrder {
    static constexpr bool GATHER = GATHER_;
    int ntile, nN, G, c, tile0; volatile LAS unsigned* ts; const int* rowtok;
    __device__ __forceinline__ bool next(int i, pg8::Unit& u) const {
        int pm, pcol;
        if ((G & 7) == 0) { const int NG = ((nN & 3) == 0 && nN >= 8) ? 4 : 1, XPG = 8 / NG, ncg = nN / NG, x = c & 7, gq = x / XPG, sub = x % XPG;
            const int nrt = (ntile > sub) ? (ntile - sub + XPG - 1) / XPG : 0, k = i * (G >> 3) + (c >> 3);
            if (k >= nrt * ncg) return false;
            pm = tile0 + (k / ncg) * XPG + sub; pcol = gq * ncg + k % ncg; }
        else { const int L = i * G + c; if (L >= ntile * nN) return false; pm = tile0 + L / nN; pcol = L % nN; }
        int e = 0;
#pragma unroll
        for (int j = 1; j < 8; ++j) e += (pm >= (int)ts[j]) ? 1 : 0;
        const int lt = pm - (int)ts[e];
        u.pm = pm; u.pn = e * nN + pcol; u.ab = e * 32768 + lt * 256; u.av = (int)ts[16 + e] - lt * 256; return true; }
    __device__ __forceinline__ int arow(const pg8::Unit& u, int r) const {
        if constexpr (!GATHER_) return (u.pm - tile0) * 256 + r;
        else { const int rc = r < u.av ? r : u.av - 1; return rowtok[u.ab + rc]; } }
};
__device__ __forceinline__ void ph_final(const Frame& F, const Args& a) {
    unsigned char* const ws = WSP(F);
    moe_load_tstart(F, a);
    const float* mod = (const float*)(ws + WS_MOD) + (size_t)1 * 12288; const bf16* Y = (const bf16*)(ws + WS_Y);
    const int* TOKSLOT = (const int*)(ws + WS_TOKSLOT); const float* TOKW = (const float*)(ws + WS_TOKW); const float* fn = P(F, 28); float* out = OUTP(F);
    const bf16* xs = (const bf16*)(ws + WS_H);
    const int lane = F.lane, m0 = F.gw, st = F.NGW;
    int sA0 = 0, sA1 = 0, sB0 = 0, sB1 = 0; float wA0 = 0.f, wA1 = 0.f, wB0 = 0.f, wB1 = 0.f;
    v2u xc[4], xn[4]; v2u yac[4], ybc[4], yan[4], ybn[4];
#define FIN_IDX(m_, s0_, s1_, w0_, w1_) { s0_ = TOKSLOT[(m_) * 2]; s1_ = TOKSLOT[(m_) * 2 + 1]; w0_ = TOKW[(m_) * 2]; w1_ = TOKW[(m_) * 2 + 1]; }
#define FIN_ROWS(m_, s0_, s1_, x_, ya_, yb_) { const size_t r0 = (size_t)F.MISC[16 + ((s0_) >> 20)] * 256 + ((s0_) & 0xfffff), r1 = (size_t)F.MISC[16 + ((s1_) >> 20)] * 256 + ((s1_) & 0xfffff); \
        _Pragma("unroll") for (int j = 0; j < 4; ++j) { const int c = 4 * lane + 256 * j; x_[j] = *(const v2u*)(xs + (size_t)(m_) * DM + c); ya_[j] = *(const v2u*)(Y + r0 * DM + c); yb_[j] = *(const v2u*)(Y + r1 * DM + c); } }
    if (m0 < T) { FIN_IDX(m0, sA0, sA1, wA0, wA1) FIN_ROWS(m0, sA0, sA1, xc, yac, ybc) }
    if (m0 + st < T) FIN_IDX(m0 + st, sB0, sB1, wB0, wB1)
#pragma unroll 1
    for (int m = m0; m < T; m += st) { const int b = m / SEQ;
        const float w0 = wA0, w1 = wA1;
        if (m + st < T) FIN_ROWS(m + st, sB0, sB1, xn, yan, ybn)
        sA0 = sB0; sA1 = sB1; wA0 = wB0; wA1 = wB1;
        if (m + 2 * st < T) FIN_IDX(m + 2 * st, sB0, sB1, wB0, wB1)
        f32x4 v[4]; float ss = 0.f;
#pragma unroll
        for (int j = 0; j < 4; ++j) { const int c = 4 * lane + 256 * j; const f32x4 x = {bflo(xc[j].x), bfhi(xc[j].x), bflo(xc[j].y), bfhi(xc[j].y)}; const f32x4 g2 = *(const f32x4*)(mod + b * 6144 + 5120 + c);
            const v2u ya = yac[j], yb = ybc[j];
            f32x4 f; f.x = w0 * bflo(ya.x) + w1 * bflo(yb.x); f.y = w0 * bfhi(ya.x) + w1 * bfhi(yb.x); f.z = w0 * bflo(ya.y) + w1 * bflo(yb.y); f.w = w0 * bfhi(ya.y) + w1 * bfhi(yb.y);
            v[j] = (PROBE_SKIP & 1) ? x : x + g2 * f; ss += (v[j].x * v[j].x + v[j].y * v[j].y) + (v[j].z * v[j].z + v[j].w * v[j].w); }
        const float rs = rsq_f(wave_sum(ss) * (1.f / 1024.f) + EPS);
        { float* orow = out + (size_t)m * DM;
#pragma unroll
          for (int j = 0; j < 4; ++j) { const int c = 4 * lane + 256 * j; const f32x4 nw = *(const f32x4*)(fn + c); *(f32x4*)(orow + c) = v[j] * rs * nw; } }
#pragma unroll
        for (int j = 0; j < 4; ++j) { xc[j] = xn[j]; yac[j] = yan[j]; ybc[j] = ybn[j]; }
    }
#undef FIN_IDX
#undef FIN_ROWS
}


#if PROBE_CHECK
__device__ __forceinline__ void chk_moe(const Frame& F) {
    if (F.vcu != 0) return;
    unsigned char* const ws = WSP(F);
    const bf16* H = (const bf16*)(ws + WS_H); const bf16* Y = (const bf16*)(ws + WS_Y);
    const int* TOKSLOT = (const int*)(ws + WS_TOKSLOT); const float* TOKW = (const float*)(ws + WS_TOKW);
    const float* Wr = P(F, 24); const float* Wg = P(F, 25); const float* Wu = P(F, 26); const float* Wd = P(F, 27);
    LAS float* hrow = (LAS float*)F.lds; LAS float* hid = hrow + 1024; LAS float* yacc = hid + 3584; LAS float* lg = yacc + 1024;
    float err = 0.f, nrm = 0.f, rerr = 0.f;
    for (int i = 0; i < 8; ++i) { const int tok = chk_row(i);
        for (int k = F.tid; k < 1024; k += NTHR) { hrow[k] = bf2f(H[(size_t)tok * 1024 + k]); yacc[k] = 0.f; }
        __syncthreads();
        if (F.tid < 8) { float s = 0.f; for (int k = 0; k < 1024; ++k) s += hrow[k] * Wr[k * 8 + F.tid]; lg[F.tid] = s; }
        __syncthreads();
        const int s0 = TOKSLOT[tok * 2], s1 = TOKSLOT[tok * 2 + 1]; const float w0 = TOKW[tok * 2], w1 = TOKW[tok * 2 + 1];
        if (F.tid == 0) { int e0 = 0; for (int e = 1; e < 8; ++e) if (lg[e] > lg[e0]) e0 = e; int e1 = -1; for (int e = 0; e < 8; ++e) if (e != e0 && (e1 < 0 || lg[e] > lg[e1])) e1 = e;
            const float nw0 = rcp_f(1.f + exp_f(lg[e1] - lg[e0]));
            if ((s0 >> 20) != e0 || (s1 >> 20) != e1 || fabsf(nw0 - w0) > 0.02f || fabsf(w0 + w1 - 1.f) > 1e-3f) rerr += 1.f; }
        for (int kx = 0; kx < 2; ++kx) { const int e = (kx ? s1 : s0) >> 20; const float w = kx ? w1 : w0;
            const float* wg = Wg + (size_t)e * 1024 * DFFE; const float* wu = Wu + (size_t)e * 1024 * DFFE; const float* wd = Wd + (size_t)e * DFFE * 1024;
            for (int j = F.tid; j < DFFE; j += NTHR) { float g = 0.f, u = 0.f; for (int k = 0; k < 1024; ++k) { const float hv = hrow[k]; g += hv * wg[(size_t)k * DFFE + j]; u += hv * wu[(size_t)k * DFFE + j]; } hid[j] = silu_f(g) * u; }
            __syncthreads();
            for (int c = F.tid; c < 1024; c += NTHR) { float y = 0.f; for (int j = 0; j < DFFE; ++j) y += hid[j] * wd[(size_t)j * 1024 + c]; yacc[c] += w * y; }
            __syncthreads(); }
        const size_t r0 = (size_t)F.MISC[16 + (s0 >> 20)] * 256 + (s0 & 0xfffff), r1 = (size_t)F.MISC[16 + (s1 >> 20)] * 256 + (s1 & 0xfffff);
        for (int c = F.tid; c < 1024; c += NTHR) { const float f = w0 * bf2f(Y[r0 * 1024 + c]) + w1 * bf2f(Y[r1 * 1024 + c]); err += (yacc[c] - f) * (yacc[c] - f); nrm += yacc[c] * yacc[c]; }
        __syncthreads();
    }
    chk_commit(F, 4, err, nrm); chk_commit(F, 5, rerr, 1.f);
}
__device__ __forceinline__ void ph_probe_scale(const Frame& F) {
    const float* slot = (const float*)(WSP(F) + WS_CTL) + CW_CHK; float code;
    if (PROBE_CHECK == 1) { int mask = 0; for (int k = 0; k < 5; ++k) { const float e = slot[2 * (PROBE_BASE + k)], n = slot[2 * (PROBE_BASE + k) + 1]; if (!(n > 0.f) || !(e <= 1e-3f * n)) mask |= 1 << k; } code = 10.f + (float)mask; }
    else { const int k = PROBE_CHECK - 2; const float e = slot[2 * k], n = slot[2 * k + 1]; float r = (n > 0.f) ? (k == 5 ? e * 0.125f : sqrtf(e / n)) : 1.f; if (!(r <= 1.f)) r = 1.f; code = 10.f + 30.f * r; }
    if (PROBE_CHECK == 100) code = wave_sum((float)F.lane + 1.0f) * (1.0f / 32.5f);
    if (PROBE_CHECK == 101) code = wave_max((float)F.lane) + sum16((float)(F.lane & 15)) * 0.1f;
    float* out = OUTP(F);
    for (int m = F.gw; m < T; m += F.NGW)
#pragma unroll
        for (int j = 0; j < 4; ++j) { f32x4* p4 = (f32x4*)(out + (size_t)m * DM + 4 * F.lane + 256 * j); *p4 = *p4 * (1.f + code); }
}
#endif
#ifndef MK_MULTI
#define MK_MULTI 0
#endif
constexpr int N_PHASES = 21 + (PROBE_CHECK ? 1 : 0);
__global__ void __launch_bounds__(NTHR, 2) mega_fwd(Args args) {
    extern __shared__ __attribute__((aligned(16))) unsigned char lds[];
    Frame F;
    F.lds = (LAS unsigned char*)lds; F.MISC = (volatile LAS unsigned*)(F.lds + MISC_OFF);
    F.tid = threadIdx.x; F.lane = F.tid & 63; F.wave = __builtin_amdgcn_readfirstlane(F.tid >> 6);
    F.G = gridDim.x; { const int bx = blockIdx.x; F.vcu = (F.G % 8 == 0) ? (bx % 8) * (F.G / 8) + bx / 8 : bx; }
    F.gw = F.vcu * NWAVES + F.wave; F.NGW = F.G * NWAVES;
    for (int u = F.tid; u < (LDS_BYTES - RING_BYTES) / 4; u += NTHR) ((LAS unsigned*)(F.lds + RING_BYTES))[u] = 0u;
    __syncthreads();
#pragma unroll
    for (int i = 0; i < 29; ++i) if (F.tid == i) { const unsigned long long v = (unsigned long long)args.in[i]; F.MISC[64 + 2 * i] = (unsigned)v; F.MISC[65 + 2 * i] = (unsigned)(v >> 32); }
    if (F.tid == 29) { const unsigned long long v = (unsigned long long)args.ws; F.MISC[64 + 58] = (unsigned)v; F.MISC[65 + 58] = (unsigned)(v >> 32); }
    if (F.tid == 30) { const unsigned long long v = (unsigned long long)args.out; F.MISC[64 + 60] = (unsigned)v; F.MISC[65 + 60] = (unsigned)(v >> 32); }
    __syncthreads();
    XcdBarrier bar; bar.bar = (unsigned*)(WSP(F) + WS_CTL) + CW_BAR; bar.x = 0; bar.st = nullptr;
    if (!MK_MULTI) bar = xcd_barrier_post((unsigned*)(WSP(F) + WS_CTL) + CW_BAR, F.MISC + 8);
    const int lo = args.ph_lo, hi = args.ph_hi; int pid = 0;
#define PH_ON (pid >= opq(lo) && pid < opq(hi))
#define PH_END do { if (!MK_MULTI && pid >= opq(lo) && pid + 1 < opq(hi)) xcd_barrier(bar); ++pid; } while (0)
#define PH_PTRS const Frame Fp = reframe(F); unsigned char* const ws = WSP(Fp); const float* const mod = (const float*)(ws + WS_MOD); bf16* const H = (bf16*)(ws + WS_H); bf16* const U = (bf16*)(ws + WS_U); bf16* const O = (bf16*)(ws + WS_O); (void)mod; (void)H; (void)U; (void)O

    if (PH_ON) { _Pragma("unroll 1") for (int rp = 0; rp < DUPN(5); ++rp) { const Frame Fp = reframe(F); ph_prologue(Fp, args); __syncthreads(); } }
    PH_END;
    for (int l = 0; l < 2; ++l) {
#if PROBE_CHECK
        if (PH_ON && l == 1) { const Frame Fp = reframe(F); unsigned char* const ws = WSP(Fp);
            chk_rows(Fp, 3, 1, (const bf16*)(ws + WS_U), DFF, DFF, P(Fp, 23), nullptr, 1024, nullptr, 0, OUTP(Fp), (const float*)(ws + WS_DT), 1024, true, (const float*)(ws + WS_MOD) + 5120); }
#endif
        if (l == 0) {
        if (PH_ON) { _Pragma("unroll 1") for (int rp = 0; rp < DUPN(6); ++rp) { const Frame Fp = reframe(F); ph_normmod(Fp, args, (const void*)P(Fp, 0), false, 0, 0); } }
        PH_END; }
        if (PH_ON) { _Pragma("unroll 1") for (int rp = 0; rp < DUPN(0); ++rp) {
            PH_PTRS; const int lp = opq(l);
            pg8::Gemm g{(lp == 0) ? (const bf16*)H : (const bf16*)OUTP(Fp), (lp == 0) ? (const bf16*)(ws + WS_WIN) : (const bf16*)(ws + WS_WINS), 1024, 1024};
            pg8::BatchOrder S; S.init(T, D_INP, Fp.G, (int)blockIdx.x, lp, SEQ);
            pg8::EpiStoreBf16 E{U, D_INP, D_INP / 256, 0, 1.0f, (lp == 0) ? (const float*)nullptr : (const float*)(ws + WS_PARTB), (const float*)(ws + WS_BIASW), D_INP, SEQ, (float*)(ws + WS_RQ), (float*)(ws + WS_RKV), (PG8_LAS float*)(Fp.lds + RING_BYTES + 4096)};
            pg8::gemm_phase<pg8::EpiStoreBf16, pg8::BatchOrder, true>(Fp.lds, Fp.tid, g, S, E);
        } }
        PH_END;
#if PROBE_CHECK
        if (PH_ON && l == 0) { const Frame Fp = reframe(F); unsigned char* const ws = WSP(Fp);
            chk_rows(Fp, 0, 0, (const bf16*)(ws + WS_H), 1024, 1024, P(Fp, 4), nullptr, D_IN, (const bf16*)(ws + WS_U), D_INP, nullptr, nullptr, 0, false, nullptr); }
#endif
        if (PH_ON) { _Pragma("unroll 1") for (int rp = 0; rp < DUPN(1); ++rp) { _Pragma("unroll 1") for (int r2 = 0; r2 < DUPN(7); ++r2) { const Frame Fp = reframe(F); ph_mla(Fp, args, opq(l)); }
            _Pragma("unroll 1") for (int r2 = 0; r2 < DUPN(8); ++r2) { const Frame Fp = reframe(F); ph_gdn_prep(Fp, args, opq(l)); __syncthreads(); }
            _Pragma("unroll 1") for (int r2 = 0; r2 < DUPN(9); ++r2) { const Frame Fp = reframe(F); ph_ssd_states(Fp, args, opq(l)); } } }
        PH_END;
        if (PH_ON) { { const Frame Fp = reframe(F); ph_ssd_scan(Fp, args); } if (DUPN(10) > 1) { const Frame Fp = reframe(F); ph_ssd_scan(Fp, args, true); } _Pragma("unroll 1") for (int rp = 0; rp < DUPN(2); ++rp) { const Frame Fp = reframe(F); ph_seq_naive(Fp, args, opq(l), opq(rp)); __syncthreads(); }
            if (DUPN(17) > 1) { const Frame Fp = reframe(F); ph_seq_naive(Fp, args, opq(l), 2, 1); __syncthreads(); }
            if (DUPN(18) > 1) { const Frame Fp = reframe(F); ph_seq_naive(Fp, args, opq(l), 3, 2); __syncthreads(); } }
        PH_END;
        #if PROBE_CHECK
        if (PH_ON && l == 0) { const Frame Fp = reframe(F); chk_gdn2(Fp, 0, PROBE_HEAD); __syncthreads(); }
#endif
        if (PH_ON) { _Pragma("unroll 1") for (int r2 = 0; r2 < DUPN(11); ++r2) { Frame Fp = reframe(F); const int lp = opq(l);
                if (lp == 1) { if (Fp.vcu >= CONV_NY) Fp.vcu = 1 << 20; Fp.G = CONV_NY; }
                ph_ssd_y(Fp, args, lp); }
            if (opq(l) == 1) { const Frame Fp = reframe(F); if (Fp.vcu >= CONV_NY) ph_moe_conv(Fp, args, Fp.vcu - CONV_NY, Fp.G - CONV_NY); __syncthreads(); } _Pragma("unroll 1") for (int r2 = 0; r2 < DUPN(12); ++r2) { const Frame Fp = reframe(F); ph_post_naive(Fp, args, opq(l)); }
            if (opq(l) == 0) {
                { const Frame Fp = reframe(F); unsigned char* const ws = WSP(Fp); ph_scale_w(Fp, (const float*)(ws + WS_MOD), 1, (const bf16*)(ws + WS_FUP), 2 * DFF, (bf16*)(ws + WS_FUPS), (float*)(ws + WS_BIASF), true); }
                { const Frame Fp = reframe(F); unsigned char* const ws = WSP(Fp); ph_scale_w(Fp, (const float*)(ws + WS_MOD) + 12288, 0, (const bf16*)(ws + WS_WIN) + (size_t)D_INP * 1024, D_INP, (bf16*)(ws + WS_WINS), (float*)(ws + WS_BIASW), false); } } }
        PH_END;
        if (PH_ON) { _Pragma("unroll 1") for (int r2 = 0; r2 < ((l == 0) ? DUPN(15) : 1); ++r2) {
            PH_PTRS; const int lp = opq(l); const void* xsrc = (lp == 0) ? (const void*)P(Fp, 0) : (const void*)OUTP(Fp);
            pg8::Gemm g{O, (const bf16*)(ws + WS_WOUT) + (size_t)lp * 1024 * 1024, 1024, 1024}; pg8::StaticOrder S; S.init(T, 1024, Fp.G, (int)blockIdx.x);
            pg8::EpiResGate E{xsrc, (lp == 0) ? (bf16*)OUTP(Fp) : (bf16*)(ws + WS_H), mod + (size_t)lp * 12288 + 2048, 6144, SEQ, lp == 0, (lp == 0) ? (unsigned char*)(ws + WS_H) : (unsigned char*)nullptr, FP8_SA, (lp == 0) ? (float*)(ws + WS_PARTA) : (float*)nullptr, (PG8_LAS float*)(Fp.lds + RING_BYTES + 4096)};
            pg8::gemm_phase<pg8::EpiResGate, pg8::StaticOrder, true>(Fp.lds, Fp.tid, g, S, E);
        } }
        PH_END;
        if (l == 0) {
#if PROBE_CHECK
            if (PH_ON) { const Frame Fp = reframe(F); unsigned char* const ws = WSP(Fp);
                chk_rows(Fp, 1, 1, (const bf16*)(ws + WS_O), 1024, 1024, P(Fp, 20), nullptr, 1024, nullptr, 0, OUTP(Fp), P(Fp, 0), 1024, false, (const float*)(ws + WS_MOD) + 2048); }
#endif
#if PROBE_CHECK
            if (PH_ON) { const Frame Fp = reframe(F); if (Fp.vcu == 0) { float* sv = (float*)(WSP(Fp) + WS_DT); const float* o = OUTP(Fp); for (int i = 0; i < 8; ++i) for (int c = Fp.tid; c < 1024; c += NTHR) sv[i * 1024 + c] = o[(size_t)chk_row(i) * 1024 + c]; } }
#endif
            if (PH_ON && !(PROBE_SKIP & 2)) { _Pragma("unroll 1") for (int rp = 0; rp < DUPN(3); ++rp) {
                PH_PTRS;
                pg8::Gemm g{(const bf16*)(ws + WS_H), (const bf16*)(ws + WS_FUPS), 512, 512}; pg8::BatchOrder S; S.init(T, 2 * DFF, Fp.G, (int)blockIdx.x, 1, SEQ);
                pg8::EpiSwiglu E{U, DFF, 2 * DFF / 256, 0, 1.0f / (FP8_SA * FP8_SW), 1.0f, (const float*)(ws + WS_PARTA), (const float*)(ws + WS_BIASF), 2 * DFF, SEQ};
                pg8::gemm_phase<pg8::EpiSwiglu, pg8::BatchOrder, true, true>(Fp.lds, Fp.tid, g, S, E);
            } }
            PH_END;
#if PROBE_CHECK
            if (PH_ON) { const Frame Fp = reframe(F); unsigned char* const ws = WSP(Fp);
                chk_rows(Fp, 2, 2, (const bf16*)(ws + WS_H), 1024, 1024, P(Fp, 21), P(Fp, 22), DFF, (const bf16*)(ws + WS_U), DFF, nullptr, nullptr, 0, false, nullptr); }
#endif
            if (PH_ON && !(PROBE_SKIP & 2)) {
                PH_PTRS; float* const outp = OUTP(Fp);
                pg8::Gemm g{U, (const bf16*)(ws + WS_FDN), DFF, DFF}; pg8::StaticOrder S; S.init(T, 1024, Fp.G, (int)blockIdx.x);
                pg8::EpiResGate E{outp, (bf16*)outp, mod + (size_t)opq(l) * 12288 + 5120, 6144, SEQ, false, (unsigned char*)nullptr, 1.0f, (float*)(ws + WS_PARTB), (PG8_LAS float*)(Fp.lds + RING_BYTES + 4096)};
                pg8::gemm_phase<pg8::EpiResGate, pg8::StaticOrder, true>(Fp.lds, Fp.tid, g, S, E);
            }
            PH_END;
        } else {
            if (PH_ON) { const Frame Fp = reframe(F); ph_moe_route(Fp, args, opq(l)); }
            PH_END;
            for (int st = 0; st < 5; ++st) {
                if (PH_ON && st >= 1) {
                    PH_PTRS; moe_load_tstart(Fp, args);
                    const int chq = opq(st) - 1, R = (int)Fp.MISC[24], tile0 = chq * 64, ntile = (chq == 3) ? ((R - tile0) > 0 ? (R - tile0) : 0) : ((R - tile0) < 64 ? ((R - tile0) > 0 ? (R - tile0) : 0) : 64);
                    pg8::Gemm g{(const bf16*)(ws + WS_HID + (size_t)(chq & 1) * HID_STRIDE), (const bf16*)(ws + WS_MDN), DFFE / 2, DFFE / 2};
                    MoeOrder<false> S{ntile, 4, Fp.G, (int)blockIdx.x, tile0, Fp.MISC + 16, (const int*)(ws + WS_ROWTOK)};
                    pg8::EpiStoreBf16 E{(bf16*)(ws + WS_Y), 1024, 4, 0, 1.0f / (FP8_SA * FP8_SW), nullptr, nullptr, 0, SEQ, nullptr, nullptr, nullptr};
                    pg8::gemm_phase<pg8::EpiStoreBf16, MoeOrder<false>, true, true>(Fp.lds, Fp.tid, g, S, E);
                }
                if (PH_ON && st <= 3) { _Pragma("unroll 1") for (int rp = 0; rp < DUPN(4); ++rp) {
                    PH_PTRS; moe_load_tstart(Fp, args);
                    const int chq = opq(st), R = (int)Fp.MISC[24], tile0 = chq * 64, ntile = (chq == 3) ? ((R - tile0) > 0 ? (R - tile0) : 0) : ((R - tile0) < 64 ? ((R - tile0) > 0 ? (R - tile0) : 0) : 64);
                    pg8::Gemm g{(const bf16*)(ws + WS_H8), (const bf16*)(ws + WS_MUP), 512, 512};
                    MoeOrder<true> S{ntile, 28, Fp.G, (int)blockIdx.x, tile0, Fp.MISC + 16, (const int*)(ws + WS_ROWTOK)};
                    pg8::EpiSwigluT<true> E{(bf16*)(ws + WS_HID + (size_t)(chq & 1) * HID_STRIDE), DFFE, 28, tile0, 1.0f / (FP8_SA * FP8_SW), FP8_SA, nullptr, nullptr, 0, SEQ};
                    pg8::gemm_phase<pg8::EpiSwigluT<true>, MoeOrder<true>, true, true>(Fp.lds, Fp.tid, g, S, E);
                } }
                PH_END;
            }
        }
    }
    if (DUPN(14) > 1 && !MK_MULTI) { _Pragma("unroll 1") for (int r2 = 0; r2 < 32; ++r2) xcd_barrier(bar); }
    if (PH_ON) { const Frame Fp = reframe(F); ph_final(Fp, args); }
#if PROBE_CHECK
    if (PH_ON) { const Frame Fp = reframe(F); moe_load_tstart(Fp, args); chk_moe(Fp); }
#endif
    PH_END;
#if PROBE_CHECK
    if (PH_ON) { const Frame Fp = reframe(F); ph_probe_scale(Fp); }
    PH_END;
#endif
#undef PH_ON
#undef PH_END
}

extern "C" void kernel_launch(void* const* d_in, const int* in_sizes, int n_in, void* d_out, int out_size, void* d_ws, size_t ws_size, hipStream_t stream) {
    static int grid = 0;
    if (grid == 0) {
        if (n_in != 29 || out_size != T * DM || ws_size < WS_END) { fprintf(stderr, "kernel_launch: unexpected shapes/workspace (n_in %d out %d ws %zu need %zu)\n", n_in, out_size, ws_size, (size_t)WS_END); grid = -1; return; }
        int dev = 0, cus = 0, per_cu = 0;
        if (hipGetDevice(&dev) != hipSuccess || hipDeviceGetAttribute(&cus, hipDeviceAttributeMultiprocessorCount, dev) != hipSuccess) { grid = -1; return; }
        if (hipFuncSetAttribute((const void*)mega_fwd, hipFuncAttributeMaxDynamicSharedMemorySize, LDS_BYTES) != hipSuccess) { fprintf(stderr, "kernel_launch: hipFuncSetAttribute failed\n"); grid = -1; return; }
        if (hipOccupancyMaxActiveBlocksPerMultiprocessor(&per_cu, (const void*)mega_fwd, NTHR, LDS_BYTES) != hipSuccess || per_cu < 1) { fprintf(stderr, "kernel_launch: occupancy query says %d\n", per_cu); }
        (void)hipGetLastError();
        grid = cus;
    }
    if (grid < 0) return;
    if (hipMemsetAsync((char*)d_ws + WS_CTL, 0, CTL_ZERO_BYTES, stream) != hipSuccess) return;
    Args a{};
    for (int i = 0; i < 29; ++i) a.in[i] = (const float*)d_in[i];
    a.out = (float*)d_out; a.ws = (unsigned char*)d_ws;
#if MK_MULTI
    for (int p = 0; p < N_PHASES; ++p) { a.ph_lo = p; a.ph_hi = p + 1; hipLaunchKernelGGL(mega_fwd, dim3(grid), dim3(NTHR), LDS_BYTES, stream, a); }
#else
    a.ph_lo = 0; a.ph_hi = 1 << 30;
    hipLaunchKernelGGL(mega_fwd, dim3(grid), dim3(NTHR), LDS_BYTES, stream, a);
#endif
}
```

```cpp
#include <hip/hip_runtime.h>
#include <cstdio>
#include <cstdint>
#include <cmath>
#ifndef DUP_MASK
#define DUP_MASK 0
#endif
#define CONV_NY 171
#define DUPN(k) (1 + ((DUP_MASK >> (k)) & 1))
#ifndef PROBE_CHECK
#define PROBE_HEAD 0
#define PROBE_BASE 8
#define PROBE_CHECK 0
#endif
#ifndef PROBE_SKIP
#define PROBE_SKIP 0
#endif
namespace pg8 {
#define PG8_LAS __attribute__((address_space(3)))
typedef unsigned short bf16_t;
typedef short bf16x8 __attribute__((ext_vector_type(8)));
typedef float f32x4 __attribute__((ext_vector_type(4)));
typedef float f32x2 __attribute__((ext_vector_type(2)));
typedef unsigned u32x4 __attribute__((ext_vector_type(4)));
constexpr int BM = 256, BK = 64, HALF = 128, HTB = HALF * BK * 2  , STAGE_BYTES = 8 * HTB, NXCD = 8, WGM = 8;

__host__ __device__ __forceinline__ int lds_byte(int r, int c) { const int st = (r >> 4) * 2 + (c >> 5), rr = r & 15, cc = c & 31, ob = rr * 64 + cc * 2; return st * 1024 + (ob ^ (((ob >> 9) & 1) << 5)); }
__host__ __device__ __forceinline__ void stage_rc(int b, int& R, int& C) { const int st = b / 1024, sb = b % 1024, swz = sb ^ (((sb >> 9) & 1) << 5); R = (st >> 1) * 16 + swz / 64; C = (st & 1) * 32 + (swz % 64) / 2; }
__host__ __device__ __forceinline__ int perm32(int rho) { const int n = rho >> 4, i = rho & 15; return 8 * (i >> 2) + 4 * n + (i & 3); }

struct Unit { int pm, pn, ab, av; };
struct Gemm { const bf16_t* A; const bf16_t* Bt; int lda; int K; };

struct StaticOrder {
    int nM, nN, nwg, G, c;
    __host__ __device__ void init(int M, int N, int G_, int c_) { nM = M / BM; nN = N / BM; nwg = nM * nN; G = G_; c = c_; }
    __host__ __device__ bool next(int i, Unit& u) const {
        const long L = (long)i * G + c; if (L >= nwg) return false;
        int wgid = (int)L; { const int q = nwg / NXCD, r = nwg % NXCD, xcd = wgid % NXCD, off = wgid / NXCD; wgid = (xcd < r ? xcd * (q + 1) : r * (q + 1) + (xcd - r) * q) + off; }
        const int nig = WGM * nN, gid = wgid / nig, fm = gid * WGM, gsz = (nM - fm) < WGM ? (nM - fm) : WGM;
        u.pm = fm + ((wgid % nig) % gsz); u.pn = (wgid % nig) / gsz; u.ab = 0; u.av = 0; return true;
    }
    static constexpr bool GATHER = false;
    __device__ __forceinline__ int arow(const Unit& u, int r) const { return u.pm * BM + r; }
};

struct BatchOrder {
    StaticOrder S; int bsel, rows_per_batch;
    __host__ __device__ void init(int M, int N, int G_, int c_, int bsel_, int rpb_) { S.init(M, N, G_, c_); bsel = bsel_; rows_per_batch = rpb_; }
    __host__ __device__ bool next(int i, Unit& u) const { if (!S.next(i, u)) return false; u.pn += bsel * ((u.pm * BM) / rows_per_batch) * S.nN; return true; }
    static constexpr bool GATHER = false;
    __device__ __forceinline__ int arow(const Unit& u, int r) const { return u.pm * BM + r; }
};
__device__ __forceinline__ unsigned cvt_pk_bf16(float lo, float hi) { unsigned r; asm volatile("v_cvt_pk_bf16_f32 %0, %1, %2" : "=v"(r) : "v"(lo), "v"(hi)); return r; }


typedef int pg8_v8i __attribute__((ext_vector_type(8))); typedef int pg8_v4i __attribute__((ext_vector_type(4)));
__device__ __forceinline__ pg8_v8i pg8_cat(bf16x8 a, bf16x8 b) { return __builtin_shufflevector(__builtin_bit_cast(pg8_v4i, a), __builtin_bit_cast(pg8_v4i, b), 0, 1, 2, 3, 4, 5, 6, 7); }
template <int IMM> __device__ __forceinline__ void glds_sv_t(const char* sbase, unsigned voff, unsigned lds_dst) { unsigned keep;
    asm volatile("s_mov_b32 %0, m0\n\ts_mov_b32 m0, %3\n\ts_nop 0\n\tglobal_load_lds_dwordx4 %1, %2 offset:%c4\n\ts_mov_b32 m0, %0" : "=&s"(keep) : "v"(voff), "s"(sbase), "s"(lds_dst), "i"(IMM) : "memory"); }
#define glds_sv(sbase, voff, ldsdst, IMM) glds_sv_t<IMM>(sbase, voff, ldsdst)
template <class Epi, class Sched, bool ALIGN_EPI, bool FP8 = false>
__device__ __forceinline__ void gemm_phase(PG8_LAS unsigned char* lds, const int tid_in, const Gemm g, const Sched& S, const Epi& E) {
    const int tid = tid_in, wid = __builtin_amdgcn_readfirstlane(tid >> 6), lane = tid & 63, wr = wid >> 2, wc = wid & 3, fr = lane & 15, fq = lane >> 4;
    const int K = g.K, nt = K / BK, lda = g.lda;
    unsigned voffB[2], voffA[2];
#pragma unroll
    for (int i = 0; i < 2; ++i) { int R, C; stage_rc(tid * 16 + i * 8192, R, C); const int Rb = Epi::PERM ? ((R & ~31) + perm32(R & 31)) : R;
        voffB[i] = (unsigned)(Rb * K + C) * 2u; voffA[i] = (unsigned)(R * lda + C) * 2u; }
    const size_t hstepA = (size_t)HALF * lda * 2;
    const size_t kstep = (size_t)(BK * 2);
    const size_t hstep = (size_t)HALF * K * 2;
    const size_t tstep = 2 * hstep;
    const unsigned ldsw = (unsigned)wid * 1024u; const unsigned lds0 = (unsigned)(uintptr_t)lds;
    const int aoff = lds_byte(wr * 64 + fr, fq * 8), boff = lds_byte(wc * 32 + fr, fq * 8);
    const char* Ab = (const char*)g.A;
#define PG8_SA(b, h) (((b) * 2 + (h)) * HTB)
#define PG8_SB(b, h) ((4 + (b) * 2 + (h)) * HTB)
#define PG8_STAGE(bufoff, gbase, voff, IMM) do { _Pragma("unroll") for (int _i = 0; _i < 2; ++_i) \
        glds_sv((const char*)(gbase), (voff)[_i], (unsigned)__builtin_amdgcn_readfirstlane(lds0 + (bufoff) + ldsw + _i * 8192 - (IMM)), IMM); } while (0)
#define PG8_AOFFS(u, o) do { _Pragma("unroll") for (int _i = 0; _i < 2; ++_i) { int R_, C_; stage_rc(tid * 16 + _i * 8192, R_, C_);     \
        _Pragma("unroll") for (int _h = 0; _h < 2; ++_h) o[_h][_i] = ((unsigned)S.arow(u, _h * HALF + R_) * (unsigned)lda + (unsigned)C_) * 2u; } } while (0)
#define PG8_LDA(dst, b, h) do { _Pragma("unroll") for (int m = 0; m < 4; ++m) { if constexpr (FP8) { dst##8[m] = __builtin_shufflevector(*(const PG8_LAS pg8_v4i*)(lds + PG8_SA(b, h) + aoff + m * 2048), *(const PG8_LAS pg8_v4i*)(lds + PG8_SA(b, h) + aoff + m * 2048 + 1024), 0, 1, 2, 3, 4, 5, 6, 7); } \
        else { _Pragma("unroll") for (int k = 0; k < 2; ++k) dst[m][k] = *(const PG8_LAS bf16x8*)(lds + PG8_SA(b, h) + aoff + m * 2048 + k * 1024); } } } while (0)
#define PG8_LDB(dst, b, h) do { _Pragma("unroll") for (int n = 0; n < 2; ++n) { if constexpr (FP8) { dst##8[n] = __builtin_shufflevector(*(const PG8_LAS pg8_v4i*)(lds + PG8_SB(b, h) + boff + n * 2048), *(const PG8_LAS pg8_v4i*)(lds + PG8_SB(b, h) + boff + n * 2048 + 1024), 0, 1, 2, 3, 4, 5, 6, 7); } \
        else { _Pragma("unroll") for (int k = 0; k < 2; ++k) dst[n][k] = *(const PG8_LAS bf16x8*)(lds + PG8_SB(b, h) + boff + n * 2048 + k * 1024); } } } while (0)
#define PG8_MMA(ai, bj, At, Bt) do { __builtin_amdgcn_s_setprio(1); if constexpr (FP8) { \
        _Pragma("unroll") for (int m = 0; m < 4; ++m) _Pragma("unroll") for (int n = 0; n < 2; ++n) \
            asm volatile("v_mfma_scale_f32_16x16x128_f8f6f4 %0, %1, %2, %0, %3, %3 op_sel_hi:[0,0,0]" : "+v"(acc[ai][bj][m][n]) : "v"(Bt##8[n]), "v"(At##8[m]), "v"(sc8));     \
      } else { _Pragma("unroll") for (int m = 0; m < 4; ++m) _Pragma("unroll") for (int n = 0; n < 2; ++n) _Pragma("unroll") for (int k = 0; k < 2; ++k) \
        acc[ai][bj][m][n] = __builtin_amdgcn_mfma_f32_16x16x32_bf16(Bt[n][k], At[m][k], acc[ai][bj][m][n], 0, 0, 0); } __builtin_amdgcn_s_setprio(0); } while (0)
#define PG8_WAIT_V(n) asm volatile("s_waitcnt vmcnt(" #n ")" ::: "memory")
#define PG8_WAIT_L(n) asm volatile("s_waitcnt lgkmcnt(" #n ")" ::: "memory")
#define PG8_BAR __builtin_amdgcn_s_barrier()
#define PG8_SCHED __builtin_amdgcn_sched_barrier(0)
    const int sc8 = 0x7f7f7f7f;
    Unit cur, nxt; int ui = 0;
#define PG8_UNIFORM(u) do { u.pm = __builtin_amdgcn_readfirstlane(u.pm); u.pn = __builtin_amdgcn_readfirstlane(u.pn); u.ab = __builtin_amdgcn_readfirstlane(u.ab); u.av = __builtin_amdgcn_readfirstlane(u.av); } while (0)
    if (!S.next(0, cur)) return;
    PG8_UNIFORM(cur);
    f32x4 acc[2][2][4][2];
#pragma unroll
    for (int a = 0; a < 2; ++a)
#pragma unroll
        for (int b = 0; b < 2; ++b)
#pragma unroll
            for (int m = 0; m < 4; ++m)
#pragma unroll
                for (int n = 0; n < 2; ++n) acc[a][b][m][n] = (f32x4){0.f, 0.f, 0.f, 0.f};
    bf16x8 At[4][2], B0[2][2], B1[2][2]; pg8_v8i At8[4], B08[2], B18[2];
    unsigned oC[2][2], o2[2][2], oN[2][2];
    const char* cA = Ab; const char* nA = Ab; const char* a2 = Ab;
    if constexpr (Sched::GATHER) { PG8_AOFFS(cur, oC); } else { cA = Ab + (size_t)S.arow(cur, 0) * lda * 2; }
#define PG8_STAGE_AC(bufoff, h, kb, IMM) do { if constexpr (Sched::GATHER) { PG8_STAGE(bufoff, Ab + (kb), oC[h], IMM); } else { PG8_STAGE(bufoff, cA + (h) * hstepA + (kb), voffA, IMM); } } while (0)
#define PG8_STAGE_A2(bufoff, h, IMM) do { if constexpr (Sched::GATHER) { PG8_STAGE(bufoff, a2, o2[h], IMM); } else { PG8_STAGE(bufoff, a2 + (h) * hstepA, voffA, IMM); } } while (0)
    const char* cB = (const char*)g.Bt + (size_t)cur.pn * tstep;
    PG8_STAGE(PG8_SB(0, 0), cB, voffB, 0); PG8_STAGE(PG8_SB(0, 1), cB + hstep, voffB, 0); PG8_STAGE_AC(PG8_SA(0, 0), 0, 0, 0); PG8_STAGE_AC(PG8_SA(0, 1), 1, 0, 0);
    if (wr == 1) PG8_BAR;
    PG8_WAIT_V(2); PG8_BAR;
    PG8_STAGE(PG8_SB(1, 0), cB, voffB, 128); PG8_STAGE_AC(PG8_SA(1, 0), 0, 0, 128); PG8_STAGE(PG8_SB(1, 1), cB + hstep, voffB, 128);
    PG8_WAIT_V(6); PG8_BAR;
    for (;;) {
        const bool has_next = S.next(ui + 1, nxt); PG8_UNIFORM(nxt);
        if constexpr (!Sched::GATHER) { nA = has_next ? Ab + (size_t)S.arow(nxt, 0) * lda * 2 : cA; }
        const char* nB = has_next ? (const char*)g.Bt + (size_t)nxt.pn * tstep : cB;
        for (int t = 0; t < nt; t += 2) {
            const bool last = (t == nt - 2);
            const size_t k0 = (size_t)t * kstep;
            const char* b2 = last ? nB : cB + (size_t)(t + 2) * kstep;
            if constexpr (Sched::GATHER) {
                a2 = last ? Ab : Ab + (size_t)(t + 2) * kstep;
                if (t == nt - 4 && has_next) { Unit nq = nxt; asm volatile("" : "+s"(nq.ab), "+s"(nq.av)); PG8_AOFFS(nq, oN); }
#pragma unroll
                for (int h = 0; h < 2; ++h)
#pragma unroll
                    for (int i = 0; i < 2; ++i) o2[h][i] = (last && has_next) ? oN[h][i] : oC[h][i];
            } else { a2 = last ? nA : cA + (size_t)(t + 2) * kstep; }
            PG8_LDB(B0, 0, 0); PG8_LDB(B1, 0, 1); PG8_SCHED; PG8_LDA(At, 0, 0); PG8_STAGE_AC(PG8_SA(1, 1), 1, k0, 128);
            PG8_WAIT_V(8); PG8_WAIT_L(0); PG8_BAR; PG8_MMA(0, 0, At, B0); PG8_MMA(0, 1, At, B1); PG8_BAR; PG8_SCHED;
            PG8_LDA(At, 0, 1); PG8_STAGE(PG8_SB(0, 0), b2, voffB, 0); PG8_STAGE(PG8_SB(0, 1), b2 + hstep, voffB, 0); PG8_STAGE_A2(PG8_SA(0, 0), 0, 0);
            PG8_WAIT_V(8); PG8_WAIT_L(0); PG8_BAR; PG8_MMA(1, 0, At, B0); PG8_MMA(1, 1, At, B1); PG8_BAR; PG8_SCHED;
            PG8_LDB(B0, 1, 0); PG8_LDB(B1, 1, 1); PG8_SCHED; PG8_LDA(At, 1, 0); PG8_STAGE_A2(PG8_SA(0, 1), 1, 0);
            PG8_WAIT_V(8); PG8_WAIT_L(0); PG8_BAR; PG8_MMA(0, 0, At, B0); PG8_MMA(0, 1, At, B1); PG8_BAR; PG8_SCHED;
            PG8_LDA(At, 1, 1); PG8_STAGE(PG8_SB(1, 0), b2, voffB, 128); PG8_STAGE(PG8_SB(1, 1), b2 + hstep, voffB, 128); PG8_STAGE_A2(PG8_SA(1, 0), 0, 128);
            PG8_WAIT_V(8); PG8_WAIT_L(0); PG8_BAR; PG8_MMA(1, 0, At, B0); PG8_MMA(1, 1, At, B1); PG8_BAR; PG8_SCHED;
        }
        if constexpr (FP8) asm volatile("s_nop 15\n\ts_nop 15" ::: "memory");
        if constexpr (ALIGN_EPI) { if (wr == 0) PG8_BAR; }
        { int ln2; asm volatile("v_mbcnt_lo_u32_b32 %0, -1, 0\n\tv_mbcnt_hi_u32_b32 %0, -1, %0" : "=v"(ln2));
          E(acc, cur, wr, wc, ln2 & 15, ln2 >> 4); }
        if (!has_next) break;
#pragma unroll
        for (int a = 0; a < 2; ++a)
#pragma unroll
            for (int b = 0; b < 2; ++b)
#pragma unroll
                for (int m = 0; m < 4; ++m)
#pragma unroll
                    for (int n = 0; n < 2; ++n) acc[a][b][m][n] = (f32x4){0.f, 0.f, 0.f, 0.f};
        cur = nxt; cB = nB; ++ui;
        if constexpr (Sched::GATHER) {
#pragma unroll
            for (int h = 0; h < 2; ++h)
#pragma unroll
                for (int i = 0; i < 2; ++i) oC[h][i] = o2[h][i];
        } else { cA = nA; }
        if constexpr (ALIGN_EPI) { if (wr == 1) PG8_BAR; }
    }
    PG8_WAIT_V(0);
    if constexpr (!ALIGN_EPI) { if (wr == 0) PG8_BAR; }
    PG8_BAR;
#undef PG8_STAGE_AC
#undef PG8_UNIFORM
#undef PG8_STAGE_A2
#undef PG8_SA
#undef PG8_SB
#undef PG8_STAGE
#undef PG8_AOFFS
#undef PG8_LDA
#undef PG8_LDB
#undef PG8_MMA
#undef PG8_WAIT_V
#undef PG8_WAIT_L
#undef PG8_BAR
#undef PG8_SCHED
}
}
namespace pg8 {
__device__ __forceinline__ float fast_silu(float g) { return g * __builtin_amdgcn_rcpf(1.0f + __builtin_amdgcn_exp2f(-1.4426950408889634f * g)); }
struct EpiStoreBf16 {
    static constexpr bool PERM = true;
    bf16_t* O; int ldc; int nN; int row_tile0; float sc; const float* part; const float* bias; int bstride; int rows_per_batch;
    __device__ __forceinline__ void operator()(const f32x4 (&acc)[2][2][4][2], const Unit& u, int wr, int wc, int fr, int fq) const {
        const int row0 = (u.pm - row_tile0) * BM + wr * 64 + fr; const int col0 = (u.pn % nN) * BM + wc * 32 + 8 * fq;
        f32x4 bv[2][2];
#pragma unroll
        for (int bj = 0; bj < 2; ++bj) { bv[bj][0] = (f32x4){0.f, 0.f, 0.f, 0.f}; bv[bj][1] = bv[bj][0]; }
        if (part) { const float* bp = bias + (size_t)((u.pm * BM) / rows_per_batch) * bstride + col0;
#pragma unroll
            for (int bj = 0; bj < 2; ++bj) { bv[bj][0] = *(const f32x4*)(bp + bj * HALF); bv[bj][1] = *(const f32x4*)(bp + bj * HALF + 4); } }
#pragma unroll
        for (int ai = 0; ai < 2; ++ai)
#pragma unroll
            for (int m = 0; m < 4; ++m) { bf16_t* rowp = (bf16_t*)((char*)O + (unsigned)((row0 + ai * HALF + m * 16) * ldc + col0) * 2u);
                float rsc = sc;
                if (part) { const f32x4 p = *(const f32x4*)(part + (size_t)(u.pm * BM + wr * 64 + fr + ai * HALF + m * 16) * 4); rsc = sc * __builtin_amdgcn_rsqf(((p.x + p.y) + (p.z + p.w)) * (1.f / 1024.f) + 1e-6f); }
#pragma unroll
                for (int bj = 0; bj < 2; ++bj) { const f32x4 v0 = acc[ai][bj][m][0] * rsc + bv[bj][0], v1 = acc[ai][bj][m][1] * rsc + bv[bj][1];
                    u32x4 w; w.x = cvt_pk_bf16(v0[0], v0[1]); w.y = cvt_pk_bf16(v0[2], v0[3]); w.z = cvt_pk_bf16(v1[0], v1[1]); w.w = cvt_pk_bf16(v1[2], v1[3]);
                    *(u32x4*)(rowp + bj * HALF) = w; } }
    }
};
template <bool F8OUT, bool FUSED = true> struct EpiSwigluT {
    static constexpr bool PERM = true;
    bf16_t* Hd; int ldh; int nN; int row_tile0; float sc; float osc;
    const float* part; const float* bias; int bstride; int rows_per_batch;
    __device__ __forceinline__ void operator()(const f32x4 (&acc)[2][2][4][2], const Unit& u, int wr, int wc, int fr, int fq) const {
        const int row0 = (u.pm - row_tile0) * BM + wr * 64 + fr; const int col0 = (u.pn % nN) * HALF + wc * 32 + 8 * fq;
        f32x4 bv[2][2];
#pragma unroll
        for (int bj = 0; bj < 2; ++bj) { bv[bj][0] = (f32x4){0.f, 0.f, 0.f, 0.f}; bv[bj][1] = bv[bj][0]; }
        if (part) { const float* bp = bias + (size_t)((u.pm * BM) / rows_per_batch) * bstride + (u.pn % nN) * BM + wc * 32 + 8 * fq;
#pragma unroll
            for (int bj = 0; bj < 2; ++bj) { bv[bj][0] = *(const f32x4*)(bp + bj * HALF); bv[bj][1] = *(const f32x4*)(bp + bj * HALF + 4); } }
#pragma unroll
        for (int ai = 0; ai < 2; ++ai)
#pragma unroll
            for (int m = 0; m < 4; ++m) {
                float rsc = sc;
                if (part) { const f32x4 p = *(const f32x4*)(part + (size_t)(u.pm * BM + wr * 64 + fr + ai * HALF + m * 16) * 4); rsc = sc * __builtin_amdgcn_rsqf(((p.x + p.y) + (p.z + p.w)) * (1.f / 1024.f) + 1e-6f); }
                const f32x4 g0 = acc[ai][0][m][0] * rsc + bv[0][0], g1 = acc[ai][0][m][1] * rsc + bv[0][1], u0 = acc[ai][1][m][0] * rsc + bv[1][0], u1 = acc[ai][1][m][1] * rsc + bv[1][1];
                float r[8];
                if constexpr (!FUSED) {
                    const f32x4 ag0 = acc[ai][0][m][0], ag1 = acc[ai][0][m][1], au0 = acc[ai][1][m][0], au1 = acc[ai][1][m][1]; const float ke = -1.4426950408889634f * sc, ko = sc * sc * osc;
#pragma unroll
                    for (int i = 0; i < 4; ++i) { r[i] = (ag0[i] * au0[i]) * __builtin_amdgcn_rcpf(1.0f + __builtin_amdgcn_exp2f(ke * ag0[i])) * ko; r[4 + i] = (ag1[i] * au1[i]) * __builtin_amdgcn_rcpf(1.0f + __builtin_amdgcn_exp2f(ke * ag1[i])) * ko; }
                } else {
#pragma unroll
                for (int i = 0; i < 4; ++i) { r[i] = fast_silu(g0[i]) * u0[i] * (F8OUT ? osc : 1.0f); r[4 + i] = fast_silu(g1[i]) * u1[i] * (F8OUT ? osc : 1.0f); } }
                if constexpr (F8OUT) { char* rowp = (char*)Hd + (unsigned)((row0 + ai * HALF + m * 16) * ldh + col0);
                    int w0 = 0, w1 = 0; w0 = __builtin_amdgcn_cvt_pk_fp8_f32(r[0], r[1], w0, false); w0 = __builtin_amdgcn_cvt_pk_fp8_f32(r[2], r[3], w0, true);
                    w1 = __builtin_amdgcn_cvt_pk_fp8_f32(r[4], r[5], w1, false); w1 = __builtin_amdgcn_cvt_pk_fp8_f32(r[6], r[7], w1, true);
                    f32x2 wv; wv.x = __builtin_bit_cast(float, w0); wv.y = __builtin_bit_cast(float, w1); *(f32x2*)rowp = wv; }
                else { bf16_t* rowp = (bf16_t*)((char*)Hd + (unsigned)((row0 + ai * HALF + m * 16) * ldh + col0) * 2u);
                    u32x4 w; w.x = cvt_pk_bf16(r[0], r[1]); w.y = cvt_pk_bf16(r[2], r[3]); w.z = cvt_pk_bf16(r[4], r[5]); w.w = cvt_pk_bf16(r[6], r[7]);
                    *(u32x4*)rowp = w; } }
    }
};
typedef EpiSwigluT<false> EpiSwiglu;
struct EpiResGate {
    static constexpr bool PERM = true;
    const void* base; bf16_t* out; const float* gate; int gstride; int rows_per_batch; bool bf32;
    unsigned char* x8; float x8scale;
    float* part; PG8_LAS float* red;
    __device__ __forceinline__ void operator()(const f32x4 (&acc)[2][2][4][2], const Unit& u, int wr, int wc, int fr, int fq) const {
        float ssq[2][4];
#pragma unroll
        for (int ai = 0; ai < 2; ++ai)
#pragma unroll
            for (int m = 0; m < 4; ++m) ssq[ai][m] = 0.f;
        const int row0 = u.pm * BM + wr * 64 + fr; const int col0 = u.pn * BM + wc * 32 + 8 * fq;
        const float* gp = gate + (size_t)((u.pm * BM) / rows_per_batch) * gstride + col0;
        f32x4 gv[2][2];
#pragma unroll
        for (int bj = 0; bj < 2; ++bj)
#pragma unroll
            for (int n = 0; n < 2; ++n) gv[bj][n] = *(const f32x4*)(gp + bj * HALF + n * 4);
#pragma unroll
        for (int ai = 0; ai < 2; ++ai)
#pragma unroll
            for (int m = 0; m < 4; ++m) { const unsigned off = (unsigned)((row0 + ai * HALF + m * 16) * 1024 + col0);
#pragma unroll
                for (int bj = 0; bj < 2; ++bj) { f32x4 b0, b1;
                    if (bf32) { b0 = *(const f32x4*)((const char*)base + (size_t)(off + bj * HALF) * 4u); b1 = *(const f32x4*)((const char*)base + (size_t)(off + bj * HALF) * 4u + 16); }
                    else { const u32x4 w = *(const u32x4*)((const char*)base + (off + bj * HALF) * 2u);
                        b0 = (f32x4){__builtin_bit_cast(float, w.x << 16), __builtin_bit_cast(float, w.x & 0xffff0000u), __builtin_bit_cast(float, w.y << 16), __builtin_bit_cast(float, w.y & 0xffff0000u)};
                        b1 = (f32x4){__builtin_bit_cast(float, w.z << 16), __builtin_bit_cast(float, w.z & 0xffff0000u), __builtin_bit_cast(float, w.w << 16), __builtin_bit_cast(float, w.w & 0xffff0000u)}; }
                    const f32x4 v0 = b0 + gv[bj][0] * acc[ai][bj][m][0], v1 = b1 + gv[bj][1] * acc[ai][bj][m][1];
                    ssq[ai][m] += ((v0[0] * v0[0] + v0[1] * v0[1]) + (v0[2] * v0[2] + v0[3] * v0[3])) + ((v1[0] * v1[0] + v1[1] * v1[1]) + (v1[2] * v1[2] + v1[3] * v1[3]));
                    u32x4 o; o.x = cvt_pk_bf16(v0[0], v0[1]); o.y = cvt_pk_bf16(v0[2], v0[3]); o.z = cvt_pk_bf16(v1[0], v1[1]); o.w = cvt_pk_bf16(v1[2], v1[3]);
                    *(u32x4*)((char*)out + (off + bj * HALF) * 2u) = o;
                    if (x8) { int w0 = 0, w1 = 0; w0 = __builtin_amdgcn_cvt_pk_fp8_f32(v0[0] * x8scale, v0[1] * x8scale, w0, false); w0 = __builtin_amdgcn_cvt_pk_fp8_f32(v0[2] * x8scale, v0[3] * x8scale, w0, true);
                        w1 = __builtin_amdgcn_cvt_pk_fp8_f32(v1[0] * x8scale, v1[1] * x8scale, w1, false); w1 = __builtin_amdgcn_cvt_pk_fp8_f32(v1[2] * x8scale, v1[3] * x8scale, w1, true);
                        f32x2 wv; wv.x = __builtin_bit_cast(float, w0); wv.y = __builtin_bit_cast(float, w1); *(f32x2*)(x8 + (off + bj * HALF)) = wv; } } }
        if (part) {
#pragma unroll
            for (int ai = 0; ai < 2; ++ai)
#pragma unroll
                for (int m = 0; m < 4; ++m) { float p = ssq[ai][m]; p += __builtin_bit_cast(float, __builtin_amdgcn_ds_swizzle(__builtin_bit_cast(int, p), (16 << 10) | 0x1f));
                    if ((fq & 1) == 0) red[(wr * 64 + fr + ai * HALF + m * 16) * 8 + wc * 2 + (fq >> 1)] = p; }
            __syncthreads();
            { const int t = (int)threadIdx.x; if (t < 256) { PG8_LAS const float* rp = red + t * 8; const float sres = ((rp[0] + rp[1]) + (rp[2] + rp[3])) + ((rp[4] + rp[5]) + (rp[6] + rp[7])); part[(size_t)(u.pm * BM + t) * 4 + u.pn] = sres; } }
        }
    }
};
}


namespace pg8 {
struct EpiMlaQ {
    static constexpr bool PERM = false;
    bf16_t* Q; const PG8_LAS float* rs; const float* rope; float qscale; int seq;
    __device__ __forceinline__ void operator()(const f32x4 (&acc)[2][2][4][2], const Unit& u, int wr, int wc, int fr, int fq) const {
#pragma unroll
        for (int bj = 0; bj < 2; ++bj) { const int gidx = u.pn * 8 + bj * 4 + wc; if (gidx >= 12) continue; const int head = gidx / 3, part = gidx % 3;
#pragma unroll
            for (int ai = 0; ai < 2; ++ai)
#pragma unroll
                for (int m = 0; m < 4; ++m) { const int rl = ai * HALF + wr * 64 + m * 16 + fr, row = u.pm * BM + rl, b = row / seq, s = row % seq; const float sc = rs[rl] * qscale;
                    bf16_t* qp = (bf16_t*)((char*)Q + (unsigned)((((b * 4 + head) * seq + s) * 96 + part * 32 + 4 * fq) * 2));
                    const f32x4 v0 = acc[ai][bj][m][0] * sc, v1 = acc[ai][bj][m][1] * sc;
                    if (part < 2) { f32x2 w0, w1; w0.x = __builtin_bit_cast(float, cvt_pk_bf16(v0[0], v0[1])); w0.y = __builtin_bit_cast(float, cvt_pk_bf16(v0[2], v0[3])); w1.x = __builtin_bit_cast(float, cvt_pk_bf16(v1[0], v1[1])); w1.y = __builtin_bit_cast(float, cvt_pk_bf16(v1[2], v1[3]));
                        *(f32x2*)qp = w0; *(f32x2*)(qp + 16) = w1; }
                    else { const char* rp = (const char*)rope + (unsigned)((s * 16 + 4 * fq) * 8); const f32x4 ca = *(const f32x4*)rp, cb = *(const f32x4*)(rp + 16);
                        const float o0 = v0[0] * ca[0] - v1[0] * ca[1], o1 = v0[1] * ca[2] - v1[1] * ca[3], o2 = v0[2] * cb[0] - v1[2] * cb[1], o3 = v0[3] * cb[2] - v1[3] * cb[3];
                        const float p0 = v1[0] * ca[0] + v0[0] * ca[1], p1 = v1[1] * ca[2] + v0[1] * ca[3], p2 = v1[2] * cb[0] + v0[2] * cb[1], p3 = v1[3] * cb[2] + v0[3] * cb[3];
                        f32x2 w0, w1; w0.x = __builtin_bit_cast(float, cvt_pk_bf16(o0, o1)); w0.y = __builtin_bit_cast(float, cvt_pk_bf16(o2, o3)); w1.x = __builtin_bit_cast(float, cvt_pk_bf16(p0, p1)); w1.y = __builtin_bit_cast(float, cvt_pk_bf16(p2, p3));
                        *(f32x2*)qp = w0; *(f32x2*)(qp + 16) = w1; } } }
    }
};
struct EpiMlaKV {
    static constexpr bool PERM = false;
    bf16_t* K; bf16_t* V; const PG8_LAS float* rs; int seq;
    __device__ __forceinline__ void operator()(const f32x4 (&acc)[2][2][4][2], const Unit& u, int wr, int wc, int fr, int fq) const {
#pragma unroll
        for (int bj = 0; bj < 2; ++bj) { const int gidx = u.pn * 8 + bj * 4 + wc, head = gidx >> 2, part = gidx & 3;
#pragma unroll
            for (int ai = 0; ai < 2; ++ai)
#pragma unroll
                for (int m = 0; m < 4; ++m) { const int rl = ai * HALF + wr * 64 + m * 16 + fr, row = u.pm * BM + rl, b = row / seq, s = row % seq; const float sc = rs[256 + rl];
                    bf16_t* dp = (part < 2) ? (bf16_t*)((char*)K + (unsigned)((((b * 4 + head) * seq + s) * 96 + part * 32 + 4 * fq) * 2)) : (bf16_t*)((char*)V + (unsigned)((((b * 4 + head) * seq + s) * 64 + (part - 2) * 32 + 4 * fq) * 2));
                    const f32x4 v0 = acc[ai][bj][m][0] * sc, v1 = acc[ai][bj][m][1] * sc;
                    f32x2 w0, w1; w0.x = __builtin_bit_cast(float, cvt_pk_bf16(v0[0], v0[1])); w0.y = __builtin_bit_cast(float, cvt_pk_bf16(v0[2], v0[3])); w1.x = __builtin_bit_cast(float, cvt_pk_bf16(v1[0], v1[1])); w1.y = __builtin_bit_cast(float, cvt_pk_bf16(v1[2], v1[3]));
                    *(f32x2*)dp = w0; *(f32x2*)(dp + 16) = w1; } }
    }
};
}
#define GAS __attribute__((address_space(1)))
#define LAS __attribute__((address_space(3)))
typedef unsigned short bf16;
typedef unsigned v4u __attribute__((ext_vector_type(4)));
typedef unsigned v2u __attribute__((ext_vector_type(2)));
typedef float f32x4 __attribute__((ext_vector_type(4)));
typedef short bf16x8 __attribute__((ext_vector_type(8)));
typedef GAS unsigned gu32;
typedef GAS unsigned long long gu64;
#define RLX_AGENT __ATOMIC_RELAXED, __HIP_MEMORY_SCOPE_AGENT
#define LDS_WAIT() asm volatile("s_waitcnt lgkmcnt(0)" ::: "memory")
#define VM_WAIT() asm volatile("s_waitcnt vmcnt(0)" ::: "memory")
typedef float pk_f2v __attribute__((ext_vector_type(2))); typedef __bf16 pk_b2v __attribute__((ext_vector_type(2)));
__device__ __forceinline__ unsigned pk2(float lo, float hi) { const pk_f2v v = {lo, hi}; return __builtin_bit_cast(unsigned, __builtin_convertvector(v, pk_b2v)); }
__device__ __forceinline__ unsigned f2bf(float f) { return pk2(f, 0.f) & 0xffffu; }
__device__ __forceinline__ float bf2f(unsigned short v) { return __builtin_bit_cast(float, (unsigned)v << 16); }
__device__ __forceinline__ float bflo(unsigned w) { return __builtin_bit_cast(float, w << 16); }
__device__ __forceinline__ float bfhi(unsigned w) { return __builtin_bit_cast(float, w & 0xffff0000u); }

#define XB_TMO      128
#define XB_XCNT(j)  (256  + 64 * (j))
#define XB_XSUB(j)  (1280 + 64 * (j))
#define XB_XGEN(j)  (2304 + 64 * (j))
#define XB_TOP      3328
#define XB_TOPGEN   3392
#define XCD_BAR_WORDS 3456
#define XB_SPIN_CAP (1u << 23)

__device__ __forceinline__ unsigned xb_ld(unsigned* p)              { return __hip_atomic_load(p, __ATOMIC_RELAXED, __HIP_MEMORY_SCOPE_AGENT); }
__device__ __forceinline__ unsigned xb_add(unsigned* p, unsigned v) { return __hip_atomic_fetch_add(p, v, __ATOMIC_RELAXED, __HIP_MEMORY_SCOPE_AGENT); }
__device__ __forceinline__ unsigned xb_xcc_id() { return (unsigned)__builtin_amdgcn_s_getreg((3 << 11) | 20) & 0xFu; }
#define XB_SPIN(cond, bar) do { unsigned _sp = 0; while (cond) { __builtin_amdgcn_s_sleep(1); \
    if ((++_sp & 255u) == 0u) { if (xb_ld(&(bar)[XB_TMO])) break; if (_sp > XB_SPIN_CAP) { atomicAdd(&(bar)[XB_TMO], 1u); break; } } } } while (0)

struct XcdBarrier {
    unsigned* bar; unsigned x;
    volatile LAS unsigned* st;
};
__device__ __forceinline__ XcdBarrier xcd_barrier_post(unsigned* bar, volatile LAS unsigned* st) {
    XcdBarrier b; b.bar = bar; b.x = xb_xcc_id(); b.st = st;
    if (threadIdx.x == 0) (void)xb_add(&bar[XB_XCNT(b.x)], 1u);
    return b;
}
__device__ __forceinline__ void xcd_barrier_complete(unsigned* bar, unsigned x, unsigned& nloc, unsigned& nx) {
    const unsigned G = gridDim.x * gridDim.y * gridDim.z;
    unsigned sum, cnt, mine, sp = 0u;
    for (;;) {
        sum = 0u; cnt = 0u; mine = 0u;
#pragma unroll
        for (unsigned j = 0; j < 16; ++j) { const unsigned c = xb_ld(&bar[XB_XCNT(j)]); sum += c; cnt += (c > 0u) ? 1u : 0u; mine = (j == x) ? c : mine; }
        if (sum == G) break;
        __builtin_amdgcn_s_sleep(1);
        if ((++sp & 255u) == 0u) { if (xb_ld(&bar[XB_TMO])) break; if (sp > XB_SPIN_CAP) { atomicAdd(&bar[XB_TMO], 1u); break; } }
    }
    nloc = mine > 0u ? mine : 1u; nx = cnt > 0u ? cnt : 1u;
}
__device__ __forceinline__ void xcd_barrier(const XcdBarrier& b) {
    asm volatile("s_waitcnt vmcnt(0)" ::: "memory");
    __syncthreads();
    if (threadIdx.x == 0) {
        unsigned* bar = b.bar;
        __builtin_amdgcn_s_waitcnt(0);
        unsigned nloc = b.st[0], nx = b.st[1];
        if (nloc == 0u) { xcd_barrier_complete(bar, b.x, nloc, nx); b.st[0] = nloc; b.st[1] = nx; }
        const unsigned old = xb_add(&bar[XB_XSUB(b.x)], 1u);
        const unsigned gen = old / nloc;
        if (old + 1u == (gen + 1u) * nloc) {
            __builtin_amdgcn_fence(__ATOMIC_RELEASE, "agent");
            asm volatile("s_waitcnt vmcnt(0)" ::: "memory");
            const unsigned og = xb_add(&bar[XB_TOP], 1u);
            const unsigned tg = og / nx;
            if (og + 1u == (tg + 1u) * nx) xb_add(&bar[XB_TOPGEN], 1u);
            else XB_SPIN(xb_ld(&bar[XB_TOPGEN]) == tg, bar);
            __builtin_amdgcn_fence(__ATOMIC_ACQUIRE, "agent");
            xb_add(&bar[XB_XGEN(b.x)], 1u);
            asm volatile("s_waitcnt vmcnt(0)" ::: "memory");
        } else {
            XB_SPIN(xb_ld(&bar[XB_XGEN(b.x)]) == gen, bar);
            __builtin_amdgcn_fence(__ATOMIC_ACQUIRE, "agent");
            asm volatile("s_waitcnt vmcnt(0)" ::: "memory");
        }
    }
    __syncthreads();
}
#include <hip/hip_bf16.h>
namespace attn_body {
using bf16=__hip_bfloat16;
using bf16x8=__attribute__((ext_vector_type(8)))short;
using s16x4=__attribute__((ext_vector_type(4)))short;
using f32x16=__attribute__((ext_vector_type(16)))float;
using u32x4=__attribute__((ext_vector_type(4)))unsigned;
constexpr int BATCH=2,NHEAD=4,SEQ=16384,DQ=96,DV=64,OPITCH=1024;
constexpr int NW=8,QBLK=32,QB=QBLK*NW,KVBLK=64,NQB=SEQ/QB;
__device__ __forceinline__ int crow(int r,int hi){return (r&3)+8*(r>>2)+4*hi;}
#define SBAR() __builtin_amdgcn_sched_barrier(0)
__device__ __forceinline__ void cmask(f32x16&p0,f32x16&p1,int jb,int qrel,int hi){
  const float NEG=-INFINITY; int qd=qrel-(64*jb+4*hi); asm volatile("":"+v"(qd));
  #pragma unroll
  for(int r=0;r<16;++r){const int c=(r&3)+8*(r>>2); if(c>qd)p0[r]=NEG; if(c+32>qd)p1[r]=NEG;}
}

constexpr int NSLOT=3, NSLOTK=4, KSLOTB=12288, VSLOTB=8192, QOB=4096;
constexpr int LDS_K=0, LDS_V=NSLOTK*KSLOTB, LDS_WS=LDS_V+NSLOT*VSLOTB, LDS_OST=LDS_WS+NW*64*4, LDS_BYTES=LDS_OST+NW*QOB;
__device__ __forceinline__ void glds16(const void*gsrc,unsigned lds_dst){unsigned keep;
  asm volatile("s_mov_b32 %0, m0\n\ts_mov_b32 m0, %2\n\ts_nop 0\n\tglobal_load_lds_dwordx4 %1, off\n\ts_mov_b32 m0, %0":"=&s"(keep):"v"(gsrc),"s"(lds_dst):"memory");}
__device__ __forceinline__ void swap32(float&a,float&b){asm volatile("s_nop 1\n\tv_permlane32_swap_b32 %0, %1\n\ts_nop 1":"+v"(a),"+v"(b));}
__device__ __forceinline__ float max3f(float a,float b,float c){float r;asm("v_max3_f32 %0, %1, %2, %3":"=v"(r):"v"(a),"v"(b),"v"(c));return r;}
__device__ __forceinline__ float max2f(float a,float b){float r;asm("v_max_f32_e32 %0, %1, %2":"=v"(r):"v"(a),"v"(b));return r;}
__device__ __forceinline__ float fadd_s(float a,float b){float r;asm("v_add_f32_e32 %0, %1, %2":"=v"(r):"v"(a),"v"(b));return r;}
__device__ __forceinline__ float fsub_s(float a,float b){float r;asm("v_sub_f32_e32 %0, %1, %2":"=v"(r):"v"(a),"v"(b));return r;}
typedef float f32x2_t __attribute__((ext_vector_type(2))); typedef __bf16 bf16x2_t __attribute__((ext_vector_type(2)));
__device__ __forceinline__ unsigned cvtpk_s(float lo,float hi){f32x2_t v={lo,hi};bf16x2_t b=__builtin_convertvector(v,bf16x2_t);return __builtin_bit_cast(unsigned,b);}
#define WAIT_BAR(N) asm volatile("s_waitcnt vmcnt(" #N ") lgkmcnt(0)\n\ts_barrier":::"memory")
#define WAIT_BAR2(NLO,NHI) do{ if(wid<4){WAIT_BAR(NLO);}else{WAIT_BAR(NHI);} }while(0)

__device__ __forceinline__ void qkt(f32x16&p0,f32x16&p1,const char*Kslot,const bf16x8*qr,int r32,int hi){
  const f32x16 zc=f32x16{};
  const char*kb=Kslot+hi*1024+r32*16;
  #pragma unroll
  for(int d0=0;d0<6;++d0){
    const bf16x8 b0=*reinterpret_cast<const bf16x8*>(kb+d0*2048);
    const bf16x8 b1=*reinterpret_cast<const bf16x8*>(kb+d0*2048+512);
    if(d0==0){p0=__builtin_amdgcn_mfma_f32_32x32x16_bf16(b0,qr[0],zc,0,0,0);p1=__builtin_amdgcn_mfma_f32_32x32x16_bf16(b1,qr[0],zc,0,0,0);}
    else{p0=__builtin_amdgcn_mfma_f32_32x32x16_bf16(b0,qr[d0],p0,0,0,0);p1=__builtin_amdgcn_mfma_f32_32x32x16_bf16(b1,qr[d0],p1,0,0,0);}}
}
typedef __attribute__((address_space(3))) const char* lds_cptr;
typedef short v4i16_t __attribute__((ext_vector_type(4)));
__device__ __forceinline__ void kload8(bf16x8*kf,lds_cptr kp){
  kf[0]=*(const __attribute__((address_space(3))) bf16x8*)(kp);      kf[1]=*(const __attribute__((address_space(3))) bf16x8*)(kp+512);
  kf[2]=*(const __attribute__((address_space(3))) bf16x8*)(kp+2048); kf[3]=*(const __attribute__((address_space(3))) bf16x8*)(kp+2560);
  kf[4]=*(const __attribute__((address_space(3))) bf16x8*)(kp+4096); kf[5]=*(const __attribute__((address_space(3))) bf16x8*)(kp+4608);
  kf[6]=*(const __attribute__((address_space(3))) bf16x8*)(kp+6144); kf[7]=*(const __attribute__((address_space(3))) bf16x8*)(kp+6656);
}
__device__ __forceinline__ void kload2(bf16x8*kf,lds_cptr kp,int j){ kf[2*j]=*(const __attribute__((address_space(3))) bf16x8*)(kp+j*2048); kf[2*j+1]=*(const __attribute__((address_space(3))) bf16x8*)(kp+j*2048+512); }
__device__ __forceinline__ s16x4 vtr(lds_cptr p){ return __builtin_bit_cast(s16x4,__builtin_amdgcn_ds_read_tr16_b64_v4i16((__attribute__((address_space(3))) v4i16_t*)p)); }
__device__ __forceinline__ float rowmax(const f32x16&p0,const f32x16&p1){
  float a=max3f(p0[0],p0[1],p1[0]),b=max3f(p0[2],p0[3],p1[1]);a=max3f(a,p1[2],p1[3]);
  #pragma unroll
  for(int r=4;r<16;r+=4){a=max3f(a,p0[r],p0[r+1]);b=max3f(b,p0[r+2],p0[r+3]);a=max3f(a,p1[r],p1[r+1]);b=max3f(b,p1[r+2],p1[r+3]);}
  float m=max2f(a,b),m2=m; swap32(m,m2);
  return max2f(m,m2);
}
__device__ __forceinline__ void pv(f32x16*o,int vb,bf16x8 pa0,bf16x8 pa1,bf16x8 pa2,bf16x8 pa3){
  #pragma unroll
  for(int d0=0;d0<2;++d0){s16x4 lo[4],hi[4];
    #pragma unroll
    for(int ks=0;ks<4;++ks){
      asm volatile("ds_read_b64_tr_b16 %0,%1 offset:%c2":"=&v"(lo[ks]):"v"(vb),"i"(d0*4096+ks*1024):"memory");
      asm volatile("ds_read_b64_tr_b16 %0,%1 offset:%c2":"=&v"(hi[ks]):"v"(vb),"i"(d0*4096+ks*1024+512):"memory");}
    asm volatile("s_waitcnt lgkmcnt(0)":::"memory");SBAR();
    #define PK(k) (bf16x8){lo[k][0],lo[k][1],lo[k][2],lo[k][3],hi[k][0],hi[k][1],hi[k][2],hi[k][3]}
    o[d0]=__builtin_amdgcn_mfma_f32_32x32x16_bf16(pa0,PK(0),o[d0],0,0,0);
    o[d0]=__builtin_amdgcn_mfma_f32_32x32x16_bf16(pa1,PK(1),o[d0],0,0,0);
    o[d0]=__builtin_amdgcn_mfma_f32_32x32x16_bf16(pa2,PK(2),o[d0],0,0,0);
    o[d0]=__builtin_amdgcn_mfma_f32_32x32x16_bf16(pa3,PK(3),o[d0],0,0,0);
    #undef PK
  }
}

#ifndef ATTN_STORE16
#define ATTN_STORE16(p,v) (*(u32x4*)(p)=(v))
#endif
template<int THRL> __device__ __forceinline__ void attn_unit(const int tid,int b,int h,int qb,const bf16*Q,const bf16*__restrict__ K,const bf16*__restrict__ V,bf16*O,char*shm){
  const int lane=tid&63,r32=lane&31,hi=lane>>5; const int wid=__builtin_amdgcn_readfirstlane(tid>>6);
  const long bhbase=(long)(b*NHEAD+h)*SEQ; const long rowbase=(long)b*SEQ; const int q0=qb*QB;
  const bf16*Qw=Q+(bhbase+q0+wid*QBLK)*DQ;
  const bf16*Kh=K+bhbase*DQ,*Vh=V+bhbase*DV;
  const unsigned lds0=(unsigned)(uintptr_t)shm;
  float*wsf=(float*)(shm+LDS_WS)+wid*64;
  const bf16*ksrc=Kh+(long)lane*DQ+wid*8;
  const bf16*vsrc=Vh+(long)(16*(wid&3)+(lane>>2))*DV+(wid>>2)*32+(lane&3)*8;
  const unsigned kdst=lds0+LDS_K+wid*1024, vdst=lds0+LDS_V+wid*1024;
  #define DMA_K(t,slot) do{ glds16(ksrc+(long)(t)*KVBLK*DQ,(unsigned)__builtin_amdgcn_readfirstlane(kdst+(slot))); if(wid<4) glds16(ksrc+(long)(t)*KVBLK*DQ+64,(unsigned)__builtin_amdgcn_readfirstlane(kdst+8192+(slot))); }while(0)
  #define DMA_V(t,slot) glds16(vsrc+(long)(t)*KVBLK*DV,(unsigned)__builtin_amdgcn_readfirstlane(vdst+(slot)))
  const int vb0=(int)(lds0+LDS_V)+((lane>>4)&1)*32+(lane&3)*8+(4*hi+((lane&15)>>2))*64;
  const char*Kbase=shm+LDS_K; bf16x8 kf[12];
  const lds_cptr shm3=(lds_cptr)shm; const lds_cptr kp0=shm3+LDS_K+hi*1024+r32*16; const lds_cptr vp0=shm3+LDS_V+((lane>>4)&1)*32+(lane&3)*8+(4*hi+((lane&15)>>2))*64;
  const int NT=(q0+QB)/KVBLK;
  DMA_K(0,0);DMA_V(0,0);DMA_K(1,KSLOTB);
  bf16x8 qr[6];
  #pragma unroll
  for(int d0=0;d0<6;++d0)qr[d0]=*reinterpret_cast<const bf16x8*>(&Qw[(long)r32*DQ+d0*16+hi*8]);
  float mhat=0.f,l_reg=0.f;f32x16 o[2];o[0]=f32x16{};o[1]=f32x16{};const f32x16 zc=f32x16{};
  const int qrel=wid*QBLK+r32;
  #define CMASK(P0,P1,t) do{int jb_=(t)-(NT-4); if(jb_>=0)cmask(P0,P1,jb_,qrel,hi);}while(0)
  bool resc=false;
  #define START(P0,P1) do{ const float rm=rowmax(P0,P1); resc=false; \
    { const float dl=rm; mhat=fadd_s(mhat,dl); \
      _Pragma("unroll") for(int r=0;r<16;++r){P0[r]=fsub_s(P0[r],dl);P1[r]=fsub_s(P1[r],dl);} } \
    _Pragma("unroll") for(int r=0;r<16;++r)P0[r]=__builtin_amdgcn_exp2f(P0[r]); }while(0)
  #define RESC() do{ if(resc){ asm volatile("s_waitcnt lgkmcnt(0)":::"memory"); const float*wl_=wsf+4*hi; asm volatile("":"+v"(wl_)); \
      _Pragma("unroll") for(int d_=0;d_<2;++d_) _Pragma("unroll") for(int r=0;r<16;++r)o[d_][r]*=wl_[crow(r,0)]; } }while(0)
  f32x16 pA0,pA1,pB0,pB1;
  int kprev=3*KSLOTB,kcur=0,knext=KSLOTB, vprev=0,vcur=0,vnext=VSLOTB;
  #define ROT() do{kprev=kcur;kcur=knext;knext=(knext==(NSLOTK-1)*KSLOTB)?0:knext+KSLOTB; vprev=vcur;vcur=vnext;vnext=(vnext==(NSLOT-1)*VSLOTB)?0:vnext+VSLOTB;}while(0)
  DMA_K(2,2*KSLOTB);
  WAIT_BAR2(5,3);
  qkt(pA0,pA1,Kbase,qr,r32,hi);asm volatile("s_nop 15\n\ts_nop 7":"+v"(pA0),"+v"(pA1));CMASK(pA0,pA1,0);
  START(pA0,pA1);
  _Pragma("unroll") for(int r=0;r<16;++r)pA1[r]=__builtin_amdgcn_exp2f(pA1[r]);
  WAIT_BAR(0);
  DMA_K(3,3*KSLOTB);DMA_V(1,VSLOTB);
  ROT();
  kload2(kf,kp0+kcur,0); kload2(kf,kp0+kcur,1); kload2(kf,kp0+kcur,2); kload2(kf,kp0+kcur,3); kload2(kf,kp0+kcur,4); kload2(kf,kp0+kcur,5);
  WAIT_BAR2(3,2);
  s16x4 vlo[8],vhi[8]; u32x4 pw0,pw1,pw2,pw3;
  #define PKW(P,B) cvtpk_s(P[B],P[B+1])
  #define PAF(k) __builtin_bit_cast(bf16x8,pw##k)
  #define VFR(i) (bf16x8){vlo[i][0],vlo[i][1],vlo[i][2],vlo[i][3],vhi[i][0],vhi[i][1],vhi[i][2],vhi[i][3]}
  #define PIN(x) asm volatile("":"+v"(x))
  #define MX3(a,b,c) __builtin_fmaxf(__builtin_fmaxf((a),(b)),(c))
  #define GAPA(MF,A0,A1,A2,A3,W0,W1,PW) do{ MF; sacc+=A0; sacc+=A1; sacc+=A2; sacc+=A3; PIN(sacc); W0; W1; PIN(PW); SBAR(); }while(0)
  #define EX(v) __builtin_amdgcn_exp2f(v)
  #define GAPB(MF,X,B) do{ MF; X[B]=EX(X[B]-mhat); X[B+1]=EX(X[B+1]-mhat); X[B+2]=EX(X[B+2]-mhat); X[B+3]=EX(X[B+3]-mhat); PIN(X); SBAR(); }while(0)
  #define VRD(i) do{ vlo[i]=vtr(vp_+(((i)>>2)*4096+((i)&3)*1024)); vhi[i]=vtr(vp_+(((i)>>2)*4096+((i)&3)*1024+512)); }while(0)
  #define KRD(G,j) do{ if(G){ kload2(kf,kp0+knext,j); SBAR(); } }while(0)
  #define STEP(C0,C1,P0,P1,t,GK,GV,GL) do{ SBAR(); \
    const lds_cptr vp_=vp0+vprev; float sacc=(P0[0]+P0[1]); \
    GAPA(C0=__builtin_amdgcn_mfma_f32_32x32x16_bf16(kf[0],qr[0],zc,0,0,0), P0[2],P0[3],P0[4],P0[5],     pw0[0]=PKW(P0,0), pw0[1]=PKW(P0,2), pw0); \
    GAPA(C1=__builtin_amdgcn_mfma_f32_32x32x16_bf16(kf[1],qr[0],zc,0,0,0), P0[6],P0[7],P0[8],P0[9],     pw0[2]=PKW(P0,4), pw0[3]=PKW(P0,6), pw0); \
    GAPA(C0=__builtin_amdgcn_mfma_f32_32x32x16_bf16(kf[2],qr[1],C0,0,0,0),   P0[10],P0[11],P0[12],P0[13], pw1[0]=PKW(P0,8), pw1[1]=PKW(P0,10), pw1); \
    GAPA(C1=__builtin_amdgcn_mfma_f32_32x32x16_bf16(kf[3],qr[1],C1,0,0,0),   P0[14],P0[15],P1[0],P1[1],   pw1[2]=PKW(P0,12),pw1[3]=PKW(P0,14), pw1); \
    GAPA(C0=__builtin_amdgcn_mfma_f32_32x32x16_bf16(kf[4],qr[2],C0,0,0,0),   P1[2],P1[3],P1[4],P1[5],     pw2[0]=PKW(P1,0), pw2[1]=PKW(P1,2), pw2); \
    GAPA(C1=__builtin_amdgcn_mfma_f32_32x32x16_bf16(kf[5],qr[2],C1,0,0,0),   P1[6],P1[7],P1[8],P1[9],     pw2[2]=PKW(P1,4), pw2[3]=PKW(P1,6), pw2); \
    GAPA(C0=__builtin_amdgcn_mfma_f32_32x32x16_bf16(kf[6],qr[3],C0,0,0,0),   P1[10],P1[11],P1[12],P1[13], pw3[0]=PKW(P1,8), pw3[1]=PKW(P1,10), pw3); \
    GAPA(C1=__builtin_amdgcn_mfma_f32_32x32x16_bf16(kf[7],qr[3],C1,0,0,0),   P1[14],P1[15],0.f,0.f,       pw3[2]=PKW(P1,12),pw3[3]=PKW(P1,14), pw3); \
    VRD(0); C0=__builtin_amdgcn_mfma_f32_32x32x16_bf16(kf[8],qr[4],C0,0,0,0); C1=__builtin_amdgcn_mfma_f32_32x32x16_bf16(kf[9],qr[4],C1,0,0,0); SBAR(); \
    VRD(4); C0=__builtin_amdgcn_mfma_f32_32x32x16_bf16(kf[10],qr[5],C0,0,0,0); C1=__builtin_amdgcn_mfma_f32_32x32x16_bf16(kf[11],qr[5],C1,0,0,0); SBAR(); \
    l_reg+=sacc; \
    if(GK){DMA_K((t)+3,kprev);} if(GV){DMA_V((t)+1,vnext);} \
    CMASK(C0,C1,t); \
    { float a=MX3(C0[0],C0[1],C1[0]),b=MX3(C0[2],C0[3],C1[1]); a=MX3(a,C1[2],C1[3]); \
      _Pragma("unroll") for(int r=4;r<16;r+=4){a=MX3(a,C0[r],C0[r+1]);b=MX3(b,C0[r+2],C0[r+3]);a=MX3(a,C1[r],C1[r+1]);b=MX3(b,C1[r+2],C1[r+3]);} \
      float rm=__builtin_fmaxf(a,b), rm2=rm; swap32(rm,rm2); rm=__builtin_fmaxf(rm,rm2)-mhat; \
      resc=false; \
      if(__builtin_expect(__any(rm>(float)THRL),0)){ const float dl=__builtin_fmaxf(rm,0.f); mhat+=dl; \
        const float f=__builtin_amdgcn_exp2f(-dl); l_reg*=f; if(hi==0)wsf[r32]=f; resc=true; } } \
    SBAR(); \
    VRD(1); SBAR(); GAPB(o[0]=__builtin_amdgcn_mfma_f32_32x32x16_bf16(PAF(0),VFR(0),o[0],0,0,0), C0,0); \
    KRD(GL,0); VRD(5); SBAR(); GAPB(o[1]=__builtin_amdgcn_mfma_f32_32x32x16_bf16(PAF(0),VFR(4),o[1],0,0,0), C0,4); \
    KRD(GL,1); VRD(2); SBAR(); GAPB(o[0]=__builtin_amdgcn_mfma_f32_32x32x16_bf16(PAF(1),VFR(1),o[0],0,0,0), C0,8); \
    KRD(GL,2); VRD(6); SBAR(); GAPB(o[1]=__builtin_amdgcn_mfma_f32_32x32x16_bf16(PAF(1),VFR(5),o[1],0,0,0), C0,12); \
    KRD(GL,3); VRD(3); SBAR(); GAPB(o[0]=__builtin_amdgcn_mfma_f32_32x32x16_bf16(PAF(2),VFR(2),o[0],0,0,0), C1,0); \
    KRD(GL,4); VRD(7); SBAR(); GAPB(o[1]=__builtin_amdgcn_mfma_f32_32x32x16_bf16(PAF(2),VFR(6),o[1],0,0,0), C1,4); \
    KRD(GL,5); GAPB(o[0]=__builtin_amdgcn_mfma_f32_32x32x16_bf16(PAF(3),VFR(3),o[0],0,0,0), C1,8); \
    GAPB(o[1]=__builtin_amdgcn_mfma_f32_32x32x16_bf16(PAF(3),VFR(7),o[1],0,0,0), C1,12); \
    }while(0)
  int t=1;
  #undef CMASK
  #define CMASK(P0,P1,t) do{}while(0)
  for(;t+5<NT;t+=2){
    STEP(pB0,pB1,pA0,pA1,t,true,true,true);     WAIT_BAR2(3,2); RESC(); ROT();
    STEP(pA0,pA1,pB0,pB1,t+1,true,true,true);   WAIT_BAR2(3,2); RESC(); ROT();
  }
  #undef CMASK
  #define CMASK(P0,P1,t) do{int jb_=(t)-(NT-4); if(jb_>=0)cmask(P0,P1,jb_,qrel,hi);}while(0)
  #define ENDW(tt) do{ if((tt)+3<NT){WAIT_BAR2(3,2);} else if((tt)+2<NT){WAIT_BAR(1);} else {WAIT_BAR(0);} }while(0)
  for(;t+1<NT;t+=2){
    STEP(pB0,pB1,pA0,pA1,t,(t+3<NT),(t+1<NT),(t+1<NT));       ENDW(t);   RESC(); ROT();
    STEP(pA0,pA1,pB0,pB1,t+1,(t+4<NT),(t+2<NT),(t+2<NT));     ENDW(t+1); RESC(); ROT();
  }
  STEP(pB0,pB1,pA0,pA1,NT-1,false,false,false); RESC();
  { float sacc=pB0[0]+pB0[1]; _Pragma("unroll") for(int r=2;r<16;++r)sacc+=pB0[r]; _Pragma("unroll") for(int r=0;r<16;++r)sacc+=pB1[r]; l_reg+=sacc;
    pw0=(u32x4){PKW(pB0,0),PKW(pB0,2),PKW(pB0,4),PKW(pB0,6)};pw1=(u32x4){PKW(pB0,8),PKW(pB0,10),PKW(pB0,12),PKW(pB0,14)};pw2=(u32x4){PKW(pB1,0),PKW(pB1,2),PKW(pB1,4),PKW(pB1,6)};pw3=(u32x4){PKW(pB1,8),PKW(pB1,10),PKW(pB1,12),PKW(pB1,14)};
    SBAR(); pv(o,vb0+vcur,PAF(0),PAF(1),PAF(2),PAF(3)); }
  #undef PKW
  #undef PAF
  #undef VFR
  #undef PIN
  #undef MX3
  #undef GAPA
  #undef GAPB
  #undef EX
  #undef VRD
  #undef KRD
  #undef STEP
  #undef ENDW
  {float l2=l_reg; swap32(l_reg,l2); l_reg=l_reg+l2;}
  if(hi==0)wsf[32+r32]=l_reg;asm volatile("s_waitcnt lgkmcnt(0)":::"memory");
  float rli[16]; { const float*wl_=wsf+32+4*hi; asm volatile("":"+v"(wl_));
  #pragma unroll
  for(int r=0;r<16;++r)rli[r]=__builtin_amdgcn_rcpf(wl_[crow(r,0)]); }
  bf16*Ow=O+(rowbase+q0+wid*QBLK)*OPITCH+h*DV;
  { bf16*stg=(bf16*)(shm+LDS_OST+wid*QOB);
    { bf16*stw=stg+(4*hi)*64+r32; asm volatile("":"+v"(stw));
    #pragma unroll
    for(int r=0;r<16;++r){const int orow=crow(r,0);
      #pragma unroll
      for(int d0=0;d0<2;++d0)stw[orow*64+d0*32]=__float2bfloat16(o[d0][r]*rli[r]);} }
    asm volatile("s_waitcnt lgkmcnt(0)":::"memory");
    #pragma unroll
    for(int i=0;i<4;++i){const int row=i*8+(lane>>3),ch=lane&7; const u32x4 v=*(const u32x4*)(stg+row*64+ch*8); ATTN_STORE16(Ow+(long)row*OPITCH+ch*8,v);} }
  asm volatile("s_waitcnt lgkmcnt(0)\n\ts_barrier":::"memory");
  #undef DMA_K
  #undef DMA_V
  #undef CMASK
  #undef START
  #undef RESC
  #undef ROT
}
constexpr int ATTN_LDS_BYTES=LDS_BYTES;
#undef SBAR
#undef WAIT_BAR
#undef WAIT_BAR2
}

constexpr int NWAVES = 8, NTHR = 512;
constexpr int BATCH = 2, SEQ = 16384, DM = 1024, T = BATCH * SEQ;
constexpr int D_IN = 2736, D_INP = 2816;
constexpr int U_CQ = 0, U_CKV = 256, U_KR = 384, U_Z = 416, U_XBC = 928, U_DT = 1696;
constexpr int U_GQKV = 1704, U_GZ = 2472, U_GB = 2728, U_GA = 2732;
constexpr int DFF = 2816, DFFE = 3584, NEXP = 8;
constexpr float EPS = 1e-6f;
constexpr float QSCALE = 0.10206207261596577f * 1.4426950408889634f;

constexpr size_t MiB = 1u << 20;
constexpr size_t WS_CTL = 0, CTL_ZERO_BYTES = 32 * 1024;
constexpr size_t WS_MODP = 1 * MiB;
constexpr size_t WS_PARTA = WS_MODP, WS_PARTB = WS_MODP + 512 * 1024;
constexpr size_t WS_BIASF = WS_MODP + 1 * MiB, WS_BIASW = WS_BIASF + 64 * 1024;
constexpr size_t WS_MOD = 2 * MiB + 512 * 1024;
constexpr size_t WS_ROWTOK = 3 * MiB;
constexpr size_t WS_TOKSLOT = 4 * MiB;
constexpr size_t WS_TOKW = 4 * MiB + 256 * 1024;
constexpr size_t WS_DT = 5 * MiB;
constexpr size_t WS_BG = 6 * MiB;
constexpr size_t WS_W = 8 * MiB;
constexpr size_t WS_WIN = WS_W;
constexpr size_t WS_WOUT = WS_WIN + 11 * MiB;
constexpr size_t WS_FUP = WS_WOUT + 4 * MiB;
constexpr size_t WS_FDN = WS_FUP + 11 * MiB;
constexpr size_t WS_WQ = WS_FDN + 5 * MiB + 512 * 1024;
constexpr size_t WS_WKV = WS_WQ + 512 * 1024;
constexpr size_t WS_O = 42 * MiB;
constexpr size_t WS_U = 106 * MiB;
constexpr size_t WS_HID = WS_U + 51 * MiB;
constexpr size_t WS_Y = WS_W;
constexpr size_t WS_H = 282 * MiB;
constexpr size_t WS_M = 346 * MiB;
constexpr size_t WS_MUP = WS_M, WS_MDN = WS_M + 112 * MiB;
constexpr size_t WS_H8 = WS_MUP + 56 * MiB;
constexpr float FP8_SA = 8.0f, FP8_SW = 64.0f;
constexpr size_t WS_Q = WS_M;
constexpr size_t WS_FUPS = WS_M, WS_WINS = WS_M + 22 * MiB;
constexpr size_t WS_K = WS_Q + 24 * MiB;
constexpr size_t WS_V = WS_K + 24 * MiB;
constexpr size_t WS_XS = WS_V + 16 * MiB;
constexpr size_t WS_SST = WS_XS, WS_CS = WS_XS + 32 * MiB;
constexpr size_t WS_GF = WS_XS + 48 * MiB;
constexpr size_t WS_OR = WS_GF + 80 * MiB;
constexpr size_t WS_ROPE = WS_OR + 32 * MiB;
constexpr size_t WS_END = WS_ROPE + 2 * MiB;
static_assert(WS_Y + (size_t)264 * 256 * 1024 * 2 <= WS_HID, "y vs hid");
constexpr size_t HID_STRIDE = 62 * MiB + 512 * 1024;
static_assert((size_t)71 * 256 * 3584 <= HID_STRIDE && WS_HID + 2 * HID_STRIDE <= WS_H, "hid vs h");
static_assert(WS_FDN + (size_t)1024 * 2816 * 2 <= WS_WQ && WS_WKV + 256 * 1024 <= WS_O, "weights vs o");
constexpr int CW_TMO = 0, CW_MOECNT = 64, CW_ATTQ = 640, CW_BAR = 4096;

constexpr int LDS_BYTES = 147456, RING_BYTES = 131072, MISC_OFF = RING_BYTES + 320;

struct Args { const float* in[29]; float* out; unsigned char* ws; int ph_lo, ph_hi; };

struct Frame { LAS unsigned char* lds; volatile LAS unsigned* MISC; int tid, lane, wave, vcu, G, gw, NGW; };
__device__ __forceinline__ const float* P(const Frame& F, int i) { const unsigned lo = __builtin_amdgcn_readfirstlane(F.MISC[64 + 2 * i]), hi = __builtin_amdgcn_readfirstlane(F.MISC[65 + 2 * i]);
    return (const float*)(const GAS float*)(((unsigned long long)hi << 32) | lo); }
__device__ __forceinline__ unsigned char* WSP(const Frame& F) { return (unsigned char*)P(F, 29); }
__device__ __forceinline__ float* OUTP(const Frame& F) { return (float*)P(F, 30); }


__device__ __forceinline__ Frame reframe(const Frame& F0) { Frame F = F0; int ln; unsigned lb = 0;
    asm volatile("v_mbcnt_lo_u32_b32 %0, -1, 0\n\tv_mbcnt_hi_u32_b32 %0, -1, %0" : "=v"(ln));
    asm volatile("" : "+s"(lb));
    F.lds = F0.lds + lb; F.MISC = (volatile LAS unsigned*)(F.lds + MISC_OFF);
    int vcv = F0.vcu; asm volatile("" : "+s"(vcv)); F.vcu = vcv;
    int gwv = F.vcu * NWAVES + F.wave; asm volatile("" : "+s"(gwv));
    F.lane = ln; F.tid = F.wave * 64 + ln; F.gw = gwv; return F; }
__device__ __forceinline__ int opq(int v) { asm volatile("" : "+s"(v)); return v; }
#define SWZ(v, k) __builtin_bit_cast(float, __builtin_amdgcn_ds_swizzle(__builtin_bit_cast(int, (v)), ((k) << 10) | 0x1f))
template <int CTRL> __device__ __forceinline__ float dppf(float v) { return __builtin_bit_cast(float, __builtin_amdgcn_update_dpp(0, __builtin_bit_cast(int, v), CTRL, 0xf, 0xf, true)); }
__device__ __forceinline__ float sum16(float v) { v += dppf<0xB1>(v); v += dppf<0x4E>(v); v += dppf<0x141>(v); v += dppf<0x140>(v); return v; }
__device__ __forceinline__ float max16(float v) { v = fmaxf(v, dppf<0xB1>(v)); v = fmaxf(v, dppf<0x4E>(v)); v = fmaxf(v, dppf<0x141>(v)); v = fmaxf(v, dppf<0x140>(v)); return v; }
#define RDL(v, k) __builtin_bit_cast(float, __builtin_amdgcn_readlane(__builtin_bit_cast(int, (v)), (k)))
__device__ __forceinline__ float wave_sum(float v) { v = sum16(v); return (RDL(v, 0) + RDL(v, 16)) + (RDL(v, 32) + RDL(v, 48)); }
__device__ __forceinline__ float wave_max(float v) { v = max16(v); return fmaxf(fmaxf(RDL(v, 0), RDL(v, 16)), fmaxf(RDL(v, 32), RDL(v, 48))); }
__device__ __forceinline__ float rcp_f(float x) { return __builtin_amdgcn_rcpf(x); }
__device__ __forceinline__ float rsq_f(float x) { return __builtin_amdgcn_rsqf(x); }
__device__ __forceinline__ float exp_f(float x) { return __builtin_amdgcn_exp2f(x * 1.4426950408889634f); }
__device__ __forceinline__ float silu_f(float x) { return x * rcp_f(1.f + exp_f(-x)); }
__device__ __forceinline__ float sigmoid_f(float x) { return rcp_f(1.f + exp_f(-x)); }
__device__ __forceinline__ float softplus_f(float x) { const float e = exp_f(-fabsf(x));
    const float l = (e < 0.01f) ? e * (1.f - e * (0.5f - e * 0.33333334f)) : __builtin_amdgcn_logf(1.f + e) * 0.6931471805599453f;
    return fmaxf(x, 0.f) + l; }

__device__ __forceinline__ void tr_block(const float* W, int ldw, int nvalid, int k0, int n0, bf16* WT, int ldt, int drow0, LAS float* scr, int lane, const float* kscale = nullptr) {
    const int col = n0 + (lane & 31);
#pragma unroll 8
    for (int i = 0; i < 32; ++i) { const int kk = 2 * i + (lane >> 5); float v = (col < nvalid) ? W[(size_t)(k0 + kk) * ldw + col] : 0.f; if (kscale) v *= kscale[k0 + kk]; scr[kk * 33 + (lane & 31)] = v; }
    LDS_WAIT(); asm volatile("" ::: "memory");
    const int c = lane & 7;
#pragma unroll
    for (int j = 0; j < 4; ++j) { const int n = (lane >> 3) + 8 * j; const LAS float* s = scr + (8 * c) * 33 + n;
        v4u o; o.x = pk2(s[0 * 33], s[1 * 33]); o.y = pk2(s[2 * 33], s[3 * 33]); o.z = pk2(s[4 * 33], s[5 * 33]); o.w = pk2(s[6 * 33], s[7 * 33]);
        *(GAS v4u*)(WT + (size_t)(drow0 + n) * ldt + k0 + 8 * c) = o; }
    LDS_WAIT(); asm volatile("" ::: "memory");
}

__device__ __forceinline__ void ph_prologue(const Frame& F, const Args& a) {
    unsigned char* const ws = WSP(F);
    const float* c = P(F, 1); const float* ada_w = P(F, 2);
    { float* mod = (float*)(ws + WS_MOD); const float* ada_b = P(F, 3); LAS float* red = (LAS float*)(F.lds + 131072 - 8192);
      for (int it = F.vcu; it < 2 * 96; it += F.G) { const int l = it / 96, cb = it % 96, col = cb * 64 + F.lane;
        const float* w = ada_w + (size_t)l * 1024 * 6144 + (size_t)(F.wave * 128) * 6144 + col;
        float a0 = 0.f, a1 = 0.f;
#pragma unroll 8
        for (int k = 0; k < 128; ++k) { const float wv = w[(size_t)k * 6144]; const int kk = F.wave * 128 + k; a0 += silu_f(c[kk]) * wv; a1 += silu_f(c[1024 + kk]) * wv; }
        red[(F.wave * 2 + 0) * 64 + F.lane] = a0; red[(F.wave * 2 + 1) * 64 + F.lane] = a1;
        __syncthreads();
        if (F.tid < 128) { const int b = F.tid >> 6, cl = F.tid & 63; float sacc = ada_b[l * 6144 + cb * 64 + cl];
#pragma unroll
            for (int wv = 0; wv < 8; ++wv) sacc += red[(wv * 2 + b) * 64 + cl];
            mod[(size_t)(l * 2 + b) * 6144 + cb * 64 + cl] = sacc; }
        __syncthreads(); } }
    LAS float* scr = (LAS float*)(F.lds + F.wave * 16384);
    bf16* WIN = (bf16*)(ws + WS_WIN); bf16* WOUT = (bf16*)(ws + WS_WOUT); bf16* FUP = (bf16*)(ws + WS_FUP); bf16* FDN = (bf16*)(ws + WS_FDN);
    constexpr int NB_IN = 16 * 88, NB_OUT = 16 * 32, NB_F = 16 * 88, NB_FD = 44 * 32;
    constexpr int NB_Q = 4 * 16, NB_KV = 2 * 16;
    constexpr int NITEMS = 2 * NB_IN + 2 * NB_OUT + 2 * NB_F + NB_FD + 2 * NB_Q + 2 * NB_KV;
    for (int it = F.gw; it < NITEMS; it += F.NGW) {
        int r = it;
        if (r < 2 * NB_IN) { const int l = r / NB_IN; r %= NB_IN; const int kb = r / 88, nb = r % 88;
            tr_block(P(F, 4) + (size_t)l * 1024 * D_IN, D_IN, D_IN, kb * 64, nb * 32, WIN + (size_t)l * D_INP * 1024, 1024, nb * 32, scr, F.lane); continue; }
        r -= 2 * NB_IN;
        if (r < 2 * NB_OUT) { const int l = r / NB_OUT; r %= NB_OUT; const int kb = r / 32, nb = r % 32;
            tr_block(P(F, 20) + (size_t)l * 1024 * 1024, 1024, 1024, kb * 64, nb * 32, WOUT + (size_t)l * 1024 * 1024, 1024, nb * 32, scr, F.lane); continue; }
        r -= 2 * NB_OUT;
        if (r < 2 * NB_F) { const int which = r / NB_F; r %= NB_F; const int kb = r / 88, nb = r % 88, n0 = nb * 32;
            tr_block(P(F, 21 + which), DFF, DFF, kb * 64, n0, FUP, 1024, 256 * (n0 / 128) + 128 * which + (n0 % 128), scr, F.lane); continue; }
        r -= 2 * NB_F;
        if (r < NB_FD) { const int kb = r / 32, nb = r % 32; tr_block(P(F, 23), 1024, 1024, kb * 64, nb * 32, FDN, DFF, nb * 32, scr, F.lane); continue; }
        r -= NB_FD;
        if (r < 2 * NB_Q) { const int l = r / NB_Q; r %= NB_Q; const int kb = r / 16, nb = r % 16;
            tr_block(P(F, 6) + (size_t)l * 256 * 384, 384, 384, kb * 64, nb * 32, (bf16*)(ws + WS_WQ) + (size_t)l * 512 * 256, 256, nb * 32, scr, F.lane, P(F, 5) + l * 256); continue; }
        r -= 2 * NB_Q;
        { const int l = r / NB_KV; r %= NB_KV; const int kb = r / 16, nb = r % 16;
            tr_block(P(F, 8) + (size_t)l * 128 * 512, 512, 512, kb * 64, nb * 32, (bf16*)(ws + WS_WKV) + (size_t)l * 512 * 128, 128, nb * 32, scr, F.lane, P(F, 7) + l * 128); }
    }
    { float* RT = (float*)(ws + WS_ROPE);
      for (int id = F.vcu * NTHR + F.tid; id < SEQ * 16; id += F.G * NTHR) { const int s = id >> 4, sub = id & 15;
        const float inv_freq = sub == 0 ? 1.0f : sub == 1 ? 0.5623413251903491f : sub == 2 ? 0.31622776601683794f : sub == 3 ? 0.1778279410038923f : sub == 4 ? 0.1f : sub == 5 ? 0.05623413251903491f
            : sub == 6 ? 0.031622776601683794f : sub == 7 ? 0.01778279410038923f : sub == 8 ? 0.01f : sub == 9 ? 0.005623413251903491f : sub == 10 ? 0.0031622776601683794f : sub == 11 ? 0.001778279410038923f
            : sub == 12 ? 0.001f : sub == 13 ? 0.0005623413251903491f : sub == 14 ? 0.00031622776601683794f : 0.0001778279410038923f;
        const float ang = (float)s * inv_freq; double rev = (double)ang * 0.15915494309189535; rev -= floor(rev); const float rf = (float)rev;
        RT[2 * id] = __builtin_amdgcn_cosf(rf); RT[2 * id + 1] = __builtin_amdgcn_sinf(rf); } }
}
__device__ __forceinline__ void ph_modreduce(const Frame& F, const Args& a) {
    unsigned char* const ws = WSP(F);
    const float* modp = (const float*)(ws + WS_MODP); float* mod = (float*)(ws + WS_MOD); const float* ada_b = P(F, 3);
    for (int idx = F.vcu * NTHR + F.tid; idx < 2 * 2 * 6144; idx += F.G * NTHR) {
        const int l = idx / 12288, r = idx % 12288, col = r % 6144;
        float s = ada_b[l * 6144 + col];
#pragma unroll
        for (int ks = 0; ks < 16; ++ks) s += modp[(size_t)(l * 16 + ks) * 12288 + r];
        mod[idx] = s;
    }
}
__device__ __forceinline__ void norm_row_load(const void* xbase, size_t row, bool isbf, int lane, f32x4 (&v)[4]) {
    if (isbf) { const GAS v2u* xr = (const GAS v2u*)((const bf16*)xbase + row * DM) + lane;
#pragma unroll
        for (int j = 0; j < 4; ++j) { const v2u w = xr[64 * j]; v[j] = (f32x4){bflo(w.x), bfhi(w.x), bflo(w.y), bfhi(w.y)}; } }
    else { const GAS f32x4* xr = (const GAS f32x4*)((const float*)xbase + row * DM) + lane;
#pragma unroll
        for (int j = 0; j < 4; ++j) v[j] = xr[64 * j]; }
}
template <bool STORE = true> __device__ __forceinline__ void norm_mod_apply(const f32x4 (&v)[4], bf16* hrow, const float* sh, const float* sc, int lane, f32x4 (&hv)[4]) {
    float s = 0.f;
#pragma unroll
    for (int j = 0; j < 4; ++j) s += (v[j].x * v[j].x + v[j].y * v[j].y) + (v[j].z * v[j].z + v[j].w * v[j].w);
    const float rstd = rsq_f(wave_sum(s) * (1.f / 1024.f) + EPS);
    GAS v2u* o8 = (GAS v2u*)hrow + lane;
#pragma unroll
    for (int j = 0; j < 4; ++j) { const f32x4 s4 = ((const GAS f32x4*)sh)[lane + 64 * j], c4 = ((const GAS f32x4*)sc)[lane + 64 * j];
        const f32x4 h = v[j] * rstd * (c4 + 1.0f) + s4; hv[j] = h; if (STORE) { v2u w; w.x = pk2(h.x, h.y); w.y = pk2(h.z, h.w); o8[64 * j] = w; } }
}
__device__ __forceinline__ void ph_normmod(const Frame& F, const Args& a, const void* src, bool isbf, int l, int which  ) {
    unsigned char* const ws = WSP(F);
    const float* mod = (const float*)(ws + WS_MOD) + (size_t)l * 12288; bf16* H = (bf16*)(ws + WS_H);
    const int lane = F.lane, m0 = F.gw, st = F.NGW;
    f32x4 va[4], vb[4], vc[4];
    if (m0 < T) norm_row_load(src, (size_t)m0, isbf, lane, va);
    if (m0 + st < T) norm_row_load(src, (size_t)(m0 + st), isbf, lane, vb);
#pragma unroll 1
    for (int m = m0; m < T; m += st) { const int b = m / SEQ; f32x4 hv[4];
        if (m + 2 * st < T) norm_row_load(src, (size_t)(m + 2 * st), isbf, lane, vc);
        norm_mod_apply(va, H + (size_t)m * DM, mod + b * 6144 + which * 3072, mod + b * 6144 + which * 3072 + 1024, lane, hv);
#pragma unroll
        for (int j = 0; j < 4; ++j) { va[j] = vb[j]; vb[j] = vc[j]; } }
}

__device__ __forceinline__ void ph_mla(const Frame& F, const Args& a, int l) {
    unsigned char* const ws = WSP(F);
    const bf16* U = (const bf16*)(ws + WS_U); bf16* Qb = (bf16*)(ws + WS_Q); bf16* Kb = (bf16*)(ws + WS_K); bf16* Vb = (bf16*)(ws + WS_V); const float* RT = (const float*)(ws + WS_ROPE);
    LAS float* rs = (LAS float*)(F.lds + RING_BYTES + 4096);
    pg8::StaticOrder S; S.init(T, 512, F.G, (int)blockIdx.x);
    for (int ui = 0; ; ++ui) {
        pg8::Unit u; if (!S.next(ui, u)) break;
        { const int r = F.tid >> 1, hf = F.tid & 1, row = u.pm * 256 + r, b = row / SEQ, s = row % SEQ; const bf16* ur = U + (size_t)row * D_INP;
          float sq = 0.f, sk = 0.f;
#pragma unroll
          for (int j = 0; j < 16; ++j) { const v4u w = *(const v4u*)(ur + U_CQ + hf * 128 + j * 8); sq += bflo(w.x) * bflo(w.x) + bfhi(w.x) * bfhi(w.x) + bflo(w.y) * bflo(w.y) + bfhi(w.y) * bfhi(w.y) + bflo(w.z) * bflo(w.z) + bfhi(w.z) * bfhi(w.z) + bflo(w.w) * bflo(w.w) + bfhi(w.w) * bfhi(w.w); }
#pragma unroll
          for (int j = 0; j < 8; ++j) { const v4u w = *(const v4u*)(ur + U_CKV + hf * 64 + j * 8); sk += bflo(w.x) * bflo(w.x) + bfhi(w.x) * bfhi(w.x) + bflo(w.y) * bflo(w.y) + bfhi(w.y) * bfhi(w.y) + bflo(w.z) * bflo(w.z) + bfhi(w.z) * bfhi(w.z) + bflo(w.w) * bflo(w.w) + bfhi(w.w) * bfhi(w.w); }
          sq += SWZ(sq, 1); sk += SWZ(sk, 1);
          if (hf == 0) { rs[r] = rsq_f(sq * (1.f / 256.f) + EPS); rs[256 + r] = rsq_f(sk * (1.f / 128.f) + EPS); }
          const v4u wa = *(const v4u*)(ur + U_KR + hf * 8), wb = *(const v4u*)(ur + U_KR + 16 + hf * 8);
          float t1[8] = {bflo(wa.x), bfhi(wa.x), bflo(wa.y), bfhi(wa.y), bflo(wa.z), bfhi(wa.z), bflo(wa.w), bfhi(wa.w)}, t2[8] = {bflo(wb.x), bfhi(wb.x), bflo(wb.y), bfhi(wb.y), bflo(wb.z), bfhi(wb.z), bflo(wb.w), bfhi(wb.w)};
          float o1[8], o2[8];
#pragma unroll
          for (int j = 0; j < 8; ++j) { const float cc = RT[((size_t)s * 16 + hf * 8 + j) * 2], sn = RT[((size_t)s * 16 + hf * 8 + j) * 2 + 1]; o1[j] = t1[j] * cc - t2[j] * sn; o2[j] = t2[j] * cc + t1[j] * sn; }
          v4u p1, p2; p1.x = pk2(o1[0], o1[1]); p1.y = pk2(o1[2], o1[3]); p1.z = pk2(o1[4], o1[5]); p1.w = pk2(o1[6], o1[7]); p2.x = pk2(o2[0], o2[1]); p2.y = pk2(o2[2], o2[3]); p2.z = pk2(o2[4], o2[5]); p2.w = pk2(o2[6], o2[7]);
#pragma unroll
          for (int h = 0; h < 4; ++h) { bf16* kp = Kb + ((size_t)(b * 4 + h) * SEQ + s) * 96 + 64 + hf * 8; *(v4u*)kp = p1; *(v4u*)(kp + 16) = p2; } }
        __syncthreads();
        if (ui > 0) break;
    }
    { pg8::Gemm g{U + U_CQ, (const bf16*)(ws + WS_WQ) + (size_t)l * 512 * 256, D_INP, 256};
      pg8::EpiMlaQ E{Qb, rs, RT, QSCALE, SEQ}; const Frame F2 = reframe(F);
      pg8::gemm_phase<pg8::EpiMlaQ, pg8::StaticOrder, true>(F2.lds, F2.tid, g, S, E); }
    { pg8::Gemm g{U + U_CKV, (const bf16*)(ws + WS_WKV) + (size_t)l * 512 * 128, D_INP, 128};
      pg8::EpiMlaKV E{Kb, Vb, rs, SEQ}; const Frame F3 = reframe(F);
      pg8::gemm_phase<pg8::EpiMlaKV, pg8::StaticOrder, true>(F3.lds, F3.tid, g, S, E); }
    __syncthreads();
}
__device__ __forceinline__ void ph_mla_prep_naive(const Frame& F, const Args& a, int l) {
    unsigned char* const ws = WSP(F);
    LAS float* xq = (LAS float*)F.lds;
    LAS float* xkv = xq + 32 * 256;
    LAS float* kr = xkv + 32 * 128;
    LAS float* cs = kr + 32 * 32;
    LAS float* qr = cs + 32 * 32;
    const bf16* U = (const bf16*)(ws + WS_U);
    bf16* Qb = (bf16*)(ws + WS_Q); bf16* Kb = (bf16*)(ws + WS_K); bf16* Vb = (bf16*)(ws + WS_V);
    const float* qn = P(F, 5) + l * 256; const float* wuq = P(F, 6) + (size_t)l * 256 * 384;
    const float* kvn = P(F, 7) + l * 128; const float* wukv = P(F, 8) + (size_t)l * 128 * 512;
    const int tid = F.tid;
    for (int blk = F.vcu; blk < T / 32; blk += F.G) {
        const int row0 = blk * 32, b = row0 / SEQ, s0 = row0 % SEQ;
        { const int r = tid >> 4, sub = tid & 15; const bf16* ur = U + (size_t)(row0 + r) * D_INP;
          float q[16]; float ss = 0.f;
#pragma unroll
          for (int i = 0; i < 16; ++i) { q[i] = bf2f(ur[U_CQ + sub * 16 + i]); ss += q[i] * q[i]; }
          ss = sum16(ss); float rs = rsq_f(ss * (1.f / 256.f) + EPS);
#pragma unroll
          for (int i = 0; i < 16; ++i) xq[r * 256 + sub * 16 + i] = q[i] * rs * qn[sub * 16 + i];
          float kv[8]; ss = 0.f;
#pragma unroll
          for (int i = 0; i < 8; ++i) { kv[i] = bf2f(ur[U_CKV + sub * 8 + i]); ss += kv[i] * kv[i]; }
          ss = sum16(ss); rs = rsq_f(ss * (1.f / 128.f) + EPS);
#pragma unroll
          for (int i = 0; i < 8; ++i) xkv[r * 128 + sub * 8 + i] = kv[i] * rs * kvn[sub * 8 + i];
          kr[r * 32 + sub * 2] = bf2f(ur[U_KR + sub * 2]); kr[r * 32 + sub * 2 + 1] = bf2f(ur[U_KR + sub * 2 + 1]);
          const float inv_freq = sub == 0 ? 1.0f : sub == 1 ? 0.5623413251903491f : sub == 2 ? 0.31622776601683794f : sub == 3 ? 0.1778279410038923f : sub == 4 ? 0.1f : sub == 5 ? 0.05623413251903491f
              : sub == 6 ? 0.031622776601683794f : sub == 7 ? 0.01778279410038923f : sub == 8 ? 0.01f : sub == 9 ? 0.005623413251903491f : sub == 10 ? 0.0031622776601683794f : sub == 11 ? 0.001778279410038923f
              : sub == 12 ? 0.001f : sub == 13 ? 0.0005623413251903491f : sub == 14 ? 0.00031622776601683794f : 0.0001778279410038923f;
          const float ang = (float)(s0 + r) * inv_freq;
          double rev = (double)ang * 0.15915494309189535; rev -= floor(rev); const float rf = (float)rev;
          cs[r * 32 + sub * 2] = __builtin_amdgcn_cosf(rf); cs[r * 32 + sub * 2 + 1] = __builtin_amdgcn_sinf(rf); }
        __syncthreads();
        float acc[32];
        if (tid < 384) {
#pragma unroll
            for (int r = 0; r < 32; ++r) acc[r] = 0.f;
            for (int k = 0; k < 256; k += 4) { const float w0 = wuq[(size_t)k * 384 + tid], w1 = wuq[(size_t)(k + 1) * 384 + tid], w2 = wuq[(size_t)(k + 2) * 384 + tid], w3 = wuq[(size_t)(k + 3) * 384 + tid];
#pragma unroll
                for (int r = 0; r < 32; ++r) { const f32x4 x4 = *(const LAS f32x4*)(xq + r * 256 + k); acc[r] += x4.x * w0 + x4.y * w1 + x4.z * w2 + x4.w * w3; } }
            const int h = tid / 96, d = tid % 96;
            if (d < 64) {
#pragma unroll
                for (int r = 0; r < 32; ++r) Qb[((size_t)(b * 4 + h) * SEQ + s0 + r) * 96 + d] = (bf16)f2bf(acc[r] * QSCALE);
            } else {
#pragma unroll
                for (int r = 0; r < 32; ++r) qr[r * 128 + h * 32 + (d - 64)] = acc[r];
            }
        }
        {
#pragma unroll
            for (int r = 0; r < 32; ++r) acc[r] = 0.f;
            for (int k = 0; k < 128; k += 4) { const float w0 = wukv[(size_t)k * 512 + tid], w1 = wukv[(size_t)(k + 1) * 512 + tid], w2 = wukv[(size_t)(k + 2) * 512 + tid], w3 = wukv[(size_t)(k + 3) * 512 + tid];
#pragma unroll
                for (int r = 0; r < 32; ++r) { const f32x4 x4 = *(const LAS f32x4*)(xkv + r * 128 + k); acc[r] += x4.x * w0 + x4.y * w1 + x4.z * w2 + x4.w * w3; } }
            const int h = tid / 128, d = tid % 128;
            if (d < 64) {
#pragma unroll
                for (int r = 0; r < 32; ++r) Kb[((size_t)(b * 4 + h) * SEQ + s0 + r) * 96 + d] = (bf16)f2bf(acc[r]);
            } else {
#pragma unroll
                for (int r = 0; r < 32; ++r) Vb[((size_t)(b * 4 + h) * SEQ + s0 + r) * 64 + (d - 64)] = (bf16)f2bf(acc[r]);
            }
        }
        __syncthreads();
        for (int p = tid; p < 2048; p += NTHR) { const int r = p >> 6, h = (p >> 4) & 3, i = p & 15;
            const float t1 = qr[r * 128 + h * 32 + i], t2 = qr[r * 128 + h * 32 + i + 16], cc = cs[r * 32 + 2 * i], sn = cs[r * 32 + 2 * i + 1];
            bf16* qp = Qb + ((size_t)(b * 4 + h) * SEQ + s0 + r) * 96 + 64;
            qp[i] = (bf16)f2bf((t1 * cc - t2 * sn) * QSCALE); qp[i + 16] = (bf16)f2bf((t2 * cc + t1 * sn) * QSCALE); }
        { const int r = tid >> 4, i = tid & 15; const float t1 = kr[r * 32 + i], t2 = kr[r * 32 + i + 16], cc = cs[r * 32 + 2 * i], sn = cs[r * 32 + 2 * i + 1];
          const bf16 k1 = (bf16)f2bf(t1 * cc - t2 * sn), k2 = (bf16)f2bf(t2 * cc + t1 * sn);
#pragma unroll
          for (int h = 0; h < 4; ++h) { bf16* kp = Kb + ((size_t)(b * 4 + h) * SEQ + s0 + r) * 96 + 64; kp[i] = k1; kp[i + 16] = k2; } }
        __syncthreads();
    }
}
__device__ __forceinline__ f32x4 conv4_silu(const bf16* U, int m, int s, int ucol, int c, const float* cw  , const float* cb) {
    f32x4 acc = *(const f32x4*)(cb + c);
#pragma unroll
    for (int j = 0; j < 4; ++j) { const int ds = 3 - j; if (s - ds >= 0) { const v2u w = *(const v2u*)(U + (size_t)(m - ds) * D_INP + ucol + c);
            const f32x4 wv = *(const f32x4*)(cw + j * 768 + c);
            acc.x += wv.x * bflo(w.x); acc.y += wv.y * bfhi(w.x); acc.z += wv.z * bflo(w.y); acc.w += wv.w * bfhi(w.y); } }
    acc.x = silu_f(acc.x); acc.y = silu_f(acc.y); acc.z = silu_f(acc.z); acc.w = silu_f(acc.w);
    return acc;
}
constexpr size_t GF_UNIT = 40960;
__device__ __forceinline__ int gfrag_off(int row, int col) { return ((((row >> 4) * 2 + (col >> 5)) * 64 + (((col & 15) >> 2) * 16) + (row & 15)) * 8) + ((col & 31) >> 4) * 4 + (col & 3); }
__device__ __forceinline__ constexpr int gf_rp_r(int row) { return ((row >> 4) * 128 + (row & 15)) * 8; }
__device__ __forceinline__ constexpr int gf_lp_c(int col) { return ((col >> 5) * 64 + ((col & 15) >> 2) * 16) * 8 + ((col & 31) >> 4) * 4 + (col & 3); }
typedef float f32x16 __attribute__((ext_vector_type(16)));
__device__ __forceinline__ int crow16(int r, int hi) { return (r & 3) + 8 * (r >> 2) + 4 * hi; }

__device__ __forceinline__ void ph_gdn_prep(const Frame& F, const Args& a, int l) {
    unsigned char* const ws = WSP(F);
    const bf16* U = (const bf16*)(ws + WS_U); unsigned char* GF = ws + WS_GF; float* GL = (float*)(ws + WS_BG);
    const float* gcw = P(F, 15) + (size_t)l * 4 * 768; const float* gcb = P(F, 16) + l * 768; const float* gdtb = P(F, 17) + l * 4; const float* galog = P(F, 18) + l * 4;
    LAS unsigned char* Kc = F.lds + F.wave * 16384;
    LAS unsigned char* Qc = Kc + 8192;
    LAS float* sm = (LAS float*)(F.lds + RING_BYTES + 4096 + F.wave * 1024);
    LAS float* bet = sm; LAS float* gcs = sm + 64; LAS float* tmp = sm + 128;
    for (int unit = F.gw; unit < BATCH * 4 * (SEQ / 64); unit += F.NGW) {
        int lane = F.lane; asm volatile("" : "+v"(lane));
        const int r32 = lane & 31, hi = lane >> 5, fn = lane & 15, fg = lane >> 4;
        const int bh = unit / (SEQ / 64), c = unit % (SEQ / 64), b = bh >> 2, h = bh & 3; const int m0 = b * SEQ + c * 64;
        bf16* KCp = (bf16*)(GF + (size_t)unit * GF_UNIT);
        bf16* fragp = KCp + lane * 8; asm volatile("" : "+v"(fragp));
        { const bf16* ur = U + (size_t)(m0 + lane) * D_INP; const float bb = bf2f(ur[U_GB + h]), aa = bf2f(ur[U_GA + h]);
          const float g = -exp_f(galog[h]) * softplus_f(aa + gdtb[h]);
          bet[lane] = sigmoid_f(bb); tmp[lane] = g; LDS_WAIT(); asm volatile("" ::: "memory");
          float gc = 0.f;
#pragma unroll 8
          for (int j = 0; j < 64; ++j) { const float gj = tmp[j]; gc += (j <= lane) ? gj : 0.f; }
          gcs[lane] = gc; LDS_WAIT(); asm volatile("" ::: "memory"); }
        const float gc63 = gcs[63];
        if (lane == 0) GL[unit] = exp_f(gc63);
#define GDN_CONV(x, chan) do { const int ch_ = (chan); const float c0_ = gcw[ch_], c1_ = gcw[768 + ch_], c2_ = gcw[2 * 768 + ch_], c3_ = gcw[3 * 768 + ch_], cb_ = gcb[ch_]; \
            const bf16* ub_ = U + (size_t)m0 * D_INP + U_GQKV; float h0_ = 0.f, h1_ = 0.f, h2_ = 0.f;        \
            _Pragma("unroll") for (int i_ = 63; i_ >= 0; --i_) x[i_] = bf2f((ub_ + (size_t)i_ * D_INP)[ch_]);        \
            if (c > 0) { h2_ = bf2f((ub_ - 1 * D_INP)[ch_]); h1_ = bf2f((ub_ - 2 * D_INP)[ch_]); h0_ = bf2f((ub_ - 3 * D_INP)[ch_]); } \
            _Pragma("unroll") for (int i_ = 63; i_ >= 0; --i_) { const float a_ = (i_ >= 3) ? x[i_ - 3] : (i_ == 2 ? h2_ : i_ == 1 ? h1_ : h0_), b_ = (i_ >= 2) ? x[i_ - 2] : (i_ == 1 ? h2_ : h1_), d_ = (i_ >= 1) ? x[i_ - 1] : h2_; \
                x[i_] = silu_f(cb_ + c0_ * a_ + c1_ * b_ + c2_ * d_ + c3_ * x[i_]); } } while (0)
#define GDN_ROWNORM(img, scale, rn) do { const LAS unsigned char* rp_ = (img) + lane * 16; float ss_ = 0.f; bf16x8 v_[8]; \
            _Pragma("unroll") for (int ck_ = 0; ck_ < 8; ++ck_) { v_[ck_] = *(const LAS bf16x8*)(rp_ + ck_ * 1024); _Pragma("unroll") for (int e_ = 0; e_ < 8; ++e_) { const float t_ = bf2f((unsigned short)v_[ck_][e_]); ss_ += t_ * t_; } } \
            rn = rsq_f(ss_ + EPS) * (scale); \
            _Pragma("unroll") for (int ck_ = 0; ck_ < 8; ++ck_) { v4u o_; \
                o_.x = pk2(bf2f((unsigned short)v_[ck_][0]) * rn, bf2f((unsigned short)v_[ck_][1]) * rn); o_.y = pk2(bf2f((unsigned short)v_[ck_][2]) * rn, bf2f((unsigned short)v_[ck_][3]) * rn); \
                o_.z = pk2(bf2f((unsigned short)v_[ck_][4]) * rn, bf2f((unsigned short)v_[ck_][5]) * rn); o_.w = pk2(bf2f((unsigned short)v_[ck_][6]) * rn, bf2f((unsigned short)v_[ck_][7]) * rn); \
                *(LAS v4u*)((img) + lane * 16 + ck_ * 1024) = o_; } } while (0)
        { float x[64]; GDN_CONV(x, h * 64 + lane);
          { LAS bf16* qw = (LAS bf16*)(Qc + (lane >> 3) * 1024 + (lane & 7) * 2); asm volatile("" : "+v"(qw));
#pragma unroll
            for (int i = 0; i < 64; ++i) qw[i * 8] = (bf16)f2bf(x[i]); }
          LDS_WAIT(); asm volatile("" ::: "memory");
          float rn; GDN_ROWNORM(Qc, 0.125f, rn); (void)rn;
          LDS_WAIT(); asm volatile("" ::: "memory"); }
        const float gcj0 = gcs[r32], gcj1 = gcs[32 + r32];
#pragma unroll 1
        for (int half = 0; half < 2; ++half) {
            LAS float* gcs_l = gcs; LAS float* bet_l = bet; asm volatile("" : "+v"(gcs_l), "+v"(bet_l));
            float w[64];
            GDN_CONV(w, (1 + half) * 256 + h * 64 + lane);
            if (half == 0) {
                { LAS bf16* kw = (LAS bf16*)(Kc + (lane >> 3) * 1024 + (lane & 7) * 2); asm volatile("" : "+v"(kw));
#pragma unroll
                  for (int i = 0; i < 64; ++i) kw[i * 8] = (bf16)f2bf(w[i]); }
                LDS_WAIT(); asm volatile("" ::: "memory");
                float rnk; GDN_ROWNORM(Kc, 1.0f, rnk);
                tmp[lane] = bet_l[lane] * exp_f(gcs_l[lane]) * rnk;
                LDS_WAIT(); asm volatile("" ::: "memory");
                { LAS float* tp = tmp; asm volatile("" : "+v"(tp));
#pragma unroll
                  for (int i = 0; i < 64; ++i) w[i] *= tp[i]; }
            } else {
#pragma unroll
                for (int i = 0; i < 64; ++i) w[i] *= bet_l[i];
            }
            if (half == 0) {
                LDS_WAIT(); asm volatile("" ::: "memory");
                bf16* fqd = fragp + 4096; bf16* fkt = fragp + 12288;
#pragma unroll
                for (int f = 0; f < 8; ++f) { const int mt = f >> 1, ks = f & 1; asm volatile("" : "+v"(fqd), "+v"(fkt));
                    { const int row = 16 * mt + fn; const float e = exp_f(gcs_l[row]); const LAS unsigned char* qp = Qc + (4 * ks + (fg >> 1)) * 1024 + row * 16 + (fg & 1) * 8;
                      const v2u lo = *(const LAS v2u*)qp, hh2 = *(const LAS v2u*)(qp + 2048);
                      v4u o; o.x = pk2(bflo(lo.x) * e, bfhi(lo.x) * e); o.y = pk2(bflo(lo.y) * e, bfhi(lo.y) * e); o.z = pk2(bflo(hh2.x) * e, bfhi(hh2.x) * e); o.w = pk2(bflo(hh2.y) * e, bfhi(hh2.y) * e);
                      *(v4u*)fqd = o; fqd += 512; }
                    { const int ch = 16 * mt + fn, L0 = 32 * ks + 4 * fg; const LAS unsigned char* kp = Kc + (ch >> 3) * 1024 + (ch & 7) * 2 + L0 * 16;
                      const f32x4 ga = *(const LAS f32x4*)(gcs_l + L0), gb = *(const LAS f32x4*)(gcs_l + L0 + 16);
                      float v[8];
#pragma unroll
                      for (int j = 0; j < 4; ++j) { v[j] = bf2f(*(const LAS bf16*)(kp + j * 16)) * exp_f(gc63 - ga[j]); v[4 + j] = bf2f(*(const LAS bf16*)(kp + (16 + j) * 16)) * exp_f(gc63 - gb[j]); }
                      v4u o; o.x = pk2(v[0], v[1]); o.y = pk2(v[2], v[3]); o.z = pk2(v[4], v[5]); o.w = pk2(v[6], v[7]);
                      *(v4u*)fkt = o; fkt += 512; } }
#pragma unroll
                for (int which = 0; which < 2; ++which) {
                    const LAS unsigned char* Am = which ? Kc : Qc; f32x16 acc[3];
#pragma unroll
                    for (int t = 0; t < 3; ++t) { const int it = (t + 1) >> 1, jt = t >> 1; acc[t] = f32x16{};
#pragma unroll
                        for (int d0 = 0; d0 < 4; ++d0) { const bf16x8 af = *(const LAS bf16x8*)(Am + (2 * d0 + hi) * 1024 + (32 * it + r32) * 16), bfr = *(const LAS bf16x8*)(Kc + (2 * d0 + hi) * 1024 + (32 * jt + r32) * 16);
                            acc[t] = __builtin_amdgcn_mfma_f32_32x32x16_bf16(af, bfr, acc[t], 0, 0, 0); } }
                    LDS_WAIT(); asm volatile("" ::: "memory");
                    {
                        LAS bf16* dst = (LAS bf16*)(which ? Kc : Qc) + 4 * hi * 64 + r32; LAS float* gr = gcs_l + 4 * hi; LAS float* br = bet_l + 4 * hi; int dd = r32 - 4 * hi;
                        asm volatile("" : "+v"(dst), "+v"(gr), "+v"(br), "+v"(dd));
#pragma unroll
                        for (int t = 0; t < 3; ++t) { const int it = (t + 1) >> 1, jt = t >> 1; const float gcj = jt ? gcj1 : gcj0;
#pragma unroll
                            for (int r = 0; r < 16; ++r) { const int c0 = crow16(r, 0), i0 = 32 * it + c0; const float dec = exp_f(gr[i0] - gcj);
                                const bool keep = (it != jt) || (which ? (c0 > dd) : (c0 >= dd));
                                const float v = which ? br[i0] * acc[t][r] * dec : acc[t][r] * dec;
                                dst[i0 * 64 + 32 * jt] = (bf16)(keep ? f2bf(v) : 0u); } }
                        if (which == 0) {
#pragma unroll
                            for (int r = 0; r < 16; ++r) dst[crow16(r, 0) * 64 + 32] = (bf16)0; }
                    }
                }
                LDS_WAIT(); asm volatile("" ::: "memory");
                { bf16* fqk = fragp + 8192;
#pragma unroll
                for (int f = 0; f < 8; ++f) { const int mt = f >> 1, ks = f & 1; const LAS unsigned char* sp = Qc + ((16 * mt + fn) * 64 + 32 * ks + 4 * fg) * 2; asm volatile("" : "+v"(fqk));
                    const v2u lo = *(const LAS v2u*)sp, hh2 = *(const LAS v2u*)(sp + 32); v4u o; o.x = lo.x; o.y = lo.y; o.z = hh2.x; o.w = hh2.y; *(v4u*)fqk = o; fqk += 512; } }
                LDS_WAIT(); asm volatile("" ::: "memory");
            }
            { unsigned wp[32];
#pragma unroll
              for (int i = 1; i < 64; ++i) { float s0 = 0.f, s1 = 0.f;
                if ((i & 1) == 1) wp[i >> 1] = pk2(w[i - 1], 0.f);
#pragma unroll
                for (int j = 0; j < i; j += 4) { const v2u a2 = *(const LAS v2u*)(Kc + (i * 64 + j) * 2); float& s = ((j >> 2) & 1) ? s1 : s0;
                    const unsigned ax = a2.x, ay = a2.y;
                    s = __builtin_amdgcn_fdot2_f32_bf16(__builtin_bit_cast(pk_b2v, ax), __builtin_bit_cast(pk_b2v, wp[j >> 1]), s, false);
                    if (j + 2 < i) s = __builtin_amdgcn_fdot2_f32_bf16(__builtin_bit_cast(pk_b2v, ay), __builtin_bit_cast(pk_b2v, wp[(j >> 1) + 1]), s, false); }
                w[i] -= s0 + s1;
                if ((i & 1) == 1) wp[i >> 1] = pk2(w[i - 1], w[i]);
                if ((i & 7) == 7) __builtin_amdgcn_sched_barrier(0); } }
            { LAS bf16* stw = (LAS bf16*)Qc + lane; asm volatile("" : "+v"(stw));
#pragma unroll
              for (int i = 0; i < 64; ++i) stw[i * 64] = (bf16)f2bf(half == 0 ? -w[i] : w[i]); }
            LDS_WAIT(); asm volatile("" ::: "memory");
            if (half == 0) {
                bf16* fkc = fragp;
#pragma unroll
                for (int f = 0; f < 8; ++f) { const int mt = f >> 1, ks = f & 1; const LAS unsigned char* sp = Qc + ((16 * mt + fn) * 64 + 32 * ks + 4 * fg) * 2; asm volatile("" : "+v"(fkc));
                    const v2u lo = *(const LAS v2u*)sp, hh2 = *(const LAS v2u*)(sp + 32); v4u o; o.x = lo.x; o.y = lo.y; o.z = hh2.x; o.w = hh2.y; *(v4u*)fkc = o; fkc += 512; }
            } else {
                bf16* uvp = KCp + 16384 + lane * 4; asm volatile("" : "+v"(uvp));
#pragma unroll
                for (int q = 0; q < 16; ++q) { const int vs = q >> 2, mt = q & 3; const LAS bf16* sp = (const LAS bf16*)Qc + (16 * mt + 4 * fg) * 64 + 16 * vs + fn; asm volatile("" : "+v"(uvp));
                    v2u o; o.x = (unsigned)sp[0] | ((unsigned)sp[64] << 16); o.y = (unsigned)sp[128] | ((unsigned)sp[192] << 16); *(v2u*)uvp = o; uvp += 256; }
            }
            LDS_WAIT(); asm volatile("" ::: "memory");
        }
    }
}
__device__ __forceinline__ void gdn_chain(const Frame& F, int bh) {
    typedef float f4 __attribute__((ext_vector_type(4)));
    unsigned char* const ws = WSP(F);
    const unsigned char* GF = ws + WS_GF; const float* GL = (const float*)(ws + WS_BG); float* OR = (float*)(ws + WS_OR);
    const int lane = F.lane, n = lane & 15, g = lane >> 4, b = bh >> 2, h = bh & 3, vs = F.wave & 3; const bool comp = F.wave < 4;
    constexpr int NC = SEQ / 64, SLOT = 40960;
    const char* ub = (const char*)GF + (size_t)bh * NC * GF_UNIT + (size_t)F.wave * 5120;
    const unsigned lds0 = (unsigned)(uintptr_t)F.lds, ldw = lds0 + F.wave * 5120;
#define GDN_DMA(cc) do { const int cu_ = (cc) < NC ? (cc) : NC - 1; const unsigned sl_ = ldw + ((cc) % 3) * SLOT; const char* src_ = ub + (size_t)cu_ * GF_UNIT; \
        _Pragma("unroll") for (int i_ = 0; i_ < 5; ++i_) pg8::glds_sv_t<0>(src_ + i_ * 1024, (unsigned)lane * 16u, (unsigned)__builtin_amdgcn_readfirstlane(sl_ + i_ * 1024)); } while (0)
    LAS float* gls = (LAS float*)(F.lds + 3 * SLOT);
    if (F.tid < NC) gls[F.tid] = GL[bh * NC + F.tid];
    asm volatile("s_waitcnt vmcnt(0) lgkmcnt(0)\n\ts_barrier" ::: "memory");
    GDN_DMA(0); GDN_DMA(1);
    asm volatile("s_waitcnt vmcnt(5)" ::: "memory");
    f4 S[4];
#pragma unroll
    for (int mt = 0; mt < 4; ++mt) S[mt] = (f4){0.f, 0.f, 0.f, 0.f};
    for (int c = 0; c < NC; ++c) {
        if (comp) asm volatile("s_waitcnt vmcnt(21) lgkmcnt(0)\n\ts_barrier" ::: "memory"); else asm volatile("s_waitcnt vmcnt(5) lgkmcnt(0)\n\ts_barrier" ::: "memory");
        GDN_DMA(c + 2);
        if (comp) {
            const LAS unsigned char* sl = F.lds + (c % 3) * SLOT + lane * 16;
            const float gl = gls[c];
#define GDN_FR(moff, f) (*(const LAS bf16x8*)(sl + (moff) + (f) * 1024))
            bf16x8 sf[2], vf[2]; f4 vn[4], o[4];
#pragma unroll
            for (int ks = 0; ks < 2; ++ks) { v4u w; w.x = pk2(S[2 * ks][0], S[2 * ks][1]); w.y = pk2(S[2 * ks][2], S[2 * ks][3]); w.z = pk2(S[2 * ks + 1][0], S[2 * ks + 1][1]); w.w = pk2(S[2 * ks + 1][2], S[2 * ks + 1][3]); sf[ks] = __builtin_bit_cast(bf16x8, w); }
#pragma unroll
            for (int mt = 0; mt < 4; ++mt) { const v2u uv = *(const LAS v2u*)(F.lds + (c % 3) * SLOT + 32768 + ((vs * 4 + mt) * 64 + lane) * 8);
                vn[mt] = (f4){bflo(uv.x), bfhi(uv.x), bflo(uv.y), bfhi(uv.y)}; o[mt] = (f4){0.f, 0.f, 0.f, 0.f}; }
            bf16x8 fa[8], fb[8];
#pragma unroll
            for (int f = 0; f < 8; ++f) fa[f] = GDN_FR(0, f);
#pragma unroll
            for (int f = 0; f < 8; ++f) fb[f] = GDN_FR(8192, f);
#pragma unroll
            for (int mt = 0; mt < 4; ++mt)
#pragma unroll
                for (int ks = 0; ks < 2; ++ks) vn[mt] = __builtin_amdgcn_mfma_f32_16x16x32_bf16(fa[mt * 2 + ks], sf[ks], vn[mt], 0, 0, 0);
#pragma unroll
            for (int f = 0; f < 8; ++f) fa[f] = GDN_FR(24576, f);
#pragma unroll
            for (int mt = 0; mt < 4; ++mt)
#pragma unroll
                for (int ks = 0; ks < 2; ++ks) o[mt] = __builtin_amdgcn_mfma_f32_16x16x32_bf16(fb[mt * 2 + ks], sf[ks], o[mt], 0, 0, 0);
#pragma unroll
            for (int f = 0; f < 8; ++f) fb[f] = GDN_FR(16384, f);
#pragma unroll
            for (int ks = 0; ks < 2; ++ks) { v4u w; w.x = pk2(vn[2 * ks][0], vn[2 * ks][1]); w.y = pk2(vn[2 * ks][2], vn[2 * ks][3]); w.z = pk2(vn[2 * ks + 1][0], vn[2 * ks + 1][1]); w.w = pk2(vn[2 * ks + 1][2], vn[2 * ks + 1][3]); vf[ks] = __builtin_bit_cast(bf16x8, w); }
#pragma unroll
            for (int mt = 0; mt < 4; ++mt) { S[mt] = S[mt] * gl;
#pragma unroll
                for (int ks = 0; ks < 2; ++ks) S[mt] = __builtin_amdgcn_mfma_f32_16x16x32_bf16(fa[mt * 2 + ks], vf[ks], S[mt], 0, 0, 0); }
#pragma unroll
            for (int mt = 0; mt < 4; ++mt)
#pragma unroll
                for (int ks = 0; ks < 2; ++ks) o[mt] = __builtin_amdgcn_mfma_f32_16x16x32_bf16(fb[mt * 2 + ks], vf[ks], o[mt], 0, 0, 0);
            { float* op = OR + ((size_t)b * SEQ + c * 64 + 4 * g) * 256 + h * 64 + vs * 16 + n;
#pragma unroll
              for (int mt = 0; mt < 4; ++mt)
#pragma unroll
                  for (int i = 0; i < 4; ++i) op[(size_t)(mt * 16 + i) * 256] = o[mt][i]; }
#undef GDN_FR
        }
    }
    asm volatile("s_waitcnt vmcnt(0) lgkmcnt(0)\n\ts_barrier" ::: "memory");
#undef GDN_DMA
}
__device__ __forceinline__ void ph_ssd_chunk(const Frame& F, const Args& a, int l) {
    unsigned char* const ws = WSP(F);
    const bf16* U = (const bf16*)(ws + WS_U); float* Y = (float*)(ws + WS_H); float* ST = (float*)(ws + WS_SST); float* EA = (float*)(ws + WS_DT); bf16* CS = (bf16*)(ws + WS_CS);
    const float* cw = P(F, 9) + (size_t)l * 4 * 768; const float* cb = P(F, 10) + l * 768; const float* dtb = P(F, 11) + l * 8;
    LAS float* Bs = (LAS float*)F.lds;
    LAS float* Cs = Bs + 2 * 128 * 64;
    LAS float* dts = (LAS float*)(F.lds + RING_BYTES + 4096);
    const int lane = F.lane, h = F.wave;
    for (int unit = F.vcu; unit < BATCH * (SEQ / 128); unit += F.G) {
        const int b = unit / (SEQ / 128), c = unit % (SEQ / 128); const int m0 = b * SEQ + c * 128, s0 = c * 128;
        for (int qd = F.tid; qd < 128 * 64; qd += NTHR) { const int r = qd >> 6, cc = (qd & 63) * 4;
            const f32x4 v = conv4_silu(U, m0 + r, s0 + r, U_XBC, 512 + cc, cw, cb);
            const int which = cc >> 7, g = (cc >> 6) & 1, n = cc & 63;
            *(LAS f32x4*)((which ? Cs : Bs) + (g * 128 + r) * 64 + n) = v;
            if (which) { v2u w; w.x = pk2(v.x, v.y); w.y = pk2(v.z, v.w); *(v2u*)(CS + (size_t)(m0 + r) * 128 + (cc - 128)) = w; } }
        for (int i = F.tid; i < 8 * 128; i += NTHR) { const int hh = i >> 7, r = i & 127; dts[i] = softplus_f(bf2f(U[(size_t)(m0 + r) * D_INP + U_DT + hh]) + dtb[hh]); }
        __syncthreads();
        {
            const int ch = h * 64 + lane, g = h >> 2; const float A = -exp_f(P(F, 12)[l * 8 + h]), Dh = P(F, 13)[l * 8 + h];
            const float w0 = cw[ch], w1 = cw[768 + ch], w2 = cw[2 * 768 + ch], w3 = cw[3 * 768 + ch], bb = cb[ch];
            const bf16* up = U + (size_t)m0 * D_INP + U_XBC + ch;
            float x0 = 0.f, x1 = 0.f, x2 = 0.f;
            if (s0 > 0) { x0 = bf2f(up[-3 * D_INP]); x1 = bf2f(up[-2 * D_INP]); x2 = bf2f(up[-1 * D_INP]); }
            float hn[64];
#pragma unroll
            for (int n = 0; n < 64; ++n) hn[n] = 0.f;
            float acum = 0.f;
            const LAS float* Bg = Bs + g * 128 * 64; const LAS float* Cg = Cs + g * 128 * 64;
            for (int lb = 0; lb < 128; lb += 16) {
                float xr[16];
#pragma unroll
                for (int i = 0; i < 16; ++i) xr[i] = bf2f(up[(size_t)(lb + i) * D_INP]);
#pragma unroll
                for (int i = 0; i < 16; ++i) { const float xin = xr[i]; const int r = lb + i;
                    const float cv = bb + w0 * x0 + w1 * x1 + w2 * x2 + w3 * xin; x0 = x1; x1 = x2; x2 = xin;
                    const float xs = silu_f(cv), dtv = dts[h * 128 + r], da = dtv * A, dA = exp_f(da), coef = dtv * xs; acum += da; float y = 0.f;
#pragma unroll
                    for (int n = 0; n < 64; n += 4) { const f32x4 b4 = *(const LAS f32x4*)(Bg + r * 64 + n), c4 = *(const LAS f32x4*)(Cg + r * 64 + n);
                        hn[n] = hn[n] * dA + coef * b4.x; y += c4.x * hn[n]; hn[n + 1] = hn[n + 1] * dA + coef * b4.y; y += c4.y * hn[n + 1];
                        hn[n + 2] = hn[n + 2] * dA + coef * b4.z; y += c4.z * hn[n + 2]; hn[n + 3] = hn[n + 3] * dA + coef * b4.w; y += c4.w * hn[n + 3]; }
                    Y[(size_t)(m0 + r) * 512 + ch] = y + Dh * xs;
                    if (lane == 0) EA[(size_t)(m0 + r) * 8 + h] = exp_f(acum); }
            }
            float* sp = ST + ((size_t)(unit * 8 + h) * 64 + lane) * 64;
#pragma unroll
            for (int n = 0; n < 64; n += 4) *(f32x4*)(sp + n) = (f32x4){hn[n], hn[n + 1], hn[n + 2], hn[n + 3]};
        }
        __syncthreads();
    }
}
__device__ __forceinline__ void ph_ssd_scan(const Frame& F, const Args& a, bool dummy = false) {
    unsigned char* const ws = WSP(F);
    float* ST = (float*)(ws + (dummy ? WS_H : WS_SST)); const float* EA = (const float*)(ws + WS_DT);
    for (int id = F.vcu * NTHR + F.tid; id < BATCH * 8 * 4096; id += F.G * NTHR) {
        const int b = id / (8 * 4096), r = id % (8 * 4096), h = r / 4096, e = r % 4096;
        float* sp = ST + ((size_t)(b * 128) * 8 + h) * 4096 + e; const float* ep = EA + ((size_t)b * SEQ + 127) * 8 + h;
        float hp = 0.f;
        for (int c0 = 0; c0 < 128; c0 += 8) { float st[8], dc[8];
#pragma unroll
            for (int i = 0; i < 8; ++i) { st[i] = sp[(size_t)(c0 + i) * 8 * 4096]; dc[i] = ep[(size_t)(c0 + i) * 128 * 8]; }
#pragma unroll
            for (int i = 0; i < 8; ++i) { sp[(size_t)(c0 + i) * 8 * 4096] = hp; hp = hp * dc[i] + st[i]; } }
    }
}
__device__ __forceinline__ void ph_ssd_out(const Frame& F, const Args& a, int l) {
    unsigned char* const ws = WSP(F);
    const bf16* U = (const bf16*)(ws + WS_U); float* Y = (float*)(ws + WS_H); const float* ST = (const float*)(ws + WS_SST); const float* EA = (const float*)(ws + WS_DT);
    const bf16* CS = (const bf16*)(ws + WS_CS); bf16* O = (bf16*)(ws + WS_O); const float* nw = P(F, 14) + l * 512;
    LAS float* Cs = (LAS float*)F.lds;
    LAS float* ssq = Cs + 2 * 128 * 64;
    const int lane = F.lane, h = F.wave;
    for (int unit = F.vcu; unit < BATCH * (SEQ / 128); unit += F.G) {
        const int b = unit / (SEQ / 128), c = unit % (SEQ / 128); const int m0 = b * SEQ + c * 128;
        for (int qd = F.tid; qd < 128 * 32; qd += NTHR) { const int r = qd >> 5, cc = (qd & 31) * 4; const v2u w = *(const v2u*)(CS + (size_t)(m0 + r) * 128 + cc);
            *(LAS f32x4*)(Cs + ((cc >> 6) * 128 + r) * 64 + (cc & 63)) = (f32x4){bflo(w.x), bfhi(w.x), bflo(w.y), bfhi(w.y)}; }
        if (F.tid < 256) ssq[F.tid] = 0.f;
        __syncthreads();
        {
            const int ch = h * 64 + lane, g = h >> 2; float pv[64];
            const float* sp = ST + ((size_t)(unit * 8 + h) * 64 + lane) * 64;
#pragma unroll
            for (int n = 0; n < 64; n += 4) { const f32x4 v = *(const f32x4*)(sp + n); pv[n] = v.x; pv[n + 1] = v.y; pv[n + 2] = v.z; pv[n + 3] = v.w; }
            const LAS float* Cg = Cs + g * 128 * 64;
            for (int lb = 0; lb < 128; lb += 8) { float yd[8], zz[8], ea[8];
#pragma unroll
                for (int i = 0; i < 8; ++i) { const size_t m = (size_t)(m0 + lb + i); yd[i] = Y[m * 512 + ch]; zz[i] = bf2f(U[m * D_INP + U_Z + ch]); ea[i] = EA[m * 8 + h]; }
#pragma unroll
                for (int i = 0; i < 8; ++i) { const int r = lb + i; float yo = 0.f;
#pragma unroll
                    for (int n = 0; n < 64; n += 4) { const f32x4 c4 = *(const LAS f32x4*)(Cg + r * 64 + n); yo += c4.x * pv[n] + c4.y * pv[n + 1] + c4.z * pv[n + 2] + c4.w * pv[n + 3]; }
                    const float y = (yd[i] + ea[i] * yo) * silu_f(zz[i]);
                    Y[(size_t)(m0 + r) * 512 + ch] = y;
                    const float s2 = wave_sum(y * y);
                    if (lane == 0) atomicAdd((float*)(ssq + g * 128 + r), s2); }
            }
        }
        __syncthreads();
        for (int qd = F.tid; qd < 128 * 128; qd += NTHR) { const int r = qd >> 7, cc = (qd & 127) * 4; const size_t m = (size_t)(m0 + r);
            f32x4 y = *(const f32x4*)(Y + m * 512 + cc); const float rs = rsq_f(ssq[(cc >> 8) * 128 + r] * (1.f / 256.f) + EPS); const f32x4 n4 = *(const f32x4*)(nw + cc);
            y = y * rs * n4; v2u w; w.x = pk2(y.x, y.y); w.y = pk2(y.z, y.w); *(v2u*)(O + m * DM + 256 + cc) = w; }
        __syncthreads();
    }
}

#define CONV_ROWS_BEGIN(NR_, U_, m0_, s0_, ch_, cw_, cb_, r0_, r1_) { \
    const f32x4 w0_ = *(const f32x4*)((cw_) + (ch_)), w1_ = *(const f32x4*)((cw_) + 768 + (ch_)), w2_ = *(const f32x4*)((cw_) + 2 * 768 + (ch_)), w3_ = *(const f32x4*)((cw_) + 3 * 768 + (ch_)), bb_ = *(const f32x4*)((cb_) + (ch_)); \
    const bf16* up_ = (U_) + (size_t)((m0_) + (r0_)) * D_INP + U_XBC + (ch_); v2u raw_[NR_ + 3]; \
    _Pragma("unroll") for (int k_ = 0; k_ < NR_ + 3; ++k_) { const int rr_ = (r0_) - 3 + k_; raw_[k_] = ((s0_) + rr_ >= 0 && rr_ < (r1_)) ? *(const v2u*)(up_ + (long)(k_ - 3) * D_INP) : (v2u){0u, 0u}; }     \
    f32x4 x0_ = {bflo(raw_[0].x), bfhi(raw_[0].x), bflo(raw_[0].y), bfhi(raw_[0].y)}, x1_ = {bflo(raw_[1].x), bfhi(raw_[1].x), bflo(raw_[1].y), bfhi(raw_[1].y)}, x2_ = {bflo(raw_[2].x), bfhi(raw_[2].x), bflo(raw_[2].y), bfhi(raw_[2].y)}; \
    _Pragma("unroll") for (int k_ = 0; k_ < NR_; ++k_) { const int r = (r0_) + k_; if (r < (r1_)) { const v2u w_ = raw_[k_ + 3]; const f32x4 xin_ = {bflo(w_.x), bfhi(w_.x), bflo(w_.y), bfhi(w_.y)}; \
        f32x4 v = bb_ + w0_ * x0_ + w1_ * x1_ + w2_ * x2_ + w3_ * xin_; x0_ = x1_; x1_ = x2_; x2_ = xin_; v.x = silu_f(v.x); v.y = silu_f(v.y); v.z = silu_f(v.z); v.w = silu_f(v.w);
#define CONV_ROWS_END } } }
#define CONV_ROWS_LOAD(NR_, raw_, U_, m0_, s0_, ch_, r0_, r1_) { const bf16* up_ = (U_) + (size_t)((m0_) + (r0_)) * D_INP + U_XBC + (ch_); \
    _Pragma("unroll") for (int k_ = 0; k_ < NR_ + 3; ++k_) { const int rr_ = (r0_) - 3 + k_; raw_[k_] = ((s0_) + rr_ >= 0 && rr_ < (r1_)) ? *(const v2u*)(up_ + (long)(k_ - 3) * D_INP) : (v2u){0u, 0u}; } }
#define CONV_ROWS_COMPUTE_BEGIN(NR_, raw_, ch_, cw_, cb_, r0_, r1_) { \
    const f32x4 w0_ = *(const f32x4*)((cw_) + (ch_)), w1_ = *(const f32x4*)((cw_) + 768 + (ch_)), w2_ = *(const f32x4*)((cw_) + 2 * 768 + (ch_)), w3_ = *(const f32x4*)((cw_) + 3 * 768 + (ch_)), bb_ = *(const f32x4*)((cb_) + (ch_)); \
    f32x4 x0_ = {bflo(raw_[0].x), bfhi(raw_[0].x), bflo(raw_[0].y), bfhi(raw_[0].y)}, x1_ = {bflo(raw_[1].x), bfhi(raw_[1].x), bflo(raw_[1].y), bfhi(raw_[1].y)}, x2_ = {bflo(raw_[2].x), bfhi(raw_[2].x), bflo(raw_[2].y), bfhi(raw_[2].y)}; \
    _Pragma("unroll") for (int k_ = 0; k_ < NR_; ++k_) { const int r = (r0_) + k_; if (r < (r1_)) { const v2u w_ = raw_[k_ + 3]; const f32x4 xin_ = {bflo(w_.x), bfhi(w_.x), bflo(w_.y), bfhi(w_.y)}; \
        f32x4 v = bb_ + w0_ * x0_ + w1_ * x1_ + w2_ * x2_ + w3_ * xin_; x0_ = x1_; x1_ = x2_; x2_ = xin_; v.x = silu_f(v.x); v.y = silu_f(v.y); v.z = silu_f(v.z); v.w = silu_f(v.w);
namespace ssdm {
typedef __attribute__((address_space(3))) const char* lcp;
typedef float f32x16 __attribute__((ext_vector_type(16)));
typedef short s16x4 __attribute__((ext_vector_type(4)));
constexpr int XI_OFF = 0, BK_OFF = 65536, CK_OFF = 81920, SM_OFF = 98304, PV_OFF = 106496, PV3_OFF = 132096;
constexpr int XI_OFF_UNUSED = 0;
__device__ __forceinline__ int crow(int r, int hi) { return (r & 3) + 8 * (r >> 2) + 4 * hi; }
__device__ __forceinline__ s16x4 vtr(lcp p) { return __builtin_bit_cast(s16x4, __builtin_amdgcn_ds_read_tr16_b64_v4i16((__attribute__((address_space(3))) attn_body::v4i16_t*)p)); }
__device__ __forceinline__ bf16x8 join(s16x4 lo, s16x4 hi) { return (bf16x8){lo[0], lo[1], lo[2], lo[3], hi[0], hi[1], hi[2], hi[3]}; }
template <int CTRL, int RMASK> __device__ __forceinline__ float dpp0f(float v) { return __builtin_bit_cast(float, __builtin_amdgcn_update_dpp(0, __builtin_bit_cast(int, v), CTRL, RMASK, 0xf, false)); }
__device__ __forceinline__ float wave_incl_scan(float v) {
    v += dpp0f<0x111, 0xf>(v); v += dpp0f<0x112, 0xf>(v); v += dpp0f<0x114, 0xf>(v); v += dpp0f<0x118, 0xf>(v);
    v += dpp0f<0x142, 0xa>(v); v += dpp0f<0x143, 0xc>(v); return v; }
__device__ __forceinline__ void dt_cumsum(const Frame& F, const bf16* U, int m0, int g, const float* dtb, const float* alog, LAS float* dts, LAS float* acs) {
    const int hh = F.tid >> 7, r = F.tid & 127, h = g * 4 + hh;
    const float dtv = softplus_f(bf2f(U[(size_t)(m0 + r) * D_INP + U_DT + h]) + dtb[h]); const float x = dtv * -exp_f(alog[h]);
    LAS float* tot = acs + 512 + 128;
    float sc = wave_incl_scan(x);
    if ((F.wave & 1) == 0 && F.lane == 63) tot[hh] = sc;
    dts[F.tid] = dtv;
    __syncthreads();
    if (F.wave & 1) sc += tot[hh];
    acs[F.tid] = sc;
    __syncthreads();
}
}

__device__ __forceinline__ void ph_ssd_states(const Frame& F, const Args& a, int l) {
    using namespace ssdm;
    unsigned char* const ws = WSP(F);
    const bf16* U = (const bf16*)(ws + WS_U); float* ST = (float*)(ws + WS_SST); float* EA = (float*)(ws + WS_DT);
    const float* cw = P(F, 9) + (size_t)l * 4 * 768; const float* cb = P(F, 10) + l * 768; const float* dtb = P(F, 11) + l * 8; const float* alog = P(F, 12) + l * 8;
    LAS unsigned char* XI = F.lds + XI_OFF; LAS unsigned char* BT = F.lds + BK_OFF; LAS float* dts = (LAS float*)(F.lds + SM_OFF); LAS float* acs = dts + 512;
    const int lane = F.lane, r32 = lane & 31, hi = lane >> 5, hh = F.wave & 3, ph = F.wave >> 2;
    for (int unit = F.vcu; unit < BATCH * (SEQ / 128) * 2; unit += F.G) {
        const int g = unit & 1, bc = unit >> 1, b = bc / (SEQ / 128), c = bc % (SEQ / 128); const int m0 = b * SEQ + c * 128, s0 = c * 128;
        dt_cumsum(F, U, m0, g, dtb, alog, dts, acs);
        if (F.tid < 480) { const int j = F.tid % 80, rg = F.tid / 80, r0 = rg * 22, r1 = (r0 + 22 < 128) ? r0 + 22 : 128;
            if (j < 64) { const int cc = j * 4, hx = cc >> 6; const float aend = acs[hx * 128 + 127]; LAS unsigned char* xp = XI + (cc >> 5) * 8192 + (cc & 31) * 2;
                CONV_ROWS_BEGIN(22, U, m0, s0, g * 256 + cc, cw, cb, r0, r1)
                    v = v * (dts[hx * 128 + r] * exp_f(aend - acs[hx * 128 + r])); v2u pk; pk.x = pk2(v.x, v.y); pk.y = pk2(v.z, v.w); *(LAS v2u*)(xp + r * 64) = pk;
                CONV_ROWS_END }
            else { const int n = (j - 64) * 4; LAS unsigned char* bp = BT + (n >> 5) * 8192 + (n & 31) * 2;
                CONV_ROWS_BEGIN(22, U, m0, s0, 512 + g * 64 + n, cw, cb, r0, r1)
                    v2u pk; pk.x = pk2(v.x, v.y); pk.y = pk2(v.z, v.w); *(LAS v2u*)(bp + r * 64) = pk;
                CONV_ROWS_END } }
        if (F.tid < 4) EA[(size_t)(m0 + 127) * 8 + g * 4 + F.tid] = exp_f(acs[F.tid * 128 + 127]);
        __syncthreads();
        {
            f32x16 acc[2]; acc[0] = f32x16{}; acc[1] = f32x16{};
            const int trl = (8 * hi + ((lane & 15) >> 2)) * 64 + ((lane >> 4) & 1) * 32 + (lane & 3) * 8;
            const lcp xa = (lcp)(XI + (hh * 2 + ph) * 8192 + trl); const lcp b0p = (lcp)(BT + trl), b1p = (lcp)(BT + 8192 + trl);
#pragma unroll
            for (int ks = 0; ks < 8; ++ks) { const bf16x8 af = join(vtr(xa + ks * 1024), vtr(xa + ks * 1024 + 256)), bf0 = join(vtr(b0p + ks * 1024), vtr(b0p + ks * 1024 + 256)), bf1 = join(vtr(b1p + ks * 1024), vtr(b1p + ks * 1024 + 256));
                acc[0] = __builtin_amdgcn_mfma_f32_32x32x16_bf16(af, bf0, acc[0], 0, 0, 0); acc[1] = __builtin_amdgcn_mfma_f32_32x32x16_bf16(af, bf1, acc[1], 0, 0, 0); }
            float* sp = ST + ((size_t)(bc * 8 + g * 4 + hh) * 64 + 32 * ph) * 64 + r32;
#pragma unroll
            for (int nt = 0; nt < 2; ++nt)
#pragma unroll
                for (int r = 0; r < 16; ++r) sp[crow(r, hi) * 64 + 32 * nt] = acc[nt][r];
        }
        __syncthreads();
    }
}
__device__ __forceinline__ void ph_ssd_y(const Frame& F, const Args& a, int l) {
    using namespace ssdm;
    unsigned char* const ws = WSP(F);
    const bf16* U = (const bf16*)(ws + WS_U); const float* ST = (const float*)(ws + WS_SST); bf16* O = (bf16*)(ws + WS_O);
    const float* cw = P(F, 9) + (size_t)l * 4 * 768; const float* cb = P(F, 10) + l * 768; const float* dtb = P(F, 11) + l * 8; const float* alog = P(F, 12) + l * 8; const float* nw = P(F, 14) + l * 512;
    LAS unsigned char* XI = F.lds + XI_OFF; LAS unsigned char* BK = F.lds + BK_OFF; LAS unsigned char* CK = F.lds + CK_OFF;
    LAS float* dts = (LAS float*)(F.lds + SM_OFF); LAS float* acs = dts + 512; LAS float* ssq = acs + 512;
    const int lane = F.lane, r32 = lane & 31, hi = lane >> 5, hh = F.wave & 3, half = F.wave >> 2;
    for (int unit = F.vcu; unit < BATCH * (SEQ / 128) * 2; unit += F.G) {
        const int g = unit & 1, bc = unit >> 1, b = bc / (SEQ / 128), c = bc % (SEQ / 128); const int m0 = b * SEQ + c * 128, s0 = c * 128, h = g * 4 + hh;
        f32x4 pv[8];
        { const float* pp = ST + ((size_t)(bc * 8 + g * 4 + (F.tid >> 7)) * 64 + ((F.tid & 127) >> 1)) * 64 + 32 * (F.tid & 1);
#pragma unroll
          for (int q = 0; q < 8; ++q) pv[q] = *(const f32x4*)(pp + 4 * q); }
        dt_cumsum(F, U, m0, g, dtb, alog, dts, acs);
        if (F.tid < 128) ssq[F.tid] = 0.f;
        if (F.tid < 480) { const int j = F.tid % 96, rg = F.tid / 96, r0 = rg * 26, r1 = (r0 + 26 < 128) ? r0 + 26 : 128;
            if (j < 64) { const int cc = j * 4; LAS unsigned char* xp = XI + (cc >> 5) * 8192 + (cc & 31) * 2;
                CONV_ROWS_BEGIN(26, U, m0, s0, g * 256 + cc, cw, cb, r0, r1)
                    v2u pk; pk.x = pk2(v.x, v.y); pk.y = pk2(v.z, v.w); *(LAS v2u*)(xp + r * 64) = pk;
                CONV_ROWS_END }
            else { const int n = ((j < 80) ? (j - 64) : (j - 80)) * 4; LAS unsigned char* kp = ((j < 80) ? BK : CK) + (n >> 3) * 2048 + (n & 7) * 2;
                CONV_ROWS_BEGIN(26, U, m0, s0, ((j < 80) ? 512 : 640) + g * 64 + n, cw, cb, r0, r1)
                    v2u pk; pk.x = pk2(v.x, v.y); pk.y = pk2(v.z, v.w); *(LAS v2u*)(kp + r * 16) = pk;
                CONV_ROWS_END } }
        { const int hq = F.tid >> 7, p = (F.tid & 127) >> 1, nh = F.tid & 1;
          LAS unsigned char* pd = F.lds + ((hq < 3) ? PV_OFF + hq * 8192 : PV3_OFF) + ((4 * nh) * 64 + p) * 16;
#pragma unroll
          for (int q = 0; q < 4; ++q) { v4u o; o.x = pk2(pv[2 * q].x, pv[2 * q].y); o.y = pk2(pv[2 * q].z, pv[2 * q].w); o.z = pk2(pv[2 * q + 1].x, pv[2 * q + 1].y); o.w = pk2(pv[2 * q + 1].z, pv[2 * q + 1].w);
              *(LAS v4u*)(pd + q * 1024) = o; } }
        __syncthreads();
        const float Dh = P(F, 13)[l * 8 + h];
        f32x16 yk[2][2];
        const int trv = (4 * hi + ((lane & 15) >> 2)) * 64 + ((lane >> 4) & 1) * 32 + (lane & 3) * 8;
#pragma unroll
        for (int li = 0; li < 2; ++li) { const int lt = half ? 1 + li : 3 * li;
            bf16x8 cq[4];
#pragma unroll
            for (int d0 = 0; d0 < 4; ++d0) cq[d0] = *(const LAS bf16x8*)(CK + (2 * d0 + hi) * 2048 + (32 * lt + r32) * 16);
            f32x16 o[2]; o[0] = f32x16{}; o[1] = f32x16{};
            const float al = acs[hh * 128 + 32 * lt + r32];
            for (int st = 0; st <= lt; ++st) {
                f32x16 gt = f32x16{};
#pragma unroll
                for (int d0 = 0; d0 < 4; ++d0) { const bf16x8 kf = *(const LAS bf16x8*)(BK + (2 * d0 + hi) * 2048 + (32 * st + r32) * 16); gt = __builtin_amdgcn_mfma_f32_32x32x16_bf16(kf, cq[d0], gt, 0, 0, 0); }
                unsigned pw[8];
                int dd = r32 - 4 * hi; LAS float* ap = acs + hh * 128 + 32 * st + 4 * hi; LAS float* dp = dts + hh * 128 + 32 * st + 4 * hi;
                asm volatile("" : "+v"(dd), "+v"(ap), "+v"(dp));
#pragma unroll
                for (int r = 0; r < 16; r += 2) { float pv[2];
#pragma unroll
                    for (int e = 0; e < 2; ++e) { const int c0 = crow(r + e, 0); const float as = ap[c0], dv = dp[c0];
                        float v = gt[r + e] * exp_f(al - as) * dv;
                        if (st == lt) { v = (c0 <= dd) ? v : 0.f; v += (c0 == dd) ? Dh : 0.f; }
                        pv[e] = v; }
                    pw[r >> 1] = pk2(pv[0], pv[1]); }
                const bf16x8 pa0 = __builtin_bit_cast(bf16x8, (v4u){pw[0], pw[1], pw[2], pw[3]}), pa1 = __builtin_bit_cast(bf16x8, (v4u){pw[4], pw[5], pw[6], pw[7]});
#pragma unroll
                for (int pt = 0; pt < 2; ++pt) { const lcp vp = (lcp)(XI + (hh * 2 + pt) * 8192 + (32 * st) * 64 + trv);
                    const bf16x8 v0 = join(vtr(vp), vtr(vp + 512)), v1 = join(vtr(vp + 1024), vtr(vp + 1024 + 512));
                    o[pt] = __builtin_amdgcn_mfma_f32_32x32x16_bf16(pa0, v0, o[pt], 0, 0, 0); o[pt] = __builtin_amdgcn_mfma_f32_32x32x16_bf16(pa1, v1, o[pt], 0, 0, 0); }
            }
            f32x16 o2[2]; o2[0] = f32x16{}; o2[1] = f32x16{};
            { const LAS unsigned char* pvh = F.lds + ((hh < 3) ? PV_OFF + hh * 8192 : PV3_OFF) + r32 * 16 + hi * 1024;
#pragma unroll
              for (int pt = 0; pt < 2; ++pt)
#pragma unroll
                for (int d0 = 0; d0 < 4; ++d0) { const bf16x8 pb = *(const LAS bf16x8*)(pvh + (2 * d0) * 1024 + pt * 512);
                    o2[pt] = __builtin_amdgcn_mfma_f32_32x32x16_bf16(cq[d0], pb, o2[pt], 0, 0, 0); } }
            { LAS float* ep = acs + hh * 128 + 32 * lt + 4 * hi; LAS float* qp = ssq + 32 * lt + 4 * hi; const bf16* zb = U + (size_t)(m0 + 32 * lt + 4 * hi) * D_INP + U_Z + h * 64 + r32;
              asm volatile("" : "+v"(ep), "+v"(qp), "+v"(zb));
#pragma unroll
              for (int r = 0; r < 16; ++r) { const int c0 = crow(r, 0); const float ea = exp_f(ep[c0]); const bf16* zp = zb + (size_t)c0 * D_INP;
                const float y0 = (o[0][r] + ea * o2[0][r]) * silu_f(bf2f(zp[0])), y1 = (o[1][r] + ea * o2[1][r]) * silu_f(bf2f(zp[32]));
                yk[li][0][r] = y0; yk[li][1][r] = y1; }
              float s2[16];
#pragma unroll
              for (int r = 0; r < 16; ++r) s2[r] = sum16(yk[li][0][r] * yk[li][0][r] + yk[li][1][r] * yk[li][1][r]);
              if ((lane & 15) == 0) {
#pragma unroll
                  for (int r = 0; r < 16; ++r) atomicAdd((float*)(qp + crow(r, 0)), s2[r]); } }
        }
        __syncthreads();
#pragma unroll
        for (int li = 0; li < 2; ++li) { const int lt = half ? 1 + li : 3 * li;
            LAS float* qp = ssq + 32 * lt + 4 * hi; LAS bf16* ot = (LAS bf16*)XI + (32 * lt + 4 * hi) * 256 + hh * 64 + r32; asm volatile("" : "+v"(qp), "+v"(ot));
            const float n0 = nw[h * 64 + r32], n1 = nw[h * 64 + 32 + r32];
#pragma unroll
            for (int r = 0; r < 16; ++r) { const int c0 = crow(r, 0); const float rs = rsq_f(qp[c0] * (1.f / 256.f) + EPS);
                ot[c0 * 256] = (bf16)f2bf(yk[li][0][r] * rs * n0); ot[c0 * 256 + 32] = (bf16)f2bf(yk[li][1][r] * rs * n1); } }
        __syncthreads();
        { const LAS unsigned char* ot = XI + (F.tid >> 5) * 512 + (F.tid & 31) * 16; bf16* ob = O + (size_t)(m0 + (F.tid >> 5)) * DM + 256 + g * 256 + (F.tid & 31) * 8; asm volatile("" : "+v"(ot), "+v"(ob));
#pragma unroll
          for (int i = 0; i < 8; ++i) { const v4u v = *(const LAS v4u*)(ot + i * 16 * 512); *(GAS v4u*)(ob + (size_t)(16 * i) * DM) = v; } }
        __syncthreads();
    }
}
__device__ __forceinline__ void ph_seq_naive(const Frame& F, const Args& a, int l, int qsel, int parts = 3) {
    unsigned char* const ws = WSP(F);
    const int lane = F.lane;
    if ((parts & 1) && F.vcu < 8) gdn_chain(F, F.vcu);
    __syncthreads();
    if (parts & 2) {
        const Frame Fa = reframe(F);
        const attn_body::bf16* Qb = (const attn_body::bf16*)(ws + WS_Q); const attn_body::bf16* Kb = (const attn_body::bf16*)(ws + WS_K); const attn_body::bf16* Vb = (const attn_body::bf16*)(ws + WS_V);
        attn_body::bf16* O = (attn_body::bf16*)(ws + WS_O);
        unsigned* qhead = (unsigned*)(ws + WS_CTL) + CW_ATTQ + 64 * l + 128 * qsel;
        for (;;) {
            if (F.tid == 0) F.MISC[48] = __hip_atomic_fetch_add(qhead, 1u, RLX_AGENT);
            __syncthreads();
            const int it = (int)F.MISC[48];
            __syncthreads();
            if (it >= 8 * 64) break;
            const int qb = 63 - (it >> 3), bh = it & 7;
            attn_body::attn_unit<8>(Fa.tid, bh >> 2, bh & 3, qb, Qb, Kb, Vb, O, (char*)Fa.lds);
        }
    }
}
__device__ __forceinline__ void ph_post_naive(const Frame& F, const Args& a, int l) {
    unsigned char* const ws = WSP(F);
    const bf16* U = (const bf16*)(ws + WS_U); const float* Y = (const float*)(ws + WS_H); const float* OR = (const float*)(ws + WS_OR); bf16* O = (bf16*)(ws + WS_O);
    const float* snw = P(F, 14) + l * 512; const float* gnw = P(F, 19) + l * 64; const int lane = F.lane;
    for (int m = F.gw; m < T; m += F.NGW) {
        { const int c = 4 * lane; f32x4 o = *(const f32x4*)(OR + (size_t)m * 256 + c); const float ss = sum16((o.x * o.x + o.y * o.y) + (o.z * o.z + o.w * o.w));
          const float rs = rsq_f(ss * (1.f / 64.f) + EPS); const f32x4 nw = *(const f32x4*)(gnw + (c & 63)); const v2u zw = *(const v2u*)(U + (size_t)m * D_INP + U_GZ + c);
          o = o * rs * nw; o.x *= silu_f(bflo(zw.x)); o.y *= silu_f(bfhi(zw.x)); o.z *= silu_f(bflo(zw.y)); o.w *= silu_f(bfhi(zw.y));
          v2u w; w.x = pk2(o.x, o.y); w.y = pk2(o.z, o.w); if ((PROBE_SKIP >> (4 + 3 * l)) & 4) { w.x = 0; w.y = 0; } *(v2u*)(O + (size_t)m * DM + 768 + c) = w;
          if ((PROBE_SKIP >> (4 + 3 * l)) & 1) { v2u z; z.x = 0; z.y = 0; *(v2u*)(O + (size_t)m * DM + c) = z; } }
    }
}

constexpr int CW_CHK = 1024;
__device__ __forceinline__ int chk_row(int i) { return i == 0 ? 0 : i == 1 ? 1 : i == 2 ? 255 : i == 3 ? 256 : i == 4 ? 16383 : i == 5 ? 16384 : i == 6 ? 24999 : 32767; }
__device__ __forceinline__ void chk_commit(const Frame& F, int k, float err, float nrm) {
    LAS float* red = (LAS float*)(F.lds + 120000);
    if (F.tid < 2) red[F.tid] = 0.f;
    __syncthreads();
    atomicAdd((float*)(red + 0), err); atomicAdd((float*)(red + 1), nrm);
    __syncthreads();
    if (F.tid == 0) { float* slot = (float*)(WSP(F) + WS_CTL) + CW_CHK + 2 * k; slot[0] = red[0]; slot[1] = red[1]; }
    __syncthreads();
}
__device__ __forceinline__ void chk_rows(const Frame& F, int k, int mode, const bf16* A, int lda, int K, const float* W, const float* W2, int N, const bf16* C, int ldc,
                                         const float* outp, const float* base, int base_ld, bool base_sampled, const float* gate) {
    if (F.vcu != 0) return;
    float err = 0.f, nrm = 0.f;
    for (int col = F.tid; col < N; col += NTHR)
        for (int i = 0; i < 8; ++i) { const int row = chk_row(i); const bf16* ar = A + (size_t)row * lda; float d = 0.f, d2 = 0.f;
            for (int kk = 0; kk < K; ++kk) { const float av = bf2f(ar[kk]); d += av * W[(size_t)kk * N + col]; if (mode == 2) d2 += av * W2[(size_t)kk * N + col]; }
            float ref, got;
            if (mode == 0) { ref = d; got = bf2f(C[(size_t)row * ldc + col]); }
            else if (mode == 1) { const float bs = base_sampled ? base[(size_t)i * base_ld + col] : base[(size_t)row * base_ld + col]; ref = bs + gate[(row / SEQ) * 6144 + col] * d; got = outp[(size_t)row * 1024 + col]; ref -= bs; got -= bs; }
            else { ref = silu_f(d) * d2; got = bf2f(C[(size_t)row * ldc + col]); }
            err += (ref - got) * (ref - got); nrm += ref * ref; }
    chk_commit(F, k, err, nrm);
}

#if PROBE_CHECK
__device__ __forceinline__ void chk_gdn(const Frame& F, int l, int hh) {
    if (F.vcu != 0) return;
    unsigned char* const ws = WSP(F);
    const bf16* U = (const bf16*)(ws + WS_U); const float* OR = (const float*)(ws + WS_OR);
    const float* gcw = P(F, 15) + (size_t)l * 4 * 768; const float* gcb = P(F, 16) + l * 768; const float* gdtb = P(F, 17) + l * 4; const float* galog = P(F, 18) + l * 4;
    LAS float* ks = (LAS float*)(F.lds + 4096); LAS float* qs = ks + 64;
    float e0 = 0.f, n0 = 0.f, e1 = 0.f, n1 = 0.f;
    if (F.wave == 0) {
        const int lane = F.lane; float S[64];
#pragma unroll
        for (int k = 0; k < 64; ++k) S[k] = 0.f;
        float xw[3][3], cwt[3][5];
#pragma unroll
        for (int pz = 0; pz < 3; ++pz) { xw[pz][0] = 0.f; xw[pz][1] = 0.f; xw[pz][2] = 0.f; const int ch = pz * 256 + hh * 64 + lane;
            cwt[pz][0] = gcw[ch]; cwt[pz][1] = gcw[768 + ch]; cwt[pz][2] = gcw[2 * 768 + ch]; cwt[pz][3] = gcw[3 * 768 + ch]; cwt[pz][4] = gcb[ch]; }
        const float gA = -exp_f(galog[hh]), gB = gdtb[hh];
#pragma unroll 1
        for (int t = 0; t < 128; ++t) { const bf16* ur = U + (size_t)t * D_INP; float cvv[3];
#pragma unroll
            for (int pz = 0; pz < 3; ++pz) { const int ch = pz * 256 + hh * 64 + lane; const float xin = bf2f(ur[U_GQKV + ch]);
                const float cv = cwt[pz][4] + cwt[pz][0] * xw[pz][0] + cwt[pz][1] * xw[pz][1] + cwt[pz][2] * xw[pz][2] + cwt[pz][3] * xin;
                xw[pz][0] = xw[pz][1]; xw[pz][1] = xw[pz][2]; xw[pz][2] = xin; cvv[pz] = silu_f(cv); }
            const float qn = cvv[0] * rsq_f(wave_sum(cvv[0] * cvv[0]) + EPS) * 0.125f, kn = cvv[1] * rsq_f(wave_sum(cvv[1] * cvv[1]) + EPS);
            const float beta = sigmoid_f(bf2f(ur[U_GB + hh])), al = exp_f(gA * softplus_f(bf2f(ur[U_GA + hh]) + gB));
            ks[lane] = kn; qs[lane] = qn; LDS_WAIT(); asm volatile("" ::: "memory");
            float kS = 0.f; LAS float* ksv = ks; asm volatile("" : "+v"(ksv));
#pragma unroll
            for (int k = 0; k < 64; k += 4) { const f32x4 k4 = *(const LAS f32x4*)(ksv + k);
                S[k] *= al; kS += k4.x * S[k]; S[k + 1] *= al; kS += k4.y * S[k + 1]; S[k + 2] *= al; kS += k4.z * S[k + 2]; S[k + 3] *= al; kS += k4.w * S[k + 3]; }
            const float vn = beta * (cvv[2] - kS); float o = 0.f;
#pragma unroll
            for (int k = 0; k < 64; k += 4) { const f32x4 k4 = *(const LAS f32x4*)(ksv + k), q4 = *(const LAS f32x4*)(ksv + 64 + k);
                S[k] += k4.x * vn; o += q4.x * S[k]; S[k + 1] += k4.y * vn; o += q4.y * S[k + 1]; S[k + 2] += k4.z * vn; o += q4.z * S[k + 2]; S[k + 3] += k4.w * vn; o += q4.w * S[k + 3]; }
            LDS_WAIT(); asm volatile("" ::: "memory");
            const float got = OR[(size_t)t * 256 + hh * 64 + lane];
            if (t < 64) { e0 += (o - got) * (o - got); n0 += o * o; } else { e1 += (o - got) * (o - got); n1 += o * o; }
        }
    }
    chk_commit(F, 6, e0, n0); chk_commit(F, 7, e1, n1);
}
#endif

#if PROBE_CHECK
__device__ __forceinline__ void chk_gdn2(const Frame& F, int l, int hh) {
    if (F.vcu != 0) return;
    unsigned char* const ws = WSP(F);
    const bf16* U = (const bf16*)(ws + WS_U);
    const bf16* KCp = (const bf16*)(ws + WS_GF + (size_t)(hh * (SEQ / 64)) * GF_UNIT); const bf16* QDp = KCp + 4096; const bf16* QKp = KCp + 8192; const bf16* KTp = KCp + 12288; const bf16* UVp = KCp + 16384;
    const float* gcw = P(F, 15) + (size_t)l * 4 * 768; const float* gcb = P(F, 16) + l * 768; const float* gdtb = P(F, 17) + l * 4; const float* galog = P(F, 18) + l * 4;
    LAS float* qs = (LAS float*)F.lds; LAS float* ks = qs + 4096; LAS float* vs = ks + 4096; LAS float* W1 = vs + 4096; LAS float* W2 = W1 + 4096; LAS float* bt = W2 + 4096; LAS float* gcm = bt + 64;
    float e[5] = {0.f, 0.f, 0.f, 0.f, 0.f}, nn[5] = {0.f, 0.f, 0.f, 0.f, 0.f};
    if (F.wave == 0) {
        int lane = F.lane; asm volatile("" : "+v"(lane));
        float xw[3][3], cwt[3][5];
#pragma unroll
        for (int pz = 0; pz < 3; ++pz) { xw[pz][0] = 0.f; xw[pz][1] = 0.f; xw[pz][2] = 0.f; const int ch = pz * 256 + hh * 64 + lane;
            cwt[pz][0] = gcw[ch]; cwt[pz][1] = gcw[768 + ch]; cwt[pz][2] = gcw[2 * 768 + ch]; cwt[pz][3] = gcw[3 * 768 + ch]; cwt[pz][4] = gcb[ch]; }
        const float gA = -exp_f(galog[hh]), gB = gdtb[hh]; float gsum = 0.f;
#pragma unroll 1
        for (int t = 0; t < 64; ++t) { const bf16* ur = U + (size_t)t * D_INP; float cvv[3];
#pragma unroll
            for (int pz = 0; pz < 3; ++pz) { const int ch = pz * 256 + hh * 64 + lane; const float xin = bf2f(ur[U_GQKV + ch]);
                const float cv = cwt[pz][4] + cwt[pz][0] * xw[pz][0] + cwt[pz][1] * xw[pz][1] + cwt[pz][2] * xw[pz][2] + cwt[pz][3] * xin;
                xw[pz][0] = xw[pz][1]; xw[pz][1] = xw[pz][2]; xw[pz][2] = xin; cvv[pz] = silu_f(cv); }
            qs[t * 64 + lane] = cvv[0] * rsq_f(wave_sum(cvv[0] * cvv[0]) + EPS) * 0.125f; ks[t * 64 + lane] = cvv[1] * rsq_f(wave_sum(cvv[1] * cvv[1]) + EPS); vs[t * 64 + lane] = cvv[2];
            gsum += gA * softplus_f(bf2f(ur[U_GA + hh]) + gB);
            if (lane == 0) { bt[t] = sigmoid_f(bf2f(ur[U_GB + hh])); gcm[t] = gsum; } }
        LDS_WAIT(); asm volatile("" ::: "memory");
        const float g63 = gcm[63];
#pragma unroll 1
        for (int i = 0; i < 64; ++i) { const float gi = gcm[i], bi = bt[i];
            { const float ref = qs[i * 64 + lane] * exp_f(gi), got = bf2f(QDp[gfrag_off(i, lane)]); e[0] += (ref - got) * (ref - got); nn[0] += ref * ref; }
            { const float ref = ks[i * 64 + lane] * exp_f(g63 - gi), got = bf2f(KTp[gfrag_off(lane, i)]); e[1] += (ref - got) * (ref - got); nn[1] += ref * ref; }
            { float d = 0.f; for (int k = 0; k < 64; ++k) d += qs[i * 64 + k] * ks[lane * 64 + k];
              const float ref = (lane <= i) ? d * exp_f(gi - gcm[lane]) : 0.f, got = bf2f(QKp[gfrag_off(i, lane)]); e[2] += (ref - got) * (ref - got); nn[2] += ref * ref; }
            float w1 = bi * vs[i * 64 + lane], w2 = bi * exp_f(gi) * ks[i * 64 + lane];
#pragma unroll 1
            for (int j = 0; j < i; ++j) { const float aij = bi * wave_sum(ks[i * 64 + lane] * ks[j * 64 + lane]) * exp_f(gi - gcm[j]); w1 -= aij * W1[j * 64 + lane]; w2 -= aij * W2[j * 64 + lane]; }
            W1[i * 64 + lane] = w1; W2[i * 64 + lane] = w2; LDS_WAIT(); asm volatile("" ::: "memory");
            { const float got = bf2f(UVp[(((lane >> 4) * 4 + (i >> 4)) * 64 + ((i & 15) >> 2) * 16 + (lane & 15)) * 4 + (i & 3)]); e[3] += (w1 - got) * (w1 - got); nn[3] += w1 * w1; }
            { const float got = -bf2f(KCp[gfrag_off(i, lane)]); e[4] += (w2 - got) * (w2 - got); nn[4] += w2 * w2; } }
    }
#pragma unroll
    for (int k = 0; k < 5; ++k) chk_commit(F, 8 + k, e[k], nn[k]);
}
#endif
__device__ __forceinline__ void moe_load_tstart(const Frame& F, const Args& a) {
    unsigned char* const ws = WSP(F);
    if (F.tid == 0) { unsigned* ctl = (unsigned*)(ws + WS_CTL); unsigned acc = 0;
        for (int e = 0; e < 8; ++e) { const unsigned c = __hip_atomic_load(ctl + CW_MOECNT + 64 * e, RLX_AGENT); F.MISC[16 + e] = acc; F.MISC[32 + e] = c; acc += (c + 255u) >> 8; }
        F.MISC[16 + 8] = acc; }
    __syncthreads();
}
__device__ __forceinline__ void ph_moe_route(const Frame& F, const Args& a, int l) {
    unsigned char* const ws = WSP(F);
    const float* mod = (const float*)(ws + WS_MOD) + (size_t)l * 12288; bf16* H = (bf16*)(ws + WS_H);
    const float* Wr = P(F, 24); const void* src = ws + WS_H;
    int* ROWTOK = (int*)(ws + WS_ROWTOK); int* TOKSLOT = (int*)(ws + WS_TOKSLOT); float* TOKW = (float*)(ws + WS_TOKW);
    unsigned* ctl = (unsigned*)(ws + WS_CTL);
    LAS int* lcnt = (LAS int*)(F.lds + 65536); LAS int* lbase = lcnt + 8; LAS int* se = lcnt + 16; LAS float* sw = (LAS float*)(lcnt + 16 + 256);
    const int lane = F.lane;
    f32x4 wr[4][4][2];
#pragma unroll
    for (int j = 0; j < 4; ++j)
#pragma unroll
        for (int i = 0; i < 4; ++i) { const int col = 4 * lane + 256 * j + i; wr[j][i][0] = *(const f32x4*)(Wr + (size_t)col * 8); wr[j][i][1] = *(const f32x4*)(Wr + (size_t)col * 8 + 4); }
    for (int blk = F.vcu; blk < T / 128; blk += F.G) {
        if (F.tid < 8) lcnt[F.tid] = 0;
        __syncthreads();
        f32x4 xa[4], xb[4];
        norm_row_load(src, (size_t)(blk * 128 + F.wave * 16), true, lane, xa);
#pragma unroll 1
        for (int rr = 0; rr < 16; ++rr) { const int r = F.wave * 16 + rr, m = blk * 128 + r, b = m / SEQ; f32x4 hv[4];
            if (rr + 1 < 16) norm_row_load(src, (size_t)(m + 1), true, lane, xb);
            norm_mod_apply<false>(xa, H + (size_t)m * DM, mod + b * 6144 + 3072, mod + b * 6144 + 4096, lane, hv);
            { unsigned* h8 = (unsigned*)(ws + WS_H8 + (size_t)m * DM) + lane;
#pragma unroll
              for (int j = 0; j < 4; ++j) { int w8 = 0; w8 = __builtin_amdgcn_cvt_pk_fp8_f32(hv[j].x * FP8_SA, hv[j].y * FP8_SA, w8, false); w8 = __builtin_amdgcn_cvt_pk_fp8_f32(hv[j].z * FP8_SA, hv[j].w * FP8_SA, w8, true); h8[64 * j] = (unsigned)w8; } }
            float lg[8];
#pragma unroll
            for (int e = 0; e < 8; ++e) lg[e] = 0.f;
#pragma unroll
            for (int j = 0; j < 4; ++j)
#pragma unroll
                for (int i = 0; i < 4; ++i) { const f32x4 wa = wr[j][i][0], wb = wr[j][i][1]; const float x = hv[j][i];
                    lg[0] += x * wa.x; lg[1] += x * wa.y; lg[2] += x * wa.z; lg[3] += x * wa.w; lg[4] += x * wb.x; lg[5] += x * wb.y; lg[6] += x * wb.z; lg[7] += x * wb.w; }
#pragma unroll
            for (int j = 0; j < 4; ++j) xa[j] = xb[j];
#pragma unroll
            for (int e = 0; e < 8; ++e) lg[e] = wave_sum(lg[e]);
            int e0 = 0; float v0 = lg[0];
#pragma unroll
            for (int e = 1; e < 8; ++e) if (lg[e] > v0) { v0 = lg[e]; e0 = e; }
            int e1 = -1; float v1 = -INFINITY;
#pragma unroll
            for (int e = 0; e < 8; ++e) if (e != e0 && lg[e] > v1) { v1 = lg[e]; e1 = e; }
            const float w0 = rcp_f(1.0f + exp_f(v1 - v0)), w1 = 1.0f - w0;
            if (lane == 0) { const int s0 = atomicAdd((int*)(lcnt + e0), 1), s1 = atomicAdd((int*)(lcnt + e1), 1);
                se[r * 2] = (e0 << 16) | s0; se[r * 2 + 1] = (e1 << 16) | s1; sw[r * 2] = w0; sw[r * 2 + 1] = w1; }
        }
        __syncthreads();
        if (F.tid < 8) lbase[F.tid] = (int)__hip_atomic_fetch_add(ctl + CW_MOECNT + 64 * F.tid, (unsigned)lcnt[F.tid], RLX_AGENT);
        __syncthreads();
        if (F.tid < 256) { const int r = F.tid >> 1, k = F.tid & 1, v = se[F.tid], e = v >> 16, idx = lbase[e] + (v & 0xffff), m = blk * 128 + r;
            ROWTOK[e * 32768 + idx] = m; TOKSLOT[m * 2 + k] = (e << 20) | idx; TOKW[m * 2 + k] = sw[F.tid]; }
        __syncthreads();
    }
}
__device__ __forceinline__ void ph_scale_w(const Frame& F, const float* modl, int which, const bf16* Wt, int N, bf16* Wo, float* bias, bool f8) {
    const int lane = F.lane;
    for (int n = F.gw; n < N; n += F.NGW) {
        const v4u wa = *(const v4u*)(Wt + (size_t)n * 1024 + lane * 16), wb = *(const v4u*)(Wt + (size_t)n * 1024 + lane * 16 + 8);
        float w[16] = {bflo(wa.x), bfhi(wa.x), bflo(wa.y), bfhi(wa.y), bflo(wa.z), bfhi(wa.z), bflo(wa.w), bfhi(wa.w), bflo(wb.x), bfhi(wb.x), bflo(wb.y), bfhi(wb.y), bflo(wb.z), bfhi(wb.z), bflo(wb.w), bfhi(wb.w)};
#pragma unroll
        for (int b = 0; b < 2; ++b) { const float* sh = modl + b * 6144 + which * 3072 + lane * 16; const float* sc = sh + 1024; float dot = 0.f; float o[16];
#pragma unroll
            for (int q = 0; q < 4; ++q) { const f32x4 s4 = *(const f32x4*)(sh + 4 * q), c4 = *(const f32x4*)(sc + 4 * q);
#pragma unroll
                for (int e = 0; e < 4; ++e) { o[4 * q + e] = w[4 * q + e] * (1.0f + c4[e]); dot += s4[e] * w[4 * q + e]; } }
            v4u oa, ob; oa.x = pk2(o[0], o[1]); oa.y = pk2(o[2], o[3]); oa.z = pk2(o[4], o[5]); oa.w = pk2(o[6], o[7]); ob.x = pk2(o[8], o[9]); ob.y = pk2(o[10], o[11]); ob.z = pk2(o[12], o[13]); ob.w = pk2(o[14], o[15]);
            if (f8) { v4u o8;
#pragma unroll
                for (int q = 0; q < 4; ++q) { int w8 = 0; w8 = __builtin_amdgcn_cvt_pk_fp8_f32(o[4 * q] * FP8_SW, o[4 * q + 1] * FP8_SW, w8, false); w8 = __builtin_amdgcn_cvt_pk_fp8_f32(o[4 * q + 2] * FP8_SW, o[4 * q + 3] * FP8_SW, w8, true); o8[q] = (unsigned)w8; }
                *(v4u*)((unsigned char*)Wo + ((size_t)b * N + n) * 1024 + lane * 16) = o8; }
            else { bf16* dst = Wo + ((size_t)b * N + n) * 1024 + lane * 16; *(v4u*)dst = oa; *(v4u*)(dst + 8) = ob; }
            dot = wave_sum(dot); if (lane == 0) bias[b * N + n] = dot; }
    }
}
__device__ __forceinline__ void ph_moe_conv(const Frame& F, const Args& a, int ci, int cn) {
    _Pragma("unroll 1") for (int r2 = 0; r2 < DUPN(13); ++r2) {
        unsigned char* const ws = WSP(F); const int lane = F.lane;
        constexpr int NBLK = 8 * 3 * 112;
        const int rh = lane >> 5, n4 = lane & 31;
        f32x4 cur[16], nxt[16];
#define MOE_BLK(b_, Wp_, ldw_, WTp_, ldt_) \
        const int e_ = (b_) / 336; int r_ = (b_) % 336; const int which_ = r_ / 112; r_ %= 112; \
        const float* Wp_; int ldw_, ldt_; unsigned char* WTp_; \
        if (which_ < 2) { const int kb_ = r_ / 28, nb_ = r_ % 28; Wp_ = P(F, 25 + which_) + (size_t)e_ * 1024 * DFFE + (size_t)(kb_ * 256) * DFFE + nb_ * 128; ldw_ = DFFE; \
            WTp_ = ws + WS_MUP + (size_t)e_ * 7168 * 1024 + (size_t)(256 * nb_ + 128 * which_) * 1024 + kb_ * 256; ldt_ = 1024; } \
        else { const int kb_ = r_ / 8, nb_ = r_ % 8; Wp_ = P(F, 27) + (size_t)e_ * DFFE * 1024 + (size_t)(kb_ * 256) * 1024 + nb_ * 128; ldw_ = 1024; \
            WTp_ = ws + WS_MDN + (size_t)e_ * 1024 * DFFE + (size_t)(nb_ * 128) * DFFE + kb_ * 256; ldt_ = DFFE; }
        int blkc = ci, buf = 0;
        if (blkc < NBLK) { MOE_BLK(blkc, W0, ldw0, WT0, ldt0) (void)WT0; (void)ldt0;
            const float* wp = W0 + (size_t)(32 * F.wave + 16 * rh) * ldw0 + 4 * n4;
#pragma unroll
            for (int j = 0; j < 16; ++j) cur[j] = *(const f32x4*)(wp + (size_t)j * ldw0); }
        for (; blkc < NBLK; blkc += cn) {
            const int bn = blkc + cn;
            if (bn < NBLK) { MOE_BLK(bn, W1, ldw1, WT1, ldt1) (void)WT1; (void)ldt1;
                const float* wp = W1 + (size_t)(32 * F.wave + 16 * rh) * ldw1 + 4 * n4;
#pragma unroll
                for (int j = 0; j < 16; ++j) nxt[j] = *(const f32x4*)(wp + (size_t)j * ldw1); }
            MOE_BLK(blkc, Wc, ldwc, WTc, ldtc) (void)Wc; (void)ldwc;
            LAS unsigned char* img = F.lds + buf * 32768;
#pragma unroll
            for (int i = 0; i < 4; ++i) { v4u o;
#pragma unroll
                for (int q = 0; q < 4; ++q) { int w8 = 0; w8 = __builtin_amdgcn_cvt_pk_fp8_f32(cur[4 * q][i] * FP8_SW, cur[4 * q + 1][i] * FP8_SW, w8, false); w8 = __builtin_amdgcn_cvt_pk_fp8_f32(cur[4 * q + 2][i] * FP8_SW, cur[4 * q + 3][i] * FP8_SW, w8, true); o[q] = (unsigned)w8; }
                *(LAS v4u*)(img + (4 * n4 + i) * 256 + (((2 * F.wave + rh) ^ (n4 & 15)) << 4)) = o; }
            __syncthreads();
            { const int chunk = F.tid & 15, rb = F.tid >> 4;
#pragma unroll
              for (int i = 0; i < 4; ++i) { const int row = rb + 32 * i; const v4u v = *(const LAS v4u*)(img + row * 256 + ((chunk ^ ((row >> 2) & 15)) << 4));
                  *(GAS v4u*)(WTc + (size_t)row * ldtc + chunk * 16) = v; } }
#pragma unroll
            for (int j = 0; j < 16; ++j) cur[j] = nxt[j];
            buf ^= 1;
        }
#undef MOE_BLK
        __syncthreads();
    }
}
template <bool GATHER_> struct MoeOrder {
    static constexpr bool GATHER = GATHER_;
    int ntile, nN, G, c, tile0; volatile LAS unsigned* ts; const int* rowtok;
    __device__ __forceinline__ bool next(int i, pg8::Unit& u) const {
        int pm, pcol;
        if ((G & 7) == 0) { const int NG = ((nN & 3) == 0 && nN >= 8) ? 4 : 1, XPG = 8 / NG, ncg = nN / NG, x = c & 7, gq = x / XPG, sub = x % XPG;
            const int nrt = (ntile > sub) ? (ntile - sub + XPG - 1) / XPG : 0, k = i * (G >> 3) + (c >> 3);
            if (k >= nrt * ncg) return false;
            pm = tile0 + (k / ncg) * XPG + sub; pcol = gq * ncg + k % ncg; }
        else { const int L = i * G + c; if (L >= ntile * nN) return false; pm = tile0 + L / nN; pcol = L % nN; }
        int e = 0;
#pragma unroll
        for (int j = 1; j < 8; ++j) e += (pm >= (int)ts[j]) ? 1 : 0;
        const int lt = pm - (int)ts[e];
        u.pm = pm; u.pn = e * nN + pcol; u.ab = e * 32768 + lt * 256; u.av = (int)ts[16 + e] - lt * 256; return true; }
    __device__ __forceinline__ int arow(const pg8::Unit& u, int r) const {
        if constexpr (!GATHER_) return (u.pm - tile0) * 256 + r;
        else { const int rc = r < u.av ? r : u.av - 1; return rowtok[u.ab + rc]; } }
};
__device__ __forceinline__ void ph_final(const Frame& F, const Args& a) {
    unsigned char* const ws = WSP(F);
    moe_load_tstart(F, a);
    const float* mod = (const float*)(ws + WS_MOD) + (size_t)1 * 12288; const bf16* Y = (const bf16*)(ws + WS_Y);
    const int* TOKSLOT = (const int*)(ws + WS_TOKSLOT); const float* TOKW = (const float*)(ws + WS_TOKW); const float* fn = P(F, 28); float* out = OUTP(F);
    const bf16* xs = (const bf16*)(ws + WS_H);
    const int lane = F.lane, m0 = F.gw, st = F.NGW;
    int sA0 = 0, sA1 = 0, sB0 = 0, sB1 = 0; float wA0 = 0.f, wA1 = 0.f, wB0 = 0.f, wB1 = 0.f;
    v2u xc[4], xn[4]; v2u yac[4], ybc[4], yan[4], ybn[4];
#define FIN_IDX(m_, s0_, s1_, w0_, w1_) { s0_ = TOKSLOT[(m_) * 2]; s1_ = TOKSLOT[(m_) * 2 + 1]; w0_ = TOKW[(m_) * 2]; w1_ = TOKW[(m_) * 2 + 1]; }
#define FIN_ROWS(m_, s0_, s1_, x_, ya_, yb_) { const size_t r0 = (size_t)F.MISC[16 + ((s0_) >> 20)] * 256 + ((s0_) & 0xfffff), r1 = (size_t)F.MISC[16 + ((s1_) >> 20)] * 256 + ((s1_) & 0xfffff); \
        _Pragma("unroll") for (int j = 0; j < 4; ++j) { const int c = 4 * lane + 256 * j; x_[j] = *(const v2u*)(xs + (size_t)(m_) * DM + c); ya_[j] = *(const v2u*)(Y + r0 * DM + c); yb_[j] = *(const v2u*)(Y + r1 * DM + c); } }
    if (m0 < T) { FIN_IDX(m0, sA0, sA1, wA0, wA1) FIN_ROWS(m0, sA0, sA1, xc, yac, ybc) }
    if (m0 + st < T) FIN_IDX(m0 + st, sB0, sB1, wB0, wB1)
#pragma unroll 1
    for (int m = m0; m < T; m += st) { const int b = m / SEQ;
        const float w0 = wA0, w1 = wA1;
        if (m + st < T) FIN_ROWS(m + st, sB0, sB1, xn, yan, ybn)
        sA0 = sB0; sA1 = sB1; wA0 = wB0; wA1 = wB1;
        if (m + 2 * st < T) FIN_IDX(m + 2 * st, sB0, sB1, wB0, wB1)
        f32x4 v[4]; float ss = 0.f;
#pragma unroll
        for (int j = 0; j < 4; ++j) { const int c = 4 * lane + 256 * j; const f32x4 x = {bflo(xc[j].x), bfhi(xc[j].x), bflo(xc[j].y), bfhi(xc[j].y)}; const f32x4 g2 = *(const f32x4*)(mod + b * 6144 + 5120 + c);
            const v2u ya = yac[j], yb = ybc[j];
            f32x4 f; f.x = w0 * bflo(ya.x) + w1 * bflo(yb.x); f.y = w0 * bfhi(ya.x) + w1 * bfhi(yb.x); f.z = w0 * bflo(ya.y) + w1 * bflo(yb.y); f.w = w0 * bfhi(ya.y) + w1 * bfhi(yb.y);
            v[j] = (PROBE_SKIP & 1) ? x : x + g2 * f; ss += (v[j].x * v[j].x + v[j].y * v[j].y) + (v[j].z * v[j].z + v[j].w * v[j].w); }
        const float rs = rsq_f(wave_sum(ss) * (1.f / 1024.f) + EPS);
        { float* orow = out + (size_t)m * DM;
#pragma unroll
          for (int j = 0; j < 4; ++j) { const int c = 4 * lane + 256 * j; const f32x4 nw = *(const f32x4*)(fn + c); *(f32x4*)(orow + c) = v[j] * rs * nw; } }
#pragma unroll
        for (int j = 0; j < 4; ++j) { xc[j] = xn[j]; yac[j] = yan[j]; ybc[j] = ybn[j]; }
    }
#undef FIN_IDX
#undef FIN_ROWS
}


#if PROBE_CHECK
__device__ __forceinline__ void chk_moe(const Frame& F) {
    if (F.vcu != 0) return;
    unsigned char* const ws = WSP(F);
    const bf16* H = (const bf16*)(ws + WS_H); const bf16* Y = (const bf16*)(ws + WS_Y);
    const int* TOKSLOT = (const int*)(ws + WS_TOKSLOT); const float* TOKW = (const float*)(ws + WS_TOKW);
    const float* Wr = P(F, 24); const float* Wg = P(F, 25); const float* Wu = P(F, 26); const float* Wd = P(F, 27);
    LAS float* hrow = (LAS float*)F.lds; LAS float* hid = hrow + 1024; LAS float* yacc = hid + 3584; LAS float* lg = yacc + 1024;
    float err = 0.f, nrm = 0.f, rerr = 0.f;
    for (int i = 0; i < 8; ++i) { const int tok = chk_row(i);
        for (int k = F.tid; k < 1024; k += NTHR) { hrow[k] = bf2f(H[(size_t)tok * 1024 + k]); yacc[k] = 0.f; }
        __syncthreads();
        if (F.tid < 8) { float s = 0.f; for (int k = 0; k < 1024; ++k) s += hrow[k] * Wr[k * 8 + F.tid]; lg[F.tid] = s; }
        __syncthreads();
        const int s0 = TOKSLOT[tok * 2], s1 = TOKSLOT[tok * 2 + 1]; const float w0 = TOKW[tok * 2], w1 = TOKW[tok * 2 + 1];
        if (F.tid == 0) { int e0 = 0; for (int e = 1; e < 8; ++e) if (lg[e] > lg[e0]) e0 = e; int e1 = -1; for (int e = 0; e < 8; ++e) if (e != e0 && (e1 < 0 || lg[e] > lg[e1])) e1 = e;
            const float nw0 = rcp_f(1.f + exp_f(lg[e1] - lg[e0]));
            if ((s0 >> 20) != e0 || (s1 >> 20) != e1 || fabsf(nw0 - w0) > 0.02f || fabsf(w0 + w1 - 1.f) > 1e-3f) rerr += 1.f; }
        for (int kx = 0; kx < 2; ++kx) { const int e = (kx ? s1 : s0) >> 20; const float w = kx ? w1 : w0;
            const float* wg = Wg + (size_t)e * 1024 * DFFE; const float* wu = Wu + (size_t)e * 1024 * DFFE; const float* wd = Wd + (size_t)e * DFFE * 1024;
            for (int j = F.tid; j < DFFE; j += NTHR) { float g = 0.f, u = 0.f; for (int k = 0; k < 1024; ++k) { const float hv = hrow[k]; g += hv * wg[(size_t)k * DFFE + j]; u += hv * wu[(size_t)k * DFFE + j]; } hid[j] = silu_f(g) * u; }
            __syncthreads();
            for (int c = F.tid; c < 1024; c += NTHR) { float y = 0.f; for (int j = 0; j < DFFE; ++j) y += hid[j] * wd[(size_t)j * 1024 + c]; yacc[c] += w * y; }
            __syncthreads(); }
        const size_t r0 = (size_t)F.MISC[16 + (s0 >> 20)] * 256 + (s0 & 0xfffff), r1 = (size_t)F.MISC[16 + (s1 >> 20)] * 256 + (s1 & 0xfffff);
        for (int c = F.tid; c < 1024; c += NTHR) { const float f = w0 * bf2f(Y[r0 * 1024 + c]) + w1 * bf2f(Y[r1 * 1024 + c]); err += (yacc[c] - f) * (yacc[c] - f); nrm += yacc[c] * yacc[c]; }
        __syncthreads();
    }
    chk_commit(F, 4, err, nrm); chk_commit(F, 5, rerr, 1.f);
}
__device__ __forceinline__ void ph_probe_scale(const Frame& F) {
    const float* slot = (const float*)(WSP(F) + WS_CTL) + CW_CHK; float code;
    if (PROBE_CHECK == 1) { int mask = 0; for (int k = 0; k < 5; ++k) { const float e = slot[2 * (PROBE_BASE + k)], n = slot[2 * (PROBE_BASE + k) + 1]; if (!(n > 0.f) || !(e <= 1e-3f * n)) mask |= 1 << k; } code = 10.f + (float)mask; }
    else { const int k = PROBE_CHECK - 2; const float e = slot[2 * k], n = slot[2 * k + 1]; float r = (n > 0.f) ? (k == 5 ? e * 0.125f : sqrtf(e / n)) : 1.f; if (!(r <= 1.f)) r = 1.f; code = 10.f + 30.f * r; }
    if (PROBE_CHECK == 100) code = wave_sum((float)F.lane + 1.0f) * (1.0f / 32.5f);
    if (PROBE_CHECK == 101) code = wave_max((float)F.lane) + sum16((float)(F.lane & 15)) * 0.1f;
    float* out = OUTP(F);
    for (int m = F.gw; m < T; m += F.NGW)
#pragma unroll
        for (int j = 0; j < 4; ++j) { f32x4* p4 = (f32x4*)(out + (size_t)m * DM + 4 * F.lane + 256 * j); *p4 = *p4 * (1.f + code); }
}
#endif
#ifndef MK_MULTI
#define MK_MULTI 0
#endif
constexpr int N_PHASES = 21 + (PROBE_CHECK ? 1 : 0);
__global__ void __launch_bounds__(NTHR, 2) mega_fwd(Args args) {
    extern __shared__ __attribute__((aligned(16))) unsigned char lds[];
    Frame F;
    F.lds = (LAS unsigned char*)lds; F.MISC = (volatile LAS unsigned*)(F.lds + MISC_OFF);
    F.tid = threadIdx.x; F.lane = F.tid & 63; F.wave = __builtin_amdgcn_readfirstlane(F.tid >> 6);
    F.G = gridDim.x; { const int bx = blockIdx.x; F.vcu = (F.G % 8 == 0) ? (bx % 8) * (F.G / 8) + bx / 8 : bx; }
    F.gw = F.vcu * NWAVES + F.wave; F.NGW = F.G * NWAVES;
    for (int u = F.tid; u < (LDS_BYTES - RING_BYTES) / 4; u += NTHR) ((LAS unsigned*)(F.lds + RING_BYTES))[u] = 0u;
    __syncthreads();
#pragma unroll
    for (int i = 0; i < 29; ++i) if (F.tid == i) { const unsigned long long v = (unsigned long long)args.in[i]; F.MISC[64 + 2 * i] = (unsigned)v; F.MISC[65 + 2 * i] = (unsigned)(v >> 32); }
    if (F.tid == 29) { const unsigned long long v = (unsigned long long)args.ws; F.MISC[64 + 58] = (unsigned)v; F.MISC[65 + 58] = (unsigned)(v >> 32); }
    if (F.tid == 30) { const unsigned long long v = (unsigned long long)args.out; F.MISC[64 + 60] = (unsigned)v; F.MISC[65 + 60] = (unsigned)(v >> 32); }
    __syncthreads();
    XcdBarrier bar; bar.bar = (unsigned*)(WSP(F) + WS_CTL) + CW_BAR; bar.x = 0; bar.st = nullptr;
    if (!MK_MULTI) bar = xcd_barrier_post((unsigned*)(WSP(F) + WS_CTL) + CW_BAR, F.MISC + 8);
    const int lo = args.ph_lo, hi = args.ph_hi; int pid = 0;
#define PH_ON (pid >= opq(lo) && pid < opq(hi))
#define PH_END do { if (!MK_MULTI && pid >= opq(lo) && pid + 1 < opq(hi)) xcd_barrier(bar); ++pid; } while (0)
#define PH_PTRS const Frame Fp = reframe(F); unsigned char* const ws = WSP(Fp); const float* const mod = (const float*)(ws + WS_MOD); bf16* const H = (bf16*)(ws + WS_H); bf16* const U = (bf16*)(ws + WS_U); bf16* const O = (bf16*)(ws + WS_O); (void)mod; (void)H; (void)U; (void)O

    if (PH_ON) { _Pragma("unroll 1") for (int rp = 0; rp < DUPN(5); ++rp) { const Frame Fp = reframe(F); ph_prologue(Fp, args); __syncthreads(); } }
    PH_END;
    for (int l = 0; l < 2; ++l) {
#if PROBE_CHECK
        if (PH_ON && l == 1) { const Frame Fp = reframe(F); unsigned char* const ws = WSP(Fp);
            chk_rows(Fp, 3, 1, (const bf16*)(ws + WS_U), DFF, DFF, P(Fp, 23), nullptr, 1024, nullptr, 0, OUTP(Fp), (const float*)(ws + WS_DT), 1024, true, (const float*)(ws + WS_MOD) + 5120); }
#endif
        if (l == 0) {
        if (PH_ON) { _Pragma("unroll 1") for (int rp = 0; rp < DUPN(6); ++rp) { const Frame Fp = reframe(F); ph_normmod(Fp, args, (const void*)P(Fp, 0), false, 0, 0); } }
        PH_END; }
        if (PH_ON) { _Pragma("unroll 1") for (int rp = 0; rp < DUPN(0); ++rp) {
            PH_PTRS; const int lp = opq(l);
            pg8::Gemm g{(lp == 0) ? (const bf16*)H : (const bf16*)OUTP(Fp), (lp == 0) ? (const bf16*)(ws + WS_WIN) : (const bf16*)(ws + WS_WINS), 1024, 1024};
            pg8::BatchOrder S; S.init(T, D_INP, Fp.G, (int)blockIdx.x, lp, SEQ);
            pg8::EpiStoreBf16 E{U, D_INP, D_INP / 256, 0, 1.0f, (lp == 0) ? (const float*)nullptr : (const float*)(ws + WS_PARTB), (const float*)(ws + WS_BIASW), D_INP, SEQ};
            pg8::gemm_phase<pg8::EpiStoreBf16, pg8::BatchOrder, true>(Fp.lds, Fp.tid, g, S, E);
        } }
        PH_END;
#if PROBE_CHECK
        if (PH_ON && l == 0) { const Frame Fp = reframe(F); unsigned char* const ws = WSP(Fp);
            chk_rows(Fp, 0, 0, (const bf16*)(ws + WS_H), 1024, 1024, P(Fp, 4), nullptr, D_IN, (const bf16*)(ws + WS_U), D_INP, nullptr, nullptr, 0, false, nullptr); }
#endif
        if (PH_ON) { _Pragma("unroll 1") for (int rp = 0; rp < DUPN(1); ++rp) { _Pragma("unroll 1") for (int r2 = 0; r2 < DUPN(7); ++r2) { const Frame Fp = reframe(F); ph_mla(Fp, args, opq(l)); }
            _Pragma("unroll 1") for (int r2 = 0; r2 < DUPN(8); ++r2) { const Frame Fp = reframe(F); ph_gdn_prep(Fp, args, opq(l)); __syncthreads(); }
            _Pragma("unroll 1") for (int r2 = 0; r2 < DUPN(9); ++r2) { const Frame Fp = reframe(F); ph_ssd_states(Fp, args, opq(l)); } } }
        PH_END;
        if (PH_ON) { { const Frame Fp = reframe(F); ph_ssd_scan(Fp, args); } if (DUPN(10) > 1) { const Frame Fp = reframe(F); ph_ssd_scan(Fp, args, true); } _Pragma("unroll 1") for (int rp = 0; rp < DUPN(2); ++rp) { const Frame Fp = reframe(F); ph_seq_naive(Fp, args, opq(l), opq(rp)); __syncthreads(); }
            if (DUPN(17) > 1) { const Frame Fp = reframe(F); ph_seq_naive(Fp, args, opq(l), 2, 1); __syncthreads(); }
            if (DUPN(18) > 1) { const Frame Fp = reframe(F); ph_seq_naive(Fp, args, opq(l), 3, 2); __syncthreads(); } }
        PH_END;
        #if PROBE_CHECK
        if (PH_ON && l == 0) { const Frame Fp = reframe(F); chk_gdn2(Fp, 0, PROBE_HEAD); __syncthreads(); }
#endif
        if (PH_ON) { _Pragma("unroll 1") for (int r2 = 0; r2 < DUPN(11); ++r2) { Frame Fp = reframe(F); const int lp = opq(l);
                if (lp == 1) { if (Fp.vcu >= CONV_NY) Fp.vcu = 1 << 20; Fp.G = CONV_NY; }
                ph_ssd_y(Fp, args, lp); }
            if (opq(l) == 1) { const Frame Fp = reframe(F); if (Fp.vcu >= CONV_NY) ph_moe_conv(Fp, args, Fp.vcu - CONV_NY, Fp.G - CONV_NY); __syncthreads(); } _Pragma("unroll 1") for (int r2 = 0; r2 < DUPN(12); ++r2) { const Frame Fp = reframe(F); ph_post_naive(Fp, args, opq(l)); }
            if (opq(l) == 0) {
                { const Frame Fp = reframe(F); unsigned char* const ws = WSP(Fp); ph_scale_w(Fp, (const float*)(ws + WS_MOD), 1, (const bf16*)(ws + WS_FUP), 2 * DFF, (bf16*)(ws + WS_FUPS), (float*)(ws + WS_BIASF), true); }
                { const Frame Fp = reframe(F); unsigned char* const ws = WSP(Fp); ph_scale_w(Fp, (const float*)(ws + WS_MOD) + 12288, 0, (const bf16*)(ws + WS_WIN) + (size_t)D_INP * 1024, D_INP, (bf16*)(ws + WS_WINS), (float*)(ws + WS_BIASW), false); } } }
        PH_END;
        if (PH_ON) { _Pragma("unroll 1") for (int r2 = 0; r2 < ((l == 0) ? DUPN(15) : 1); ++r2) {
            PH_PTRS; const int lp = opq(l); const void* xsrc = (lp == 0) ? (const void*)P(Fp, 0) : (const void*)OUTP(Fp);
            pg8::Gemm g{O, (const bf16*)(ws + WS_WOUT) + (size_t)lp * 1024 * 1024, 1024, 1024}; pg8::StaticOrder S; S.init(T, 1024, Fp.G, (int)blockIdx.x);
            pg8::EpiResGate E{xsrc, (lp == 0) ? (bf16*)OUTP(Fp) : (bf16*)(ws + WS_H), mod + (size_t)lp * 12288 + 2048, 6144, SEQ, lp == 0, (lp == 0) ? (unsigned char*)(ws + WS_H) : (unsigned char*)nullptr, FP8_SA, (lp == 0) ? (float*)(ws + WS_PARTA) : (float*)nullptr, (PG8_LAS float*)(Fp.lds + RING_BYTES + 4096)};
            pg8::gemm_phase<pg8::EpiResGate, pg8::StaticOrder, true>(Fp.lds, Fp.tid, g, S, E);
        } }
        PH_END;
        if (l == 0) {
#if PROBE_CHECK
            if (PH_ON) { const Frame Fp = reframe(F); unsigned char* const ws = WSP(Fp);
                chk_rows(Fp, 1, 1, (const bf16*)(ws + WS_O), 1024, 1024, P(Fp, 20), nullptr, 1024, nullptr, 0, OUTP(Fp), P(Fp, 0), 1024, false, (const float*)(ws + WS_MOD) + 2048); }
#endif
#if PROBE_CHECK
            if (PH_ON) { const Frame Fp = reframe(F); if (Fp.vcu == 0) { float* sv = (float*)(WSP(Fp) + WS_DT); const float* o = OUTP(Fp); for (int i = 0; i < 8; ++i) for (int c = Fp.tid; c < 1024; c += NTHR) sv[i * 1024 + c] = o[(size_t)chk_row(i) * 1024 + c]; } }
#endif
            if (PH_ON && !(PROBE_SKIP & 2)) { _Pragma("unroll 1") for (int rp = 0; rp < DUPN(3); ++rp) {
                PH_PTRS;
                pg8::Gemm g{(const bf16*)(ws + WS_H), (const bf16*)(ws + WS_FUPS), 512, 512}; pg8::BatchOrder S; S.init(T, 2 * DFF, Fp.G, (int)blockIdx.x, 1, SEQ);
                pg8::EpiSwiglu E{U, DFF, 2 * DFF / 256, 0, 1.0f / (FP8_SA * FP8_SW), 1.0f, (const float*)(ws + WS_PARTA), (const float*)(ws + WS_BIASF), 2 * DFF, SEQ};
                pg8::gemm_phase<pg8::EpiSwiglu, pg8::BatchOrder, true, true>(Fp.lds, Fp.tid, g, S, E);
            } }
            PH_END;
#if PROBE_CHECK
            if (PH_ON) { const Frame Fp = reframe(F); unsigned char* const ws = WSP(Fp);
                chk_rows(Fp, 2, 2, (const bf16*)(ws + WS_H), 1024, 1024, P(Fp, 21), P(Fp, 22), DFF, (const bf16*)(ws + WS_U), DFF, nullptr, nullptr, 0, false, nullptr); }
#endif
            if (PH_ON && !(PROBE_SKIP & 2)) {
                PH_PTRS; float* const outp = OUTP(Fp);
                pg8::Gemm g{U, (const bf16*)(ws + WS_FDN), DFF, DFF}; pg8::StaticOrder S; S.init(T, 1024, Fp.G, (int)blockIdx.x);
                pg8::EpiResGate E{outp, (bf16*)outp, mod + (size_t)opq(l) * 12288 + 5120, 6144, SEQ, false, (unsigned char*)nullptr, 1.0f, (float*)(ws + WS_PARTB), (PG8_LAS float*)(Fp.lds + RING_BYTES + 4096)};
                pg8::gemm_phase<pg8::EpiResGate, pg8::StaticOrder, true>(Fp.lds, Fp.tid, g, S, E);
            }
            PH_END;
        } else {
            if (PH_ON) { const Frame Fp = reframe(F); ph_moe_route(Fp, args, opq(l)); }
            PH_END;
            for (int st = 0; st < 5; ++st) {
                if (PH_ON && st >= 1) {
                    PH_PTRS; moe_load_tstart(Fp, args);
                    const int chq = opq(st) - 1, R = (int)Fp.MISC[24], tile0 = chq * 64, ntile = (chq == 3) ? ((R - tile0) > 0 ? (R - tile0) : 0) : ((R - tile0) < 64 ? ((R - tile0) > 0 ? (R - tile0) : 0) : 64);
                    pg8::Gemm g{(const bf16*)(ws + WS_HID + (size_t)(chq & 1) * HID_STRIDE), (const bf16*)(ws + WS_MDN), DFFE / 2, DFFE / 2};
                    MoeOrder<false> S{ntile, 4, Fp.G, (int)blockIdx.x, tile0, Fp.MISC + 16, (const int*)(ws + WS_ROWTOK)};
                    pg8::EpiStoreBf16 E{(bf16*)(ws + WS_Y), 1024, 4, 0, 1.0f / (FP8_SA * FP8_SW), nullptr, nullptr, 0, SEQ};
                    pg8::gemm_phase<pg8::EpiStoreBf16, MoeOrder<false>, true, true>(Fp.lds, Fp.tid, g, S, E);
                }
                if (PH_ON && st <= 3) { _Pragma("unroll 1") for (int rp = 0; rp < DUPN(4); ++rp) {
                    PH_PTRS; moe_load_tstart(Fp, args);
                    const int chq = opq(st), R = (int)Fp.MISC[24], tile0 = chq * 64, ntile = (chq == 3) ? ((R - tile0) > 0 ? (R - tile0) : 0) : ((R - tile0) < 64 ? ((R - tile0) > 0 ? (R - tile0) : 0) : 64);
                    pg8::Gemm g{(const bf16*)(ws + WS_H8), (const bf16*)(ws + WS_MUP), 512, 512};
                    MoeOrder<true> S{ntile, 28, Fp.G, (int)blockIdx.x, tile0, Fp.MISC + 16, (const int*)(ws + WS_ROWTOK)};
                    pg8::EpiSwigluT<true, false> E{(bf16*)(ws + WS_HID + (size_t)(chq & 1) * HID_STRIDE), DFFE, 28, tile0, 1.0f / (FP8_SA * FP8_SW), FP8_SA, nullptr, nullptr, 0, SEQ};
                    pg8::gemm_phase<pg8::EpiSwigluT<true, false>, MoeOrder<true>, true, true>(Fp.lds, Fp.tid, g, S, E);
                } }
                PH_END;
            }
        }
    }
    if (DUPN(14) > 1 && !MK_MULTI) { _Pragma("unroll 1") for (int r2 = 0; r2 < 32; ++r2) xcd_barrier(bar); }
    if (PH_ON) { const Frame Fp = reframe(F); ph_final(Fp, args); }
#if PROBE_CHECK
    if (PH_ON) { const Frame Fp = reframe(F); moe_load_tstart(Fp, args); chk_moe(Fp); }
#endif
    PH_END;
#if PROBE_CHECK
    if (PH_ON) { const Frame Fp = reframe(F); ph_probe_scale(Fp); }
    PH_END;
#endif
#undef PH_ON
#undef PH_END
}

extern "C" void kernel_launch(void* const* d_in, const int* in_sizes, int n_in, void* d_out, int out_size, void* d_ws, size_t ws_size, hipStream_t stream) {
    static int grid = 0;
    if (grid == 0) {
        if (n_in != 29 || out_size != T * DM || ws_size < WS_END) { fprintf(stderr, "kernel_launch: unexpected shapes/workspace (n_in %d out %d ws %zu need %zu)\n", n_in, out_size, ws_size, (size_t)WS_END); grid = -1; return; }
        int dev = 0, cus = 0, per_cu = 0;
        if (hipGetDevice(&dev) != hipSuccess || hipDeviceGetAttribute(&cus, hipDeviceAttributeMultiprocessorCount, dev) != hipSuccess) { grid = -1; return; }
        if (hipFuncSetAttribute((const void*)mega_fwd, hipFuncAttributeMaxDynamicSharedMemorySize, LDS_BYTES) != hipSuccess) { fprintf(stderr, "kernel_launch: hipFuncSetAttribute failed\n"); grid = -1; return; }
        if (hipOccupancyMaxActiveBlocksPerMultiprocessor(&per_cu, (const void*)mega_fwd, NTHR, LDS_BYTES) != hipSuccess || per_cu < 1) { fprintf(stderr, "kernel_launch: occupancy query says %d\n", per_cu); }
        (void)hipGetLastError();
        grid = cus;
    }
    if (grid < 0) return;
    if (hipMemsetAsync((char*)d_ws + WS_CTL, 0, CTL_ZERO_BYTES, stream) != hipSuccess) return;
    Args a{};
    for (int i = 0; i < 29; ++i) a.in[i] = (const float*)d_in[i];
    a.out = (float*)d_out; a.ws = (unsigned char*)d_ws;
#if MK_MULTI
    for (int p = 0; p < N_PHASES; ++p) { a.ph_lo = p; a.ph_hi = p + 1; hipLaunchKernelGGL(mega_fwd, dim3(grid), dim3(NTHR), LDS_BYTES, stream, a); }
#else
    a.ph_lo = 0; a.ph_hi = 1 << 30;
    hipLaunchKernelGGL(mega_fwd, dim3(grid), dim3(NTHR), LDS_BYTES, stream, a);
#endif
}
```

```cpp
#include <hip/hip_runtime.h>
#include <cstdio>
#include <cstdint>
#include <cmath>
#ifndef DUP_MASK
#define DUP_MASK 0
#endif
#define CONV_NY 171
#define DUPN(k) (1 + ((DUP_MASK >> (k)) & 1))
#ifndef PROBE_CHECK
#define PROBE_HEAD 0
#define PROBE_BASE 8
#define PROBE_CHECK 0
#endif
#ifndef PROBE_SKIP
#define PROBE_SKIP 0
#endif
namespace pg8 {
#define PG8_LAS __attribute__((address_space(3)))
typedef unsigned short bf16_t;
typedef short bf16x8 __attribute__((ext_vector_type(8)));
typedef float f32x4 __attribute__((ext_vector_type(4)));
typedef float f32x2 __attribute__((ext_vector_type(2)));
typedef unsigned u32x4 __attribute__((ext_vector_type(4)));
constexpr int BM = 256, BK = 64, HALF = 128, HTB = HALF * BK * 2  , STAGE_BYTES = 8 * HTB, NXCD = 8, WGM = 8;

__host__ __device__ __forceinline__ int lds_byte(int r, int c) { const int st = (r >> 4) * 2 + (c >> 5), rr = r & 15, cc = c & 31, ob = rr * 64 + cc * 2; return st * 1024 + (ob ^ (((ob >> 9) & 1) << 5)); }
__host__ __device__ __forceinline__ void stage_rc(int b, int& R, int& C) { const int st = b / 1024, sb = b % 1024, swz = sb ^ (((sb >> 9) & 1) << 5); R = (st >> 1) * 16 + swz / 64; C = (st & 1) * 32 + (swz % 64) / 2; }
__host__ __device__ __forceinline__ int perm32(int rho) { const int n = rho >> 4, i = rho & 15; return 8 * (i >> 2) + 4 * n + (i & 3); }

struct Unit { int pm, pn, ab, av; };
struct Gemm { const bf16_t* A; const bf16_t* Bt; int lda; int K; };

struct StaticOrder {
    int nM, nN, nwg, G, c;
    __host__ __device__ void init(int M, int N, int G_, int c_) { nM = M / BM; nN = N / BM; nwg = nM * nN; G = G_; c = c_; }
    __host__ __device__ bool next(int i, Unit& u) const {
        const long L = (long)i * G + c; if (L >= nwg) return false;
        int wgid = (int)L; { const int q = nwg / NXCD, r = nwg % NXCD, xcd = wgid % NXCD, off = wgid / NXCD; wgid = (xcd < r ? xcd * (q + 1) : r * (q + 1) + (xcd - r) * q) + off; }
        const int nig = WGM * nN, gid = wgid / nig, fm = gid * WGM, gsz = (nM - fm) < WGM ? (nM - fm) : WGM;
        u.pm = fm + ((wgid % nig) % gsz); u.pn = (wgid % nig) / gsz; u.ab = 0; u.av = 0; return true;
    }
    static constexpr bool GATHER = false;
    __device__ __forceinline__ int arow(const Unit& u, int r) const { return u.pm * BM + r; }
};

struct BatchOrder {
    StaticOrder S; int bsel, rows_per_batch;
    __host__ __device__ void init(int M, int N, int G_, int c_, int bsel_, int rpb_) { S.init(M, N, G_, c_); bsel = bsel_; rows_per_batch = rpb_; }
    __host__ __device__ bool next(int i, Unit& u) const { if (!S.next(i, u)) return false; u.pn += bsel * ((u.pm * BM) / rows_per_batch) * S.nN; return true; }
    static constexpr bool GATHER = false;
    __device__ __forceinline__ int arow(const Unit& u, int r) const { return u.pm * BM + r; }
};
__device__ __forceinline__ unsigned cvt_pk_bf16(float lo, float hi) { unsigned r; asm volatile("v_cvt_pk_bf16_f32 %0, %1, %2" : "=v"(r) : "v"(lo), "v"(hi)); return r; }


typedef int pg8_v8i __attribute__((ext_vector_type(8))); typedef int pg8_v4i __attribute__((ext_vector_type(4)));
__device__ __forceinline__ pg8_v8i pg8_cat(bf16x8 a, bf16x8 b) { return __builtin_shufflevector(__builtin_bit_cast(pg8_v4i, a), __builtin_bit_cast(pg8_v4i, b), 0, 1, 2, 3, 4, 5, 6, 7); }
template <int IMM> __device__ __forceinline__ void glds_sv_t(const char* sbase, unsigned voff, unsigned lds_dst) { unsigned keep;
    asm volatile("s_mov_b32 %0, m0\n\ts_mov_b32 m0, %3\n\ts_nop 0\n\tglobal_load_lds_dwordx4 %1, %2 offset:%c4\n\ts_mov_b32 m0, %0" : "=&s"(keep) : "v"(voff), "s"(sbase), "s"(lds_dst), "i"(IMM) : "memory"); }
#define glds_sv(sbase, voff, ldsdst, IMM) glds_sv_t<IMM>(sbase, voff, ldsdst)
template <class Epi, class Sched, bool ALIGN_EPI, bool FP8 = false>
__device__ __forceinline__ void gemm_phase(PG8_LAS unsigned char* lds, const int tid_in, const Gemm g, const Sched& S, const Epi& E) {
    const int tid = tid_in, wid = __builtin_amdgcn_readfirstlane(tid >> 6), lane = tid & 63, wr = wid >> 2, wc = wid & 3, fr = lane & 15, fq = lane >> 4;
    const int K = g.K, nt = K / BK, lda = g.lda;
    unsigned voffB[2], voffA[2];
#pragma unroll
    for (int i = 0; i < 2; ++i) { int R, C; stage_rc(tid * 16 + i * 8192, R, C); const int Rb = Epi::PERM ? ((R & ~31) + perm32(R & 31)) : R;
        voffB[i] = (unsigned)(Rb * K + C) * 2u; voffA[i] = (unsigned)(R * lda + C) * 2u; }
    const size_t hstepA = (size_t)HALF * lda * 2;
    const size_t kstep = (size_t)(BK * 2);
    const size_t hstep = (size_t)HALF * K * 2;
    const size_t tstep = 2 * hstep;
    const unsigned ldsw = (unsigned)wid * 1024u; const unsigned lds0 = (unsigned)(uintptr_t)lds;
    const int aoff = lds_byte(wr * 64 + fr, fq * 8), boff = lds_byte(wc * 32 + fr, fq * 8);
    const char* Ab = (const char*)g.A;
#define PG8_SA(b, h) (((b) * 2 + (h)) * HTB)
#define PG8_SB(b, h) ((4 + (b) * 2 + (h)) * HTB)
#define PG8_STAGE(bufoff, gbase, voff, IMM) do { _Pragma("unroll") for (int _i = 0; _i < 2; ++_i) \
        glds_sv((const char*)(gbase), (voff)[_i], (unsigned)__builtin_amdgcn_readfirstlane(lds0 + (bufoff) + ldsw + _i * 8192 - (IMM)), IMM); } while (0)
#define PG8_AOFFS(u, o) do { _Pragma("unroll") for (int _i = 0; _i < 2; ++_i) { int R_, C_; stage_rc(tid * 16 + _i * 8192, R_, C_);     \
        _Pragma("unroll") for (int _h = 0; _h < 2; ++_h) o[_h][_i] = ((unsigned)S.arow(u, _h * HALF + R_) * (unsigned)lda + (unsigned)C_) * 2u; } } while (0)
#define PG8_LDA(dst, b, h) do { _Pragma("unroll") for (int m = 0; m < 4; ++m) { if constexpr (FP8) { dst##8[m] = __builtin_shufflevector(*(const PG8_LAS pg8_v4i*)(lds + PG8_SA(b, h) + aoff + m * 2048), *(const PG8_LAS pg8_v4i*)(lds + PG8_SA(b, h) + aoff + m * 2048 + 1024), 0, 1, 2, 3, 4, 5, 6, 7); } \
        else { _Pragma("unroll") for (int k = 0; k < 2; ++k) dst[m][k] = *(const PG8_LAS bf16x8*)(lds + PG8_SA(b, h) + aoff + m * 2048 + k * 1024); } } } while (0)
#define PG8_LDB(dst, b, h) do { _Pragma("unroll") for (int n = 0; n < 2; ++n) { if constexpr (FP8) { dst##8[n] = __builtin_shufflevector(*(const PG8_LAS pg8_v4i*)(lds + PG8_SB(b, h) + boff + n * 2048), *(const PG8_LAS pg8_v4i*)(lds + PG8_SB(b, h) + boff + n * 2048 + 1024), 0, 1, 2, 3, 4, 5, 6, 7); } \
        else { _Pragma("unroll") for (int k = 0; k < 2; ++k) dst[n][k] = *(const PG8_LAS bf16x8*)(lds + PG8_SB(b, h) + boff + n * 2048 + k * 1024); } } } while (0)
#define PG8_MMA(ai, bj, At, Bt) do { __builtin_amdgcn_s_setprio(1); if constexpr (FP8) { \
        _Pragma("unroll") for (int m = 0; m < 4; ++m) _Pragma("unroll") for (int n = 0; n < 2; ++n) \
            asm volatile("v_mfma_scale_f32_16x16x128_f8f6f4 %0, %1, %2, %0, %3, %3 op_sel_hi:[0,0,0]" : "+v"(acc[ai][bj][m][n]) : "v"(Bt##8[n]), "v"(At##8[m]), "v"(sc8));     \
      } else { _Pragma("unroll") for (int m = 0; m < 4; ++m) _Pragma("unroll") for (int n = 0; n < 2; ++n) _Pragma("unroll") for (int k = 0; k < 2; ++k) \
        acc[ai][bj][m][n] = __builtin_amdgcn_mfma_f32_16x16x32_bf16(Bt[n][k], At[m][k], acc[ai][bj][m][n], 0, 0, 0); } __builtin_amdgcn_s_setprio(0); } while (0)
#define PG8_WAIT_V(n) asm volatile("s_waitcnt vmcnt(" #n ")" ::: "memory")
#define PG8_WAIT_L(n) asm volatile("s_waitcnt lgkmcnt(" #n ")" ::: "memory")
#define PG8_BAR __builtin_amdgcn_s_barrier()
#define PG8_SCHED __builtin_amdgcn_sched_barrier(0)
    const int sc8 = 0x7f7f7f7f;
    Unit cur, nxt; int ui = 0;
#define PG8_UNIFORM(u) do { u.pm = __builtin_amdgcn_readfirstlane(u.pm); u.pn = __builtin_amdgcn_readfirstlane(u.pn); u.ab = __builtin_amdgcn_readfirstlane(u.ab); u.av = __builtin_amdgcn_readfirstlane(u.av); } while (0)
    if (!S.next(0, cur)) return;
    PG8_UNIFORM(cur);
    f32x4 acc[2][2][4][2];
#pragma unroll
    for (int a = 0; a < 2; ++a)
#pragma unroll
        for (int b = 0; b < 2; ++b)
#pragma unroll
            for (int m = 0; m < 4; ++m)
#pragma unroll
                for (int n = 0; n < 2; ++n) acc[a][b][m][n] = (f32x4){0.f, 0.f, 0.f, 0.f};
    bf16x8 At[4][2], B0[2][2], B1[2][2]; pg8_v8i At8[4], B08[2], B18[2];
    unsigned oC[2][2], o2[2][2], oN[2][2];
    const char* cA = Ab; const char* nA = Ab; const char* a2 = Ab;
    if constexpr (Sched::GATHER) { PG8_AOFFS(cur, oC); } else { cA = Ab + (size_t)S.arow(cur, 0) * lda * 2; }
#define PG8_STAGE_AC(bufoff, h, kb, IMM) do { if constexpr (Sched::GATHER) { PG8_STAGE(bufoff, Ab + (kb), oC[h], IMM); } else { PG8_STAGE(bufoff, cA + (h) * hstepA + (kb), voffA, IMM); } } while (0)
#define PG8_STAGE_A2(bufoff, h, IMM) do { if constexpr (Sched::GATHER) { PG8_STAGE(bufoff, a2, o2[h], IMM); } else { PG8_STAGE(bufoff, a2 + (h) * hstepA, voffA, IMM); } } while (0)
    const char* cB = (const char*)g.Bt + (size_t)cur.pn * tstep;
    PG8_STAGE(PG8_SB(0, 0), cB, voffB, 0); PG8_STAGE(PG8_SB(0, 1), cB + hstep, voffB, 0); PG8_STAGE_AC(PG8_SA(0, 0), 0, 0, 0); PG8_STAGE_AC(PG8_SA(0, 1), 1, 0, 0);
    if (wr == 1) PG8_BAR;
    PG8_WAIT_V(2); PG8_BAR;
    PG8_STAGE(PG8_SB(1, 0), cB, voffB, 128); PG8_STAGE_AC(PG8_SA(1, 0), 0, 0, 128); PG8_STAGE(PG8_SB(1, 1), cB + hstep, voffB, 128);
    PG8_WAIT_V(6); PG8_BAR;
    for (;;) {
        const bool has_next = S.next(ui + 1, nxt); PG8_UNIFORM(nxt);
        if constexpr (!Sched::GATHER) { nA = has_next ? Ab + (size_t)S.arow(nxt, 0) * lda * 2 : cA; }
        const char* nB = has_next ? (const char*)g.Bt + (size_t)nxt.pn * tstep : cB;
        for (int t = 0; t < nt; t += 2) {
            const bool last = (t == nt - 2);
            const size_t k0 = (size_t)t * kstep;
            const char* b2 = last ? nB : cB + (size_t)(t + 2) * kstep;
            if constexpr (Sched::GATHER) {
                a2 = last ? Ab : Ab + (size_t)(t + 2) * kstep;
                if (t == nt - 4 && has_next) { Unit nq = nxt; asm volatile("" : "+s"(nq.ab), "+s"(nq.av)); PG8_AOFFS(nq, oN); }
#pragma unroll
                for (int h = 0; h < 2; ++h)
#pragma unroll
                    for (int i = 0; i < 2; ++i) o2[h][i] = (last && has_next) ? oN[h][i] : oC[h][i];
            } else { a2 = last ? nA : cA + (size_t)(t + 2) * kstep; }
            PG8_LDB(B0, 0, 0); PG8_LDB(B1, 0, 1); PG8_SCHED; PG8_LDA(At, 0, 0); PG8_STAGE_AC(PG8_SA(1, 1), 1, k0, 128);
            PG8_WAIT_V(8); PG8_WAIT_L(0); PG8_BAR; PG8_MMA(0, 0, At, B0); PG8_MMA(0, 1, At, B1); PG8_BAR; PG8_SCHED;
            PG8_LDA(At, 0, 1); PG8_STAGE(PG8_SB(0, 0), b2, voffB, 0); PG8_STAGE(PG8_SB(0, 1), b2 + hstep, voffB, 0); PG8_STAGE_A2(PG8_SA(0, 0), 0, 0);
            PG8_WAIT_V(8); PG8_WAIT_L(0); PG8_BAR; PG8_MMA(1, 0, At, B0); PG8_MMA(1, 1, At, B1); PG8_BAR; PG8_SCHED;
            PG8_LDB(B0, 1, 0); PG8_LDB(B1, 1, 1); PG8_SCHED; PG8_LDA(At, 1, 0); PG8_STAGE_A2(PG8_SA(0, 1), 1, 0);
            PG8_WAIT_V(8); PG8_WAIT_L(0); PG8_BAR; PG8_MMA(0, 0, At, B0); PG8_MMA(0, 1, At, B1); PG8_BAR; PG8_SCHED;
            PG8_LDA(At, 1, 1); PG8_STAGE(PG8_SB(1, 0), b2, voffB, 128); PG8_STAGE(PG8_SB(1, 1), b2 + hstep, voffB, 128); PG8_STAGE_A2(PG8_SA(1, 0), 0, 128);
            PG8_WAIT_V(8); PG8_WAIT_L(0); PG8_BAR; PG8_MMA(1, 0, At, B0); PG8_MMA(1, 1, At, B1); PG8_BAR; PG8_SCHED;
        }
        if constexpr (FP8) asm volatile("s_nop 15\n\ts_nop 15" ::: "memory");
        if constexpr (ALIGN_EPI) { if (wr == 0) PG8_BAR; }
        { int ln2; asm volatile("v_mbcnt_lo_u32_b32 %0, -1, 0\n\tv_mbcnt_hi_u32_b32 %0, -1, %0" : "=v"(ln2));
          E(acc, cur, wr, wc, ln2 & 15, ln2 >> 4); }
        if (!has_next) break;
#pragma unroll
        for (int a = 0; a < 2; ++a)
#pragma unroll
            for (int b = 0; b < 2; ++b)
#pragma unroll
                for (int m = 0; m < 4; ++m)
#pragma unroll
                    for (int n = 0; n < 2; ++n) acc[a][b][m][n] = (f32x4){0.f, 0.f, 0.f, 0.f};
        cur = nxt; cB = nB; ++ui;
        if constexpr (Sched::GATHER) {
#pragma unroll
            for (int h = 0; h < 2; ++h)
#pragma unroll
                for (int i = 0; i < 2; ++i) oC[h][i] = o2[h][i];
        } else { cA = nA; }
        if constexpr (ALIGN_EPI) { if (wr == 1) PG8_BAR; }
    }
    PG8_WAIT_V(0);
    if constexpr (!ALIGN_EPI) { if (wr == 0) PG8_BAR; }
    PG8_BAR;
#undef PG8_STAGE_AC
#undef PG8_UNIFORM
#undef PG8_STAGE_A2
#undef PG8_SA
#undef PG8_SB
#undef PG8_STAGE
#undef PG8_AOFFS
#undef PG8_LDA
#undef PG8_LDB
#undef PG8_MMA
#undef PG8_WAIT_V
#undef PG8_WAIT_L
#undef PG8_BAR
#undef PG8_SCHED
}
}
namespace pg8 {
__device__ __forceinline__ float fast_silu(float g) { return g * __builtin_amdgcn_rcpf(1.0f + __builtin_amdgcn_exp2f(-1.4426950408889634f * g)); }
struct EpiStoreBf16 {
    static constexpr bool PERM = true;
    bf16_t* O; int ldc; int nN; int row_tile0; float sc; const float* part; const float* bias; int bstride; int rows_per_batch;
    __device__ __forceinline__ void operator()(const f32x4 (&acc)[2][2][4][2], const Unit& u, int wr, int wc, int fr, int fq) const {
        const int row0 = (u.pm - row_tile0) * BM + wr * 64 + fr; const int col0 = (u.pn % nN) * BM + wc * 32 + 8 * fq;
        f32x4 bv[2][2];
#pragma unroll
        for (int bj = 0; bj < 2; ++bj) { bv[bj][0] = (f32x4){0.f, 0.f, 0.f, 0.f}; bv[bj][1] = bv[bj][0]; }
        if (part) { const float* bp = bias + (size_t)((u.pm * BM) / rows_per_batch) * bstride + col0;
#pragma unroll
            for (int bj = 0; bj < 2; ++bj) { bv[bj][0] = *(const f32x4*)(bp + bj * HALF); bv[bj][1] = *(const f32x4*)(bp + bj * HALF + 4); } }
#pragma unroll
        for (int ai = 0; ai < 2; ++ai)
#pragma unroll
            for (int m = 0; m < 4; ++m) { bf16_t* rowp = (bf16_t*)((char*)O + (unsigned)((row0 + ai * HALF + m * 16) * ldc + col0) * 2u);
                float rsc = sc;
                if (part) { const f32x4 p = *(const f32x4*)(part + (size_t)(u.pm * BM + wr * 64 + fr + ai * HALF + m * 16) * 4); rsc = sc * __builtin_amdgcn_rsqf(((p.x + p.y) + (p.z + p.w)) * (1.f / 1024.f) + 1e-6f); }
#pragma unroll
                for (int bj = 0; bj < 2; ++bj) { const f32x4 v0 = acc[ai][bj][m][0] * rsc + bv[bj][0], v1 = acc[ai][bj][m][1] * rsc + bv[bj][1];
                    u32x4 w; w.x = cvt_pk_bf16(v0[0], v0[1]); w.y = cvt_pk_bf16(v0[2], v0[3]); w.z = cvt_pk_bf16(v1[0], v1[1]); w.w = cvt_pk_bf16(v1[2], v1[3]);
                    *(u32x4*)(rowp + bj * HALF) = w; } }
    }
};
template <bool F8OUT, bool FUSED = true> struct EpiSwigluT {
    static constexpr bool PERM = true;
    bf16_t* Hd; int ldh; int nN; int row_tile0; float sc; float osc;
    const float* part; const float* bias; int bstride; int rows_per_batch;
    __device__ __forceinline__ void operator()(const f32x4 (&acc)[2][2][4][2], const Unit& u, int wr, int wc, int fr, int fq) const {
        const int row0 = (u.pm - row_tile0) * BM + wr * 64 + fr; const int col0 = (u.pn % nN) * HALF + wc * 32 + 8 * fq;
        f32x4 bv[2][2];
#pragma unroll
        for (int bj = 0; bj < 2; ++bj) { bv[bj][0] = (f32x4){0.f, 0.f, 0.f, 0.f}; bv[bj][1] = bv[bj][0]; }
        if (part) { const float* bp = bias + (size_t)((u.pm * BM) / rows_per_batch) * bstride + (u.pn % nN) * BM + wc * 32 + 8 * fq;
#pragma unroll
            for (int bj = 0; bj < 2; ++bj) { bv[bj][0] = *(const f32x4*)(bp + bj * HALF); bv[bj][1] = *(const f32x4*)(bp + bj * HALF + 4); } }
#pragma unroll
        for (int ai = 0; ai < 2; ++ai)
#pragma unroll
            for (int m = 0; m < 4; ++m) {
                float rsc = sc;
                if (part) { const f32x4 p = *(const f32x4*)(part + (size_t)(u.pm * BM + wr * 64 + fr + ai * HALF + m * 16) * 4); rsc = sc * __builtin_amdgcn_rsqf(((p.x + p.y) + (p.z + p.w)) * (1.f / 1024.f) + 1e-6f); }
                const f32x4 g0 = acc[ai][0][m][0] * rsc + bv[0][0], g1 = acc[ai][0][m][1] * rsc + bv[0][1], u0 = acc[ai][1][m][0] * rsc + bv[1][0], u1 = acc[ai][1][m][1] * rsc + bv[1][1];
                float r[8];
                if constexpr (!FUSED) {
                    const f32x4 ag0 = acc[ai][0][m][0], ag1 = acc[ai][0][m][1], au0 = acc[ai][1][m][0], au1 = acc[ai][1][m][1]; const float ke = -1.4426950408889634f * sc, ko = sc * sc * osc, kinv = 1.0f / ko, kc = __builtin_log2f(kinv);
#pragma unroll
                    for (int i = 0; i < 4; ++i) { r[i] = (ag0[i] * au0[i]) * __builtin_amdgcn_rcpf(kinv + __builtin_amdgcn_exp2f(__builtin_fmaf(ke, ag0[i], kc))); r[4 + i] = (ag1[i] * au1[i]) * __builtin_amdgcn_rcpf(kinv + __builtin_amdgcn_exp2f(__builtin_fmaf(ke, ag1[i], kc))); }
                } else {
#pragma unroll
                for (int i = 0; i < 4; ++i) { r[i] = fast_silu(g0[i]) * u0[i] * (F8OUT ? osc : 1.0f); r[4 + i] = fast_silu(g1[i]) * u1[i] * (F8OUT ? osc : 1.0f); } }
                if constexpr (F8OUT) { char* rowp = (char*)Hd + (unsigned)((row0 + ai * HALF + m * 16) * ldh + col0);
                    int w0 = 0, w1 = 0; w0 = __builtin_amdgcn_cvt_pk_fp8_f32(r[0], r[1], w0, false); w0 = __builtin_amdgcn_cvt_pk_fp8_f32(r[2], r[3], w0, true);
                    w1 = __builtin_amdgcn_cvt_pk_fp8_f32(r[4], r[5], w1, false); w1 = __builtin_amdgcn_cvt_pk_fp8_f32(r[6], r[7], w1, true);
                    f32x2 wv; wv.x = __builtin_bit_cast(float, w0); wv.y = __builtin_bit_cast(float, w1); *(f32x2*)rowp = wv; }
                else { bf16_t* rowp = (bf16_t*)((char*)Hd + (unsigned)((row0 + ai * HALF + m * 16) * ldh + col0) * 2u);
                    u32x4 w; w.x = cvt_pk_bf16(r[0], r[1]); w.y = cvt_pk_bf16(r[2], r[3]); w.z = cvt_pk_bf16(r[4], r[5]); w.w = cvt_pk_bf16(r[6], r[7]);
                    *(u32x4*)rowp = w; } }
    }
};
typedef EpiSwigluT<false> EpiSwiglu;
struct EpiResGate {
    static constexpr bool PERM = true;
    const void* base; bf16_t* out; const float* gate; int gstride; int rows_per_batch; bool bf32;
    unsigned char* x8; float x8scale;
    float* part; PG8_LAS float* red;
    __device__ __forceinline__ void operator()(const f32x4 (&acc)[2][2][4][2], const Unit& u, int wr, int wc, int fr, int fq) const {
        float ssq[2][4];
#pragma unroll
        for (int ai = 0; ai < 2; ++ai)
#pragma unroll
            for (int m = 0; m < 4; ++m) ssq[ai][m] = 0.f;
        const int row0 = u.pm * BM + wr * 64 + fr; const int col0 = u.pn * BM + wc * 32 + 8 * fq;
        const float* gp = gate + (size_t)((u.pm * BM) / rows_per_batch) * gstride + col0;
        f32x4 gv[2][2];
#pragma unroll
        for (int bj = 0; bj < 2; ++bj)
#pragma unroll
            for (int n = 0; n < 2; ++n) gv[bj][n] = *(const f32x4*)(gp + bj * HALF + n * 4);
#pragma unroll
        for (int ai = 0; ai < 2; ++ai)
#pragma unroll
            for (int m = 0; m < 4; ++m) { const unsigned off = (unsigned)((row0 + ai * HALF + m * 16) * 1024 + col0);
#pragma unroll
                for (int bj = 0; bj < 2; ++bj) { f32x4 b0, b1;
                    if (bf32) { b0 = *(const f32x4*)((const char*)base + (size_t)(off + bj * HALF) * 4u); b1 = *(const f32x4*)((const char*)base + (size_t)(off + bj * HALF) * 4u + 16); }
                    else { const u32x4 w = *(const u32x4*)((const char*)base + (off + bj * HALF) * 2u);
                        b0 = (f32x4){__builtin_bit_cast(float, w.x << 16), __builtin_bit_cast(float, w.x & 0xffff0000u), __builtin_bit_cast(float, w.y << 16), __builtin_bit_cast(float, w.y & 0xffff0000u)};
                        b1 = (f32x4){__builtin_bit_cast(float, w.z << 16), __builtin_bit_cast(float, w.z & 0xffff0000u), __builtin_bit_cast(float, w.w << 16), __builtin_bit_cast(float, w.w & 0xffff0000u)}; }
                    const f32x4 v0 = b0 + gv[bj][0] * acc[ai][bj][m][0], v1 = b1 + gv[bj][1] * acc[ai][bj][m][1];
                    ssq[ai][m] += ((v0[0] * v0[0] + v0[1] * v0[1]) + (v0[2] * v0[2] + v0[3] * v0[3])) + ((v1[0] * v1[0] + v1[1] * v1[1]) + (v1[2] * v1[2] + v1[3] * v1[3]));
                    u32x4 o; o.x = cvt_pk_bf16(v0[0], v0[1]); o.y = cvt_pk_bf16(v0[2], v0[3]); o.z = cvt_pk_bf16(v1[0], v1[1]); o.w = cvt_pk_bf16(v1[2], v1[3]);
                    *(u32x4*)((char*)out + (off + bj * HALF) * 2u) = o;
                    if (x8) { int w0 = 0, w1 = 0; w0 = __builtin_amdgcn_cvt_pk_fp8_f32(v0[0] * x8scale, v0[1] * x8scale, w0, false); w0 = __builtin_amdgcn_cvt_pk_fp8_f32(v0[2] * x8scale, v0[3] * x8scale, w0, true);
                        w1 = __builtin_amdgcn_cvt_pk_fp8_f32(v1[0] * x8scale, v1[1] * x8scale, w1, false); w1 = __builtin_amdgcn_cvt_pk_fp8_f32(v1[2] * x8scale, v1[3] * x8scale, w1, true);
                        f32x2 wv; wv.x = __builtin_bit_cast(float, w0); wv.y = __builtin_bit_cast(float, w1); *(f32x2*)(x8 + (off + bj * HALF)) = wv; } } }
        if (part) {
#pragma unroll
            for (int ai = 0; ai < 2; ++ai)
#pragma unroll
                for (int m = 0; m < 4; ++m) { float p = ssq[ai][m]; p += __builtin_bit_cast(float, __builtin_amdgcn_ds_swizzle(__builtin_bit_cast(int, p), (16 << 10) | 0x1f));
                    if ((fq & 1) == 0) red[(wr * 64 + fr + ai * HALF + m * 16) * 8 + wc * 2 + (fq >> 1)] = p; }
            __syncthreads();
            { int t = (wr * 4 + wc) * 64 + fr + 16 * fq; asm volatile("" : "+v"(t));
              if (t < 256) { PG8_LAS const float* rp = red + t * 8; const float sres = ((rp[0] + rp[1]) + (rp[2] + rp[3])) + ((rp[4] + rp[5]) + (rp[6] + rp[7])); part[(size_t)(u.pm * BM + t) * 4 + u.pn] = sres; } }
        }
    }
};
}


namespace pg8 {
struct EpiMlaQ {
    static constexpr bool PERM = false;
    bf16_t* Q; const PG8_LAS float* rs; const float* rope; float qscale; int seq;
    __device__ __forceinline__ void operator()(const f32x4 (&acc)[2][2][4][2], const Unit& u, int wr, int wc, int fr, int fq) const {
#pragma unroll
        for (int bj = 0; bj < 2; ++bj) { const int gidx = u.pn * 8 + bj * 4 + wc; if (gidx >= 12) continue; const int head = gidx / 3, part = gidx % 3;
#pragma unroll
            for (int ai = 0; ai < 2; ++ai)
#pragma unroll
                for (int m = 0; m < 4; ++m) { const int rl = ai * HALF + wr * 64 + m * 16 + fr, row = u.pm * BM + rl, b = row / seq, s = row % seq; const float sc = rs[rl] * qscale;
                    bf16_t* qp = (bf16_t*)((char*)Q + (unsigned)((((b * 4 + head) * seq + s) * 96 + part * 32 + 4 * fq) * 2));
                    const f32x4 v0 = acc[ai][bj][m][0] * sc, v1 = acc[ai][bj][m][1] * sc;
                    if (part < 2) { f32x2 w0, w1; w0.x = __builtin_bit_cast(float, cvt_pk_bf16(v0[0], v0[1])); w0.y = __builtin_bit_cast(float, cvt_pk_bf16(v0[2], v0[3])); w1.x = __builtin_bit_cast(float, cvt_pk_bf16(v1[0], v1[1])); w1.y = __builtin_bit_cast(float, cvt_pk_bf16(v1[2], v1[3]));
                        *(f32x2*)qp = w0; *(f32x2*)(qp + 16) = w1; }
                    else { const char* rp = (const char*)rope + (unsigned)((s * 16 + 4 * fq) * 8); const f32x4 ca = *(const f32x4*)rp, cb = *(const f32x4*)(rp + 16);
                        const float o0 = v0[0] * ca[0] - v1[0] * ca[1], o1 = v0[1] * ca[2] - v1[1] * ca[3], o2 = v0[2] * cb[0] - v1[2] * cb[1], o3 = v0[3] * cb[2] - v1[3] * cb[3];
                        const float p0 = v1[0] * ca[0] + v0[0] * ca[1], p1 = v1[1] * ca[2] + v0[1] * ca[3], p2 = v1[2] * cb[0] + v0[2] * cb[1], p3 = v1[3] * cb[2] + v0[3] * cb[3];
                        f32x2 w0, w1; w0.x = __builtin_bit_cast(float, cvt_pk_bf16(o0, o1)); w0.y = __builtin_bit_cast(float, cvt_pk_bf16(o2, o3)); w1.x = __builtin_bit_cast(float, cvt_pk_bf16(p0, p1)); w1.y = __builtin_bit_cast(float, cvt_pk_bf16(p2, p3));
                        *(f32x2*)qp = w0; *(f32x2*)(qp + 16) = w1; } } }
    }
};
struct EpiMlaKV {
    static constexpr bool PERM = false;
    bf16_t* K; bf16_t* V; const PG8_LAS float* rs; int seq;
    __device__ __forceinline__ void operator()(const f32x4 (&acc)[2][2][4][2], const Unit& u, int wr, int wc, int fr, int fq) const {
#pragma unroll
        for (int bj = 0; bj < 2; ++bj) { const int gidx = u.pn * 8 + bj * 4 + wc, head = gidx >> 2, part = gidx & 3;
#pragma unroll
            for (int ai = 0; ai < 2; ++ai)
#pragma unroll
                for (int m = 0; m < 4; ++m) { const int rl = ai * HALF + wr * 64 + m * 16 + fr, row = u.pm * BM + rl, b = row / seq, s = row % seq; const float sc = rs[256 + rl];
                    bf16_t* dp = (part < 2) ? (bf16_t*)((char*)K + (unsigned)((((b * 4 + head) * seq + s) * 96 + part * 32 + 4 * fq) * 2)) : (bf16_t*)((char*)V + (unsigned)((((b * 4 + head) * seq + s) * 64 + (part - 2) * 32 + 4 * fq) * 2));
                    const f32x4 v0 = acc[ai][bj][m][0] * sc, v1 = acc[ai][bj][m][1] * sc;
                    f32x2 w0, w1; w0.x = __builtin_bit_cast(float, cvt_pk_bf16(v0[0], v0[1])); w0.y = __builtin_bit_cast(float, cvt_pk_bf16(v0[2], v0[3])); w1.x = __builtin_bit_cast(float, cvt_pk_bf16(v1[0], v1[1])); w1.y = __builtin_bit_cast(float, cvt_pk_bf16(v1[2], v1[3]));
                    *(f32x2*)dp = w0; *(f32x2*)(dp + 16) = w1; } }
    }
};
}
#define GAS __attribute__((address_space(1)))
#define LAS __attribute__((address_space(3)))
typedef unsigned short bf16;
typedef unsigned v4u __attribute__((ext_vector_type(4)));
typedef unsigned v2u __attribute__((ext_vector_type(2)));
typedef float f32x4 __attribute__((ext_vector_type(4)));
typedef short bf16x8 __attribute__((ext_vector_type(8)));
typedef GAS unsigned gu32;
typedef GAS unsigned long long gu64;
#define RLX_AGENT __ATOMIC_RELAXED, __HIP_MEMORY_SCOPE_AGENT
#define LDS_WAIT() asm volatile("s_waitcnt lgkmcnt(0)" ::: "memory")
#define VM_WAIT() asm volatile("s_waitcnt vmcnt(0)" ::: "memory")
typedef float pk_f2v __attribute__((ext_vector_type(2))); typedef __bf16 pk_b2v __attribute__((ext_vector_type(2)));
__device__ __forceinline__ unsigned pk2(float lo, float hi) { const pk_f2v v = {lo, hi}; return __builtin_bit_cast(unsigned, __builtin_convertvector(v, pk_b2v)); }
__device__ __forceinline__ unsigned f2bf(float f) { return pk2(f, 0.f) & 0xffffu; }
__device__ __forceinline__ float bf2f(unsigned short v) { return __builtin_bit_cast(float, (unsigned)v << 16); }
__device__ __forceinline__ float bflo(unsigned w) { return __builtin_bit_cast(float, w << 16); }
__device__ __forceinline__ float bfhi(unsigned w) { return __builtin_bit_cast(float, w & 0xffff0000u); }

#define XB_TMO      128
#define XB_XCNT(j)  (256  + 64 * (j))
#define XB_XSUB(j)  (1280 + 64 * (j))
#define XB_XGEN(j)  (2304 + 64 * (j))
#define XB_TOP      3328
#define XB_TOPGEN   3392
#define XCD_BAR_WORDS 3456
#define XB_SPIN_CAP (1u << 23)

__device__ __forceinline__ unsigned xb_ld(unsigned* p)              { return __hip_atomic_load(p, __ATOMIC_RELAXED, __HIP_MEMORY_SCOPE_AGENT); }
__device__ __forceinline__ unsigned xb_add(unsigned* p, unsigned v) { return __hip_atomic_fetch_add(p, v, __ATOMIC_RELAXED, __HIP_MEMORY_SCOPE_AGENT); }
__device__ __forceinline__ unsigned xb_xcc_id() { return (unsigned)__builtin_amdgcn_s_getreg((3 << 11) | 20) & 0xFu; }
#define XB_SPIN(cond, bar) do { unsigned _sp = 0; while (cond) { __builtin_amdgcn_s_sleep(1); \
    if ((++_sp & 255u) == 0u) { if (xb_ld(&(bar)[XB_TMO])) break; if (_sp > XB_SPIN_CAP) { atomicAdd(&(bar)[XB_TMO], 1u); break; } } } } while (0)

struct XcdBarrier {
    unsigned* bar; unsigned x;
    volatile LAS unsigned* st;
};
__device__ __forceinline__ XcdBarrier xcd_barrier_post(unsigned* bar, volatile LAS unsigned* st) {
    XcdBarrier b; b.bar = bar; b.x = xb_xcc_id(); b.st = st;
    if (threadIdx.x == 0) (void)xb_add(&bar[XB_XCNT(b.x)], 1u);
    return b;
}
__device__ __forceinline__ void xcd_barrier_complete(unsigned* bar, unsigned x, unsigned& nloc, unsigned& nx) {
    const unsigned G = gridDim.x * gridDim.y * gridDim.z;
    unsigned sum, cnt, mine, sp = 0u;
    for (;;) {
        sum = 0u; cnt = 0u; mine = 0u;
#pragma unroll
        for (unsigned j = 0; j < 16; ++j) { const unsigned c = xb_ld(&bar[XB_XCNT(j)]); sum += c; cnt += (c > 0u) ? 1u : 0u; mine = (j == x) ? c : mine; }
        if (sum == G) break;
        __builtin_amdgcn_s_sleep(1);
        if ((++sp & 255u) == 0u) { if (xb_ld(&bar[XB_TMO])) break; if (sp > XB_SPIN_CAP) { atomicAdd(&bar[XB_TMO], 1u); break; } }
    }
    nloc = mine > 0u ? mine : 1u; nx = cnt > 0u ? cnt : 1u;
}
__device__ __forceinline__ void xcd_barrier(const XcdBarrier& b) {
    asm volatile("s_waitcnt vmcnt(0)" ::: "memory");
    __syncthreads();
    if (threadIdx.x == 0) {
        unsigned* bar = b.bar;
        __builtin_amdgcn_s_waitcnt(0);
        unsigned nloc = b.st[0], nx = b.st[1];
        if (nloc == 0u) { xcd_barrier_complete(bar, b.x, nloc, nx); b.st[0] = nloc; b.st[1] = nx; }
        const unsigned old = xb_add(&bar[XB_XSUB(b.x)], 1u);
        const unsigned gen = old / nloc;
        if (old + 1u == (gen + 1u) * nloc) {
            __builtin_amdgcn_fence(__ATOMIC_RELEASE, "agent");
            asm volatile("s_waitcnt vmcnt(0)" ::: "memory");
            const unsigned og = xb_add(&bar[XB_TOP], 1u);
            const unsigned tg = og / nx;
            if (og + 1u == (tg + 1u) * nx) xb_add(&bar[XB_TOPGEN], 1u);
            else XB_SPIN(xb_ld(&bar[XB_TOPGEN]) == tg, bar);
            __builtin_amdgcn_fence(__ATOMIC_ACQUIRE, "agent");
            xb_add(&bar[XB_XGEN(b.x)], 1u);
            asm volatile("s_waitcnt vmcnt(0)" ::: "memory");
        } else {
            XB_SPIN(xb_ld(&bar[XB_XGEN(b.x)]) == gen, bar);
            __builtin_amdgcn_fence(__ATOMIC_ACQUIRE, "agent");
            asm volatile("s_waitcnt vmcnt(0)" ::: "memory");
        }
    }
    __syncthreads();
}
#include <hip/hip_bf16.h>
namespace attn_body {
using bf16=__hip_bfloat16;
using bf16x8=__attribute__((ext_vector_type(8)))short;
using s16x4=__attribute__((ext_vector_type(4)))short;
using f32x16=__attribute__((ext_vector_type(16)))float;
using u32x4=__attribute__((ext_vector_type(4)))unsigned;
constexpr int BATCH=2,NHEAD=4,SEQ=16384,DQ=96,DV=64,OPITCH=1024;
constexpr int NW=8,QBLK=32,QB=QBLK*NW,KVBLK=64,NQB=SEQ/QB;
__device__ __forceinline__ int crow(int r,int hi){return (r&3)+8*(r>>2)+4*hi;}
#define SBAR() __builtin_amdgcn_sched_barrier(0)
__device__ __forceinline__ void cmask(f32x16&p0,f32x16&p1,int jb,int qrel,int hi){
  const float NEG=-INFINITY; int qd=qrel-(64*jb+4*hi); asm volatile("":"+v"(qd));
  #pragma unroll
  for(int r=0;r<16;++r){const int c=(r&3)+8*(r>>2); if(c>qd)p0[r]=NEG; if(c+32>qd)p1[r]=NEG;}
}

constexpr int NSLOT=3, NSLOTK=4, KSLOTB=12288, VSLOTB=8192, QOB=4096;
constexpr int LDS_K=0, LDS_V=NSLOTK*KSLOTB, LDS_WS=LDS_V+NSLOT*VSLOTB, LDS_OST=LDS_WS+NW*64*4, LDS_BYTES=LDS_OST+NW*QOB;
__device__ __forceinline__ void glds16(const void*gsrc,unsigned lds_dst){unsigned keep;
  asm volatile("s_mov_b32 %0, m0\n\ts_mov_b32 m0, %2\n\ts_nop 0\n\tglobal_load_lds_dwordx4 %1, off\n\ts_mov_b32 m0, %0":"=&s"(keep):"v"(gsrc),"s"(lds_dst):"memory");}
__device__ __forceinline__ void swap32(float&a,float&b){asm volatile("s_nop 1\n\tv_permlane32_swap_b32 %0, %1\n\ts_nop 1":"+v"(a),"+v"(b));}
__device__ __forceinline__ float max3f(float a,float b,float c){float r;asm("v_max3_f32 %0, %1, %2, %3":"=v"(r):"v"(a),"v"(b),"v"(c));return r;}
__device__ __forceinline__ float max2f(float a,float b){float r;asm("v_max_f32_e32 %0, %1, %2":"=v"(r):"v"(a),"v"(b));return r;}
__device__ __forceinline__ float fadd_s(float a,float b){float r;asm("v_add_f32_e32 %0, %1, %2":"=v"(r):"v"(a),"v"(b));return r;}
__device__ __forceinline__ float fsub_s(float a,float b){float r;asm("v_sub_f32_e32 %0, %1, %2":"=v"(r):"v"(a),"v"(b));return r;}
typedef float f32x2_t __attribute__((ext_vector_type(2))); typedef __bf16 bf16x2_t __attribute__((ext_vector_type(2)));
__device__ __forceinline__ unsigned cvtpk_s(float lo,float hi){f32x2_t v={lo,hi};bf16x2_t b=__builtin_convertvector(v,bf16x2_t);return __builtin_bit_cast(unsigned,b);}
#define WAIT_BAR(N) asm volatile("s_waitcnt vmcnt(" #N ") lgkmcnt(0)\n\ts_barrier":::"memory")
#define WAIT_BAR2(NLO,NHI) do{ if(wid<4){WAIT_BAR(NLO);}else{WAIT_BAR(NHI);} }while(0)

__device__ __forceinline__ void qkt(f32x16&p0,f32x16&p1,const char*Kslot,const bf16x8*qr,int r32,int hi){
  const f32x16 zc=f32x16{};
  const char*kb=Kslot+hi*1024+r32*16;
  #pragma unroll
  for(int d0=0;d0<6;++d0){
    const bf16x8 b0=*reinterpret_cast<const bf16x8*>(kb+d0*2048);
    const bf16x8 b1=*reinterpret_cast<const bf16x8*>(kb+d0*2048+512);
    if(d0==0){p0=__builtin_amdgcn_mfma_f32_32x32x16_bf16(b0,qr[0],zc,0,0,0);p1=__builtin_amdgcn_mfma_f32_32x32x16_bf16(b1,qr[0],zc,0,0,0);}
    else{p0=__builtin_amdgcn_mfma_f32_32x32x16_bf16(b0,qr[d0],p0,0,0,0);p1=__builtin_amdgcn_mfma_f32_32x32x16_bf16(b1,qr[d0],p1,0,0,0);}}
}
typedef __attribute__((address_space(3))) const char* lds_cptr;
typedef short v4i16_t __attribute__((ext_vector_type(4)));
__device__ __forceinline__ void kload8(bf16x8*kf,lds_cptr kp){
  kf[0]=*(const __attribute__((address_space(3))) bf16x8*)(kp);      kf[1]=*(const __attribute__((address_space(3))) bf16x8*)(kp+512);
  kf[2]=*(const __attribute__((address_space(3))) bf16x8*)(kp+2048); kf[3]=*(const __attribute__((address_space(3))) bf16x8*)(kp+2560);
  kf[4]=*(const __attribute__((address_space(3))) bf16x8*)(kp+4096); kf[5]=*(const __attribute__((address_space(3))) bf16x8*)(kp+4608);
  kf[6]=*(const __attribute__((address_space(3))) bf16x8*)(kp+6144); kf[7]=*(const __attribute__((address_space(3))) bf16x8*)(kp+6656);
}
__device__ __forceinline__ void kload2(bf16x8*kf,lds_cptr kp,int j){ kf[2*j]=*(const __attribute__((address_space(3))) bf16x8*)(kp+j*2048); kf[2*j+1]=*(const __attribute__((address_space(3))) bf16x8*)(kp+j*2048+512); }
__device__ __forceinline__ s16x4 vtr(lds_cptr p){ return __builtin_bit_cast(s16x4,__builtin_amdgcn_ds_read_tr16_b64_v4i16((__attribute__((address_space(3))) v4i16_t*)p)); }
__device__ __forceinline__ float rowmax(const f32x16&p0,const f32x16&p1){
  float a=max3f(p0[0],p0[1],p1[0]),b=max3f(p0[2],p0[3],p1[1]);a=max3f(a,p1[2],p1[3]);
  #pragma unroll
  for(int r=4;r<16;r+=4){a=max3f(a,p0[r],p0[r+1]);b=max3f(b,p0[r+2],p0[r+3]);a=max3f(a,p1[r],p1[r+1]);b=max3f(b,p1[r+2],p1[r+3]);}
  float m=max2f(a,b),m2=m; swap32(m,m2);
  return max2f(m,m2);
}
__device__ __forceinline__ void pv(f32x16*o,int vb,bf16x8 pa0,bf16x8 pa1,bf16x8 pa2,bf16x8 pa3){
  #pragma unroll
  for(int d0=0;d0<2;++d0){s16x4 lo[4],hi[4];
    #pragma unroll
    for(int ks=0;ks<4;++ks){
      asm volatile("ds_read_b64_tr_b16 %0,%1 offset:%c2":"=&v"(lo[ks]):"v"(vb),"i"(d0*4096+ks*1024):"memory");
      asm volatile("ds_read_b64_tr_b16 %0,%1 offset:%c2":"=&v"(hi[ks]):"v"(vb),"i"(d0*4096+ks*1024+512):"memory");}
    asm volatile("s_waitcnt lgkmcnt(0)":::"memory");SBAR();
    #define PK(k) (bf16x8){lo[k][0],lo[k][1],lo[k][2],lo[k][3],hi[k][0],hi[k][1],hi[k][2],hi[k][3]}
    o[d0]=__builtin_amdgcn_mfma_f32_32x32x16_bf16(pa0,PK(0),o[d0],0,0,0);
    o[d0]=__builtin_amdgcn_mfma_f32_32x32x16_bf16(pa1,PK(1),o[d0],0,0,0);
    o[d0]=__builtin_amdgcn_mfma_f32_32x32x16_bf16(pa2,PK(2),o[d0],0,0,0);
    o[d0]=__builtin_amdgcn_mfma_f32_32x32x16_bf16(pa3,PK(3),o[d0],0,0,0);
    #undef PK
  }
}

#ifndef ATTN_STORE16
#define ATTN_STORE16(p,v) (*(u32x4*)(p)=(v))
#endif
template<int THRL> __device__ __forceinline__ void attn_unit(const int tid,int b,int h,int qb,const bf16*Q,const bf16*__restrict__ K,const bf16*__restrict__ V,bf16*O,char*shm){
  const int lane=tid&63,r32=lane&31,hi=lane>>5; const int wid=__builtin_amdgcn_readfirstlane(tid>>6);
  const long bhbase=(long)(b*NHEAD+h)*SEQ; const long rowbase=(long)b*SEQ; const int q0=qb*QB;
  const bf16*Qw=Q+(bhbase+q0+wid*QBLK)*DQ;
  const bf16*Kh=K+bhbase*DQ,*Vh=V+bhbase*DV;
  const unsigned lds0=(unsigned)(uintptr_t)shm;
  float*wsf=(float*)(shm+LDS_WS)+wid*64;
  const bf16*ksrc=Kh+(long)lane*DQ+wid*8;
  const bf16*vsrc=Vh+(long)(16*(wid&3)+(lane>>2))*DV+(wid>>2)*32+(lane&3)*8;
  const unsigned kdst=lds0+LDS_K+wid*1024, vdst=lds0+LDS_V+wid*1024;
  #define DMA_K(t,slot) do{ glds16(ksrc+(long)(t)*KVBLK*DQ,(unsigned)__builtin_amdgcn_readfirstlane(kdst+(slot))); if(wid<4) glds16(ksrc+(long)(t)*KVBLK*DQ+64,(unsigned)__builtin_amdgcn_readfirstlane(kdst+8192+(slot))); }while(0)
  #define DMA_V(t,slot) glds16(vsrc+(long)(t)*KVBLK*DV,(unsigned)__builtin_amdgcn_readfirstlane(vdst+(slot)))
  const int vb0=(int)(lds0+LDS_V)+((lane>>4)&1)*32+(lane&3)*8+(4*hi+((lane&15)>>2))*64;
  const char*Kbase=shm+LDS_K; bf16x8 kf[12];
  const lds_cptr shm3=(lds_cptr)shm; const lds_cptr kp0=shm3+LDS_K+hi*1024+r32*16; const lds_cptr vp0=shm3+LDS_V+((lane>>4)&1)*32+(lane&3)*8+(4*hi+((lane&15)>>2))*64;
  const int NT=(q0+QB)/KVBLK;
  DMA_K(0,0);DMA_V(0,0);DMA_K(1,KSLOTB);
  bf16x8 qr[6];
  #pragma unroll
  for(int d0=0;d0<6;++d0)qr[d0]=*reinterpret_cast<const bf16x8*>(&Qw[(long)r32*DQ+d0*16+hi*8]);
  float mhat=0.f,l_reg=0.f;f32x16 o[2];o[0]=f32x16{};o[1]=f32x16{};const f32x16 zc=f32x16{};
  const int qrel=wid*QBLK+r32;
  #define CMASK(P0,P1,t) do{int jb_=(t)-(NT-4); if(jb_>=0)cmask(P0,P1,jb_,qrel,hi);}while(0)
  bool resc=false;
  #define START(P0,P1) do{ const float rm=rowmax(P0,P1); resc=false; \
    { const float dl=rm; mhat=fadd_s(mhat,dl); \
      _Pragma("unroll") for(int r=0;r<16;++r){P0[r]=fsub_s(P0[r],dl);P1[r]=fsub_s(P1[r],dl);} } \
    _Pragma("unroll") for(int r=0;r<16;++r)P0[r]=__builtin_amdgcn_exp2f(P0[r]); }while(0)
  #define RESC() do{ if(resc){ asm volatile("s_waitcnt lgkmcnt(0)":::"memory"); const float*wl_=wsf+4*hi; asm volatile("":"+v"(wl_)); \
      _Pragma("unroll") for(int d_=0;d_<2;++d_) _Pragma("unroll") for(int r=0;r<16;++r)o[d_][r]*=wl_[crow(r,0)]; } }while(0)
  f32x16 pA0,pA1,pB0,pB1;
  int kprev=3*KSLOTB,kcur=0,knext=KSLOTB, vprev=0,vcur=0,vnext=VSLOTB;
  #define ROT() do{kprev=kcur;kcur=knext;knext=(knext==(NSLOTK-1)*KSLOTB)?0:knext+KSLOTB; vprev=vcur;vcur=vnext;vnext=(vnext==(NSLOT-1)*VSLOTB)?0:vnext+VSLOTB;}while(0)
  DMA_K(2,2*KSLOTB);
  WAIT_BAR2(5,3);
  qkt(pA0,pA1,Kbase,qr,r32,hi);asm volatile("s_nop 15\n\ts_nop 7":"+v"(pA0),"+v"(pA1));CMASK(pA0,pA1,0);
  START(pA0,pA1);
  _Pragma("unroll") for(int r=0;r<16;++r)pA1[r]=__builtin_amdgcn_exp2f(pA1[r]);
  WAIT_BAR(0);
  DMA_K(3,3*KSLOTB);DMA_V(1,VSLOTB);
  ROT();
  kload2(kf,kp0+kcur,0); kload2(kf,kp0+kcur,1); kload2(kf,kp0+kcur,2); kload2(kf,kp0+kcur,3); kload2(kf,kp0+kcur,4); kload2(kf,kp0+kcur,5);
  WAIT_BAR2(3,2);
  s16x4 vlo[8],vhi[8]; u32x4 pw0,pw1,pw2,pw3;
  #define PKW(P,B) cvtpk_s(P[B],P[B+1])
  #define PAF(k) __builtin_bit_cast(bf16x8,pw##k)
  #define VFR(i) (bf16x8){vlo[i][0],vlo[i][1],vlo[i][2],vlo[i][3],vhi[i][0],vhi[i][1],vhi[i][2],vhi[i][3]}
  #define PIN(x) asm volatile("":"+v"(x))
  #define MX3(a,b,c) __builtin_fmaxf(__builtin_fmaxf((a),(b)),(c))
  #define GAPA(MF,A0,A1,A2,A3,W0,W1,PW) do{ MF; sacc+=A0; sacc+=A1; sacc+=A2; sacc+=A3; PIN(sacc); W0; W1; PIN(PW); SBAR(); }while(0)
  #define EX(v) __builtin_amdgcn_exp2f(v)
  #define GAPB(MF,X,B) do{ MF; X[B]=EX(X[B]-mhat); X[B+1]=EX(X[B+1]-mhat); X[B+2]=EX(X[B+2]-mhat); X[B+3]=EX(X[B+3]-mhat); PIN(X); SBAR(); }while(0)
  #define VRD(i) do{ vlo[i]=vtr(vp_+(((i)>>2)*4096+((i)&3)*1024)); vhi[i]=vtr(vp_+(((i)>>2)*4096+((i)&3)*1024+512)); }while(0)
  #define KRD(G,j) do{ if(G){ kload2(kf,kp0+knext,j); SBAR(); } }while(0)
  #define STEP(C0,C1,P0,P1,t,GK,GV,GL) do{ SBAR(); \
    const lds_cptr vp_=vp0+vprev; float sacc=(P0[0]+P0[1]); \
    GAPA(C0=__builtin_amdgcn_mfma_f32_32x32x16_bf16(kf[0],qr[0],zc,0,0,0), P0[2],P0[3],P0[4],P0[5],     pw0[0]=PKW(P0,0), pw0[1]=PKW(P0,2), pw0); \
    GAPA(C1=__builtin_amdgcn_mfma_f32_32x32x16_bf16(kf[1],qr[0],zc,0,0,0), P0[6],P0[7],P0[8],P0[9],     pw0[2]=PKW(P0,4), pw0[3]=PKW(P0,6), pw0); \
    GAPA(C0=__builtin_amdgcn_mfma_f32_32x32x16_bf16(kf[2],qr[1],C0,0,0,0),   P0[10],P0[11],P0[12],P0[13], pw1[0]=PKW(P0,8), pw1[1]=PKW(P0,10), pw1); \
    GAPA(C1=__builtin_amdgcn_mfma_f32_32x32x16_bf16(kf[3],qr[1],C1,0,0,0),   P0[14],P0[15],P1[0],P1[1],   pw1[2]=PKW(P0,12),pw1[3]=PKW(P0,14), pw1); \
    GAPA(C0=__builtin_amdgcn_mfma_f32_32x32x16_bf16(kf[4],qr[2],C0,0,0,0),   P1[2],P1[3],P1[4],P1[5],     pw2[0]=PKW(P1,0), pw2[1]=PKW(P1,2), pw2); \
    GAPA(C1=__builtin_amdgcn_mfma_f32_32x32x16_bf16(kf[5],qr[2],C1,0,0,0),   P1[6],P1[7],P1[8],P1[9],     pw2[2]=PKW(P1,4), pw2[3]=PKW(P1,6), pw2); \
    GAPA(C0=__builtin_amdgcn_mfma_f32_32x32x16_bf16(kf[6],qr[3],C0,0,0,0),   P1[10],P1[11],P1[12],P1[13], pw3[0]=PKW(P1,8), pw3[1]=PKW(P1,10), pw3); \
    GAPA(C1=__builtin_amdgcn_mfma_f32_32x32x16_bf16(kf[7],qr[3],C1,0,0,0),   P1[14],P1[15],0.f,0.f,       pw3[2]=PKW(P1,12),pw3[3]=PKW(P1,14), pw3); \
    VRD(0); C0=__builtin_amdgcn_mfma_f32_32x32x16_bf16(kf[8],qr[4],C0,0,0,0); C1=__builtin_amdgcn_mfma_f32_32x32x16_bf16(kf[9],qr[4],C1,0,0,0); SBAR(); \
    VRD(4); C0=__builtin_amdgcn_mfma_f32_32x32x16_bf16(kf[10],qr[5],C0,0,0,0); C1=__builtin_amdgcn_mfma_f32_32x32x16_bf16(kf[11],qr[5],C1,0,0,0); SBAR(); \
    l_reg+=sacc; \
    if(GK){DMA_K((t)+3,kprev);} if(GV){DMA_V((t)+1,vnext);} \
    CMASK(C0,C1,t); \
    { float a=MX3(C0[0],C0[1],C1[0]),b=MX3(C0[2],C0[3],C1[1]); a=MX3(a,C1[2],C1[3]); \
      _Pragma("unroll") for(int r=4;r<16;r+=4){a=MX3(a,C0[r],C0[r+1]);b=MX3(b,C0[r+2],C0[r+3]);a=MX3(a,C1[r],C1[r+1]);b=MX3(b,C1[r+2],C1[r+3]);} \
      float rm=__builtin_fmaxf(a,b), rm2=rm; swap32(rm,rm2); rm=__builtin_fmaxf(rm,rm2)-mhat; \
      resc=false; \
      if(__builtin_expect(__any(rm>(float)THRL),0)){ const float dl=__builtin_fmaxf(rm,0.f); mhat+=dl; \
        const float f=__builtin_amdgcn_exp2f(-dl); l_reg*=f; if(hi==0)wsf[r32]=f; resc=true; } } \
    SBAR(); \
    VRD(1); SBAR(); GAPB(o[0]=__builtin_amdgcn_mfma_f32_32x32x16_bf16(PAF(0),VFR(0),o[0],0,0,0), C0,0); \
    KRD(GL,0); VRD(5); SBAR(); GAPB(o[1]=__builtin_amdgcn_mfma_f32_32x32x16_bf16(PAF(0),VFR(4),o[1],0,0,0), C0,4); \
    KRD(GL,1); VRD(2); SBAR(); GAPB(o[0]=__builtin_amdgcn_mfma_f32_32x32x16_bf16(PAF(1),VFR(1),o[0],0,0,0), C0,8); \
    KRD(GL,2); VRD(6); SBAR(); GAPB(o[1]=__builtin_amdgcn_mfma_f32_32x32x16_bf16(PAF(1),VFR(5),o[1],0,0,0), C0,12); \
    KRD(GL,3); VRD(3); SBAR(); GAPB(o[0]=__builtin_amdgcn_mfma_f32_32x32x16_bf16(PAF(2),VFR(2),o[0],0,0,0), C1,0); \
    KRD(GL,4); VRD(7); SBAR(); GAPB(o[1]=__builtin_amdgcn_mfma_f32_32x32x16_bf16(PAF(2),VFR(6),o[1],0,0,0), C1,4); \
    KRD(GL,5); GAPB(o[0]=__builtin_amdgcn_mfma_f32_32x32x16_bf16(PAF(3),VFR(3),o[0],0,0,0), C1,8); \
    GAPB(o[1]=__builtin_amdgcn_mfma_f32_32x32x16_bf16(PAF(3),VFR(7),o[1],0,0,0), C1,12); \
    }while(0)
  int t=1;
  #undef CMASK
  #define CMASK(P0,P1,t) do{}while(0)
  for(;t+5<NT;t+=2){
    STEP(pB0,pB1,pA0,pA1,t,true,true,true);     WAIT_BAR2(3,2); RESC(); ROT();
    STEP(pA0,pA1,pB0,pB1,t+1,true,true,true);   WAIT_BAR2(3,2); RESC(); ROT();
  }
  #undef CMASK
  #define CMASK(P0,P1,t) do{int jb_=(t)-(NT-4); if(jb_>=0)cmask(P0,P1,jb_,qrel,hi);}while(0)
  #define ENDW(tt) do{ if((tt)+3<NT){WAIT_BAR2(3,2);} else if((tt)+2<NT){WAIT_BAR(1);} else {WAIT_BAR(0);} }while(0)
  for(;t+1<NT;t+=2){
    STEP(pB0,pB1,pA0,pA1,t,(t+3<NT),(t+1<NT),(t+1<NT));       ENDW(t);   RESC(); ROT();
    STEP(pA0,pA1,pB0,pB1,t+1,(t+4<NT),(t+2<NT),(t+2<NT));     ENDW(t+1); RESC(); ROT();
  }
  STEP(pB0,pB1,pA0,pA1,NT-1,false,false,false); RESC();
  { float sacc=pB0[0]+pB0[1]; _Pragma("unroll") for(int r=2;r<16;++r)sacc+=pB0[r]; _Pragma("unroll") for(int r=0;r<16;++r)sacc+=pB1[r]; l_reg+=sacc;
    pw0=(u32x4){PKW(pB0,0),PKW(pB0,2),PKW(pB0,4),PKW(pB0,6)};pw1=(u32x4){PKW(pB0,8),PKW(pB0,10),PKW(pB0,12),PKW(pB0,14)};pw2=(u32x4){PKW(pB1,0),PKW(pB1,2),PKW(pB1,4),PKW(pB1,6)};pw3=(u32x4){PKW(pB1,8),PKW(pB1,10),PKW(pB1,12),PKW(pB1,14)};
    SBAR(); pv(o,vb0+vcur,PAF(0),PAF(1),PAF(2),PAF(3)); }
  #undef PKW
  #undef PAF
  #undef VFR
  #undef PIN
  #undef MX3
  #undef GAPA
  #undef GAPB
  #undef EX
  #undef VRD
  #undef KRD
  #undef STEP
  #undef ENDW
  {float l2=l_reg; swap32(l_reg,l2); l_reg=l_reg+l2;}
  if(hi==0)wsf[32+r32]=l_reg;asm volatile("s_waitcnt lgkmcnt(0)":::"memory");
  float rli[16]; { const float*wl_=wsf+32+4*hi; asm volatile("":"+v"(wl_));
  #pragma unroll
  for(int r=0;r<16;++r)rli[r]=__builtin_amdgcn_rcpf(wl_[crow(r,0)]); }
  bf16*Ow=O+(rowbase+q0+wid*QBLK)*OPITCH+h*DV;
  { bf16*stg=(bf16*)(shm+LDS_OST+wid*QOB);
    { bf16*stw=stg+(4*hi)*64+r32; asm volatile("":"+v"(stw));
    #pragma unroll
    for(int r=0;r<16;++r){const int orow=crow(r,0);
      #pragma unroll
      for(int d0=0;d0<2;++d0)stw[orow*64+d0*32]=__float2bfloat16(o[d0][r]*rli[r]);} }
    asm volatile("s_waitcnt lgkmcnt(0)":::"memory");
    #pragma unroll
    for(int i=0;i<4;++i){const int row=i*8+(lane>>3),ch=lane&7; const u32x4 v=*(const u32x4*)(stg+row*64+ch*8); ATTN_STORE16(Ow+(long)row*OPITCH+ch*8,v);} }
  asm volatile("s_waitcnt lgkmcnt(0)\n\ts_barrier":::"memory");
  #undef DMA_K
  #undef DMA_V
  #undef CMASK
  #undef START
  #undef RESC
  #undef ROT
}
constexpr int ATTN_LDS_BYTES=LDS_BYTES;
#undef SBAR
#undef WAIT_BAR
#undef WAIT_BAR2
}

constexpr int NWAVES = 8, NTHR = 512;
constexpr int BATCH = 2, SEQ = 16384, DM = 1024, T = BATCH * SEQ;
constexpr int D_IN = 2736, D_INP = 2816;
constexpr int U_CQ = 0, U_CKV = 256, U_KR = 384, U_Z = 416, U_XBC = 928, U_DT = 1696;
constexpr int U_GQKV = 1704, U_GZ = 2472, U_GB = 2728, U_GA = 2732;
constexpr int DFF = 2816, DFFE = 3584, NEXP = 8;
constexpr float EPS = 1e-6f;
constexpr float QSCALE = 0.10206207261596577f * 1.4426950408889634f;

constexpr size_t MiB = 1u << 20;
constexpr size_t WS_CTL = 0, CTL_ZERO_BYTES = 32 * 1024;
constexpr size_t WS_MODP = 1 * MiB;
constexpr size_t WS_PARTA = WS_MODP, WS_PARTB = WS_MODP + 512 * 1024;
constexpr size_t WS_BIASF = WS_MODP + 1 * MiB, WS_BIASW = WS_BIASF + 64 * 1024;
constexpr size_t WS_MOD = 2 * MiB + 512 * 1024;
constexpr size_t WS_ROWTOK = 3 * MiB;
constexpr size_t WS_TOKSLOT = 4 * MiB;
constexpr size_t WS_TOKW = 4 * MiB + 256 * 1024;
constexpr size_t WS_DT = 5 * MiB;
constexpr size_t WS_BG = 6 * MiB;
constexpr size_t WS_W = 8 * MiB;
constexpr size_t WS_WIN = WS_W;
constexpr size_t WS_WOUT = WS_WIN + 11 * MiB;
constexpr size_t WS_FUP = WS_WOUT + 4 * MiB;
constexpr size_t WS_FDN = WS_FUP + 11 * MiB;
constexpr size_t WS_WQ = WS_FDN + 5 * MiB + 512 * 1024;
constexpr size_t WS_WKV = WS_WQ + 512 * 1024;
constexpr size_t WS_O = 42 * MiB;
constexpr size_t WS_U = 106 * MiB;
constexpr size_t WS_HID = WS_U + 51 * MiB;
constexpr size_t WS_Y = WS_W;
constexpr size_t WS_H = 282 * MiB;
constexpr size_t WS_M = 346 * MiB;
constexpr size_t WS_MUP = WS_M, WS_MDN = WS_M + 112 * MiB;
constexpr size_t WS_H8 = WS_MUP + 56 * MiB;
constexpr float FP8_SA = 8.0f, FP8_SW = 64.0f;
constexpr size_t WS_Q = WS_M;
constexpr size_t WS_FUPS = WS_M, WS_WINS = WS_M + 22 * MiB;
constexpr size_t WS_K = WS_Q + 24 * MiB;
constexpr size_t WS_V = WS_K + 24 * MiB;
constexpr size_t WS_XS = WS_V + 16 * MiB;
constexpr size_t WS_SST = WS_XS, WS_CS = WS_XS + 32 * MiB;
constexpr size_t WS_GF = WS_XS + 48 * MiB;
constexpr size_t WS_OR = WS_GF + 80 * MiB;
constexpr size_t WS_ROPE = WS_OR + 32 * MiB;
constexpr size_t WS_END = WS_ROPE + 2 * MiB;
static_assert(WS_Y + (size_t)264 * 256 * 1024 * 2 <= WS_HID, "y vs hid");
constexpr size_t HID_STRIDE = 62 * MiB + 512 * 1024;
static_assert((size_t)71 * 256 * 3584 <= HID_STRIDE && WS_HID + 2 * HID_STRIDE <= WS_H, "hid vs h");
static_assert(WS_FDN + (size_t)1024 * 2816 * 2 <= WS_WQ && WS_WKV + 256 * 1024 <= WS_O, "weights vs o");
constexpr int CW_TMO = 0, CW_MOECNT = 64, CW_ATTQ = 640, CW_BAR = 4096;

constexpr int LDS_BYTES = 147456, RING_BYTES = 131072, MISC_OFF = RING_BYTES + 320;

struct Args { const float* in[29]; float* out; unsigned char* ws; int ph_lo, ph_hi; };

struct Frame { LAS unsigned char* lds; volatile LAS unsigned* MISC; int tid, lane, wave, vcu, G, gw, NGW; };
__device__ __forceinline__ const float* P(const Frame& F, int i) { const unsigned lo = __builtin_amdgcn_readfirstlane(F.MISC[64 + 2 * i]), hi = __builtin_amdgcn_readfirstlane(F.MISC[65 + 2 * i]);
    return (const float*)(const GAS float*)(((unsigned long long)hi << 32) | lo); }
__device__ __forceinline__ unsigned char* WSP(const Frame& F) { return (unsigned char*)P(F, 29); }
__device__ __forceinline__ float* OUTP(const Frame& F) { return (float*)P(F, 30); }


__device__ __forceinline__ Frame reframe(const Frame& F0) { Frame F = F0; int ln; unsigned lb = 0;
    asm volatile("v_mbcnt_lo_u32_b32 %0, -1, 0\n\tv_mbcnt_hi_u32_b32 %0, -1, %0" : "=v"(ln));
    asm volatile("" : "+s"(lb));
    F.lds = F0.lds + lb; F.MISC = (volatile LAS unsigned*)(F.lds + MISC_OFF);
    int vcv = F0.vcu; asm volatile("" : "+s"(vcv)); F.vcu = vcv;
    int gwv = F.vcu * NWAVES + F.wave; asm volatile("" : "+s"(gwv));
    F.lane = ln; F.tid = F.wave * 64 + ln; F.gw = gwv; return F; }
__device__ __forceinline__ int opq(int v) { asm volatile("" : "+s"(v)); return v; }
#define SWZ(v, k) __builtin_bit_cast(float, __builtin_amdgcn_ds_swizzle(__builtin_bit_cast(int, (v)), ((k) << 10) | 0x1f))
template <int CTRL> __device__ __forceinline__ float dppf(float v) { return __builtin_bit_cast(float, __builtin_amdgcn_update_dpp(0, __builtin_bit_cast(int, v), CTRL, 0xf, 0xf, true)); }
__device__ __forceinline__ float sum16(float v) { v += dppf<0xB1>(v); v += dppf<0x4E>(v); v += dppf<0x141>(v); v += dppf<0x140>(v); return v; }
__device__ __forceinline__ float max16(float v) { v = fmaxf(v, dppf<0xB1>(v)); v = fmaxf(v, dppf<0x4E>(v)); v = fmaxf(v, dppf<0x141>(v)); v = fmaxf(v, dppf<0x140>(v)); return v; }
#define RDL(v, k) __builtin_bit_cast(float, __builtin_amdgcn_readlane(__builtin_bit_cast(int, (v)), (k)))
__device__ __forceinline__ float wave_sum(float v) { v = sum16(v); return (RDL(v, 0) + RDL(v, 16)) + (RDL(v, 32) + RDL(v, 48)); }
__device__ __forceinline__ float wave_max(float v) { v = max16(v); return fmaxf(fmaxf(RDL(v, 0), RDL(v, 16)), fmaxf(RDL(v, 32), RDL(v, 48))); }
__device__ __forceinline__ float rcp_f(float x) { return __builtin_amdgcn_rcpf(x); }
__device__ __forceinline__ float rsq_f(float x) { return __builtin_amdgcn_rsqf(x); }
__device__ __forceinline__ float exp_f(float x) { return __builtin_amdgcn_exp2f(x * 1.4426950408889634f); }
__device__ __forceinline__ float silu_f(float x) { return x * rcp_f(1.f + exp_f(-x)); }
__device__ __forceinline__ float sigmoid_f(float x) { return rcp_f(1.f + exp_f(-x)); }
__device__ __forceinline__ float softplus_f(float x) { const float e = exp_f(-fabsf(x));
    const float l = (e < 0.01f) ? e * (1.f - e * (0.5f - e * 0.33333334f)) : __builtin_amdgcn_logf(1.f + e) * 0.6931471805599453f;
    return fmaxf(x, 0.f) + l; }

__device__ __forceinline__ void tr_block(const float* W, int ldw, int nvalid, int k0, int n0, bf16* WT, int ldt, int drow0, LAS float* scr, int lane, const float* kscale = nullptr) {
    const int col = n0 + (lane & 31);
#pragma unroll 8
    for (int i = 0; i < 32; ++i) { const int kk = 2 * i + (lane >> 5); float v = (col < nvalid) ? W[(size_t)(k0 + kk) * ldw + col] : 0.f; if (kscale) v *= kscale[k0 + kk]; scr[kk * 33 + (lane & 31)] = v; }
    LDS_WAIT(); asm volatile("" ::: "memory");
    const int c = lane & 7;
#pragma unroll
    for (int j = 0; j < 4; ++j) { const int n = (lane >> 3) + 8 * j; const LAS float* s = scr + (8 * c) * 33 + n;
        v4u o; o.x = pk2(s[0 * 33], s[1 * 33]); o.y = pk2(s[2 * 33], s[3 * 33]); o.z = pk2(s[4 * 33], s[5 * 33]); o.w = pk2(s[6 * 33], s[7 * 33]);
        *(GAS v4u*)(WT + (size_t)(drow0 + n) * ldt + k0 + 8 * c) = o; }
    LDS_WAIT(); asm volatile("" ::: "memory");
}

__device__ __forceinline__ void ph_prologue(const Frame& F, const Args& a) {
    unsigned char* const ws = WSP(F);
    const float* c = P(F, 1); const float* ada_w = P(F, 2);
    { float* mod = (float*)(ws + WS_MOD); const float* ada_b = P(F, 3); LAS float* red = (LAS float*)(F.lds + 131072 - 8192);
      for (int it = F.vcu; it < 2 * 96; it += F.G) { const int l = it / 96, cb = it % 96, col = cb * 64 + F.lane;
        const float* w = ada_w + (size_t)l * 1024 * 6144 + (size_t)(F.wave * 128) * 6144 + col;
        float a0 = 0.f, a1 = 0.f;
#pragma unroll 8
        for (int k = 0; k < 128; ++k) { const float wv = w[(size_t)k * 6144]; const int kk = F.wave * 128 + k; a0 += silu_f(c[kk]) * wv; a1 += silu_f(c[1024 + kk]) * wv; }
        red[(F.wave * 2 + 0) * 64 + F.lane] = a0; red[(F.wave * 2 + 1) * 64 + F.lane] = a1;
        __syncthreads();
        if (F.tid < 128) { const int b = F.tid >> 6, cl = F.tid & 63; float sacc = ada_b[l * 6144 + cb * 64 + cl];
#pragma unroll
            for (int wv = 0; wv < 8; ++wv) sacc += red[(wv * 2 + b) * 64 + cl];
            mod[(size_t)(l * 2 + b) * 6144 + cb * 64 + cl] = sacc; }
        __syncthreads(); } }
    LAS float* scr = (LAS float*)(F.lds + F.wave * 16384);
    bf16* WIN = (bf16*)(ws + WS_WIN); bf16* WOUT = (bf16*)(ws + WS_WOUT); bf16* FUP = (bf16*)(ws + WS_FUP); bf16* FDN = (bf16*)(ws + WS_FDN);
    constexpr int NB_IN = 16 * 88, NB_OUT = 16 * 32, NB_F = 16 * 88, NB_FD = 44 * 32;
    constexpr int NB_Q = 4 * 16, NB_KV = 2 * 16;
    constexpr int NITEMS = 2 * NB_IN + 2 * NB_OUT + 2 * NB_F + NB_FD + 2 * NB_Q + 2 * NB_KV;
    for (int it = F.gw; it < NITEMS; it += F.NGW) {
        int r = it;
        if (r < 2 * NB_IN) { const int l = r / NB_IN; r %= NB_IN; const int kb = r / 88, nb = r % 88;
            tr_block(P(F, 4) + (size_t)l * 1024 * D_IN, D_IN, D_IN, kb * 64, nb * 32, WIN + (size_t)l * D_INP * 1024, 1024, nb * 32, scr, F.lane); continue; }
        r -= 2 * NB_IN;
        if (r < 2 * NB_OUT) { const int l = r / NB_OUT; r %= NB_OUT; const int kb = r / 32, nb = r % 32;
            tr_block(P(F, 20) + (size_t)l * 1024 * 1024, 1024, 1024, kb * 64, nb * 32, WOUT + (size_t)l * 1024 * 1024, 1024, nb * 32, scr, F.lane); continue; }
        r -= 2 * NB_OUT;
        if (r < 2 * NB_F) { const int which = r / NB_F; r %= NB_F; const int kb = r / 88, nb = r % 88, n0 = nb * 32;
            tr_block(P(F, 21 + which), DFF, DFF, kb * 64, n0, FUP, 1024, 256 * (n0 / 128) + 128 * which + (n0 % 128), scr, F.lane); continue; }
        r -= 2 * NB_F;
        if (r < NB_FD) { const int kb = r / 32, nb = r % 32; tr_block(P(F, 23), 1024, 1024, kb * 64, nb * 32, FDN, DFF, nb * 32, scr, F.lane); continue; }
        r -= NB_FD;
        if (r < 2 * NB_Q) { const int l = r / NB_Q; r %= NB_Q; const int kb = r / 16, nb = r % 16;
            tr_block(P(F, 6) + (size_t)l * 256 * 384, 384, 384, kb * 64, nb * 32, (bf16*)(ws + WS_WQ) + (size_t)l * 512 * 256, 256, nb * 32, scr, F.lane, P(F, 5) + l * 256); continue; }
        r -= 2 * NB_Q;
        { const int l = r / NB_KV; r %= NB_KV; const int kb = r / 16, nb = r % 16;
            tr_block(P(F, 8) + (size_t)l * 128 * 512, 512, 512, kb * 64, nb * 32, (bf16*)(ws + WS_WKV) + (size_t)l * 512 * 128, 128, nb * 32, scr, F.lane, P(F, 7) + l * 128); }
    }
    { float* RT = (float*)(ws + WS_ROPE);
      for (int id = F.vcu * NTHR + F.tid; id < SEQ * 16; id += F.G * NTHR) { const int s = id >> 4, sub = id & 15;
        const float inv_freq = sub == 0 ? 1.0f : sub == 1 ? 0.5623413251903491f : sub == 2 ? 0.31622776601683794f : sub == 3 ? 0.1778279410038923f : sub == 4 ? 0.1f : sub == 5 ? 0.05623413251903491f
            : sub == 6 ? 0.031622776601683794f : sub == 7 ? 0.01778279410038923f : sub == 8 ? 0.01f : sub == 9 ? 0.005623413251903491f : sub == 10 ? 0.0031622776601683794f : sub == 11 ? 0.001778279410038923f
            : sub == 12 ? 0.001f : sub == 13 ? 0.0005623413251903491f : sub == 14 ? 0.00031622776601683794f : 0.0001778279410038923f;
        const float ang = (float)s * inv_freq; double rev = (double)ang * 0.15915494309189535; rev -= floor(rev); const float rf = (float)rev;
        RT[2 * id] = __builtin_amdgcn_cosf(rf); RT[2 * id + 1] = __builtin_amdgcn_sinf(rf); } }
}
__device__ __forceinline__ void ph_modreduce(const Frame& F, const Args& a) {
    unsigned char* const ws = WSP(F);
    const float* modp = (const float*)(ws + WS_MODP); float* mod = (float*)(ws + WS_MOD); const float* ada_b = P(F, 3);
    for (int idx = F.vcu * NTHR + F.tid; idx < 2 * 2 * 6144; idx += F.G * NTHR) {
        const int l = idx / 12288, r = idx % 12288, col = r % 6144;
        float s = ada_b[l * 6144 + col];
#pragma unroll
        for (int ks = 0; ks < 16; ++ks) s += modp[(size_t)(l * 16 + ks) * 12288 + r];
        mod[idx] = s;
    }
}
__device__ __forceinline__ void norm_row_load(const void* xbase, size_t row, bool isbf, int lane, f32x4 (&v)[4]) {
    if (isbf) { const GAS v2u* xr = (const GAS v2u*)((const bf16*)xbase + row * DM) + lane;
#pragma unroll
        for (int j = 0; j < 4; ++j) { const v2u w = xr[64 * j]; v[j] = (f32x4){bflo(w.x), bfhi(w.x), bflo(w.y), bfhi(w.y)}; } }
    else { const GAS f32x4* xr = (const GAS f32x4*)((const float*)xbase + row * DM) + lane;
#pragma unroll
        for (int j = 0; j < 4; ++j) v[j] = xr[64 * j]; }
}
template <bool STORE = true> __device__ __forceinline__ void norm_mod_apply(const f32x4 (&v)[4], bf16* hrow, const float* sh, const float* sc, int lane, f32x4 (&hv)[4]) {
    float s = 0.f;
#pragma unroll
    for (int j = 0; j < 4; ++j) s += (v[j].x * v[j].x + v[j].y * v[j].y) + (v[j].z * v[j].z + v[j].w * v[j].w);
    const float rstd = rsq_f(wave_sum(s) * (1.f / 1024.f) + EPS);
    GAS v2u* o8 = (GAS v2u*)hrow + lane;
#pragma unroll
    for (int j = 0; j < 4; ++j) { const f32x4 s4 = ((const GAS f32x4*)sh)[lane + 64 * j], c4 = ((const GAS f32x4*)sc)[lane + 64 * j];
        const f32x4 h = v[j] * rstd * (c4 + 1.0f) + s4; hv[j] = h; if (STORE) { v2u w; w.x = pk2(h.x, h.y); w.y = pk2(h.z, h.w); o8[64 * j] = w; } }
}
__device__ __forceinline__ void ph_normmod(const Frame& F, const Args& a, const void* src, bool isbf, int l, int which  ) {
    unsigned char* const ws = WSP(F);
    const float* mod = (const float*)(ws + WS_MOD) + (size_t)l * 12288; bf16* H = (bf16*)(ws + WS_H);
    const int lane = F.lane, m0 = F.gw, st = F.NGW;
    f32x4 va[4], vb[4], vc[4];
    if (m0 < T) norm_row_load(src, (size_t)m0, isbf, lane, va);
    if (m0 + st < T) norm_row_load(src, (size_t)(m0 + st), isbf, lane, vb);
#pragma unroll 1
    for (int m = m0; m < T; m += st) { const int b = m / SEQ; f32x4 hv[4];
        if (m + 2 * st < T) norm_row_load(src, (size_t)(m + 2 * st), isbf, lane, vc);
        norm_mod_apply(va, H + (size_t)m * DM, mod + b * 6144 + which * 3072, mod + b * 6144 + which * 3072 + 1024, lane, hv);
#pragma unroll
        for (int j = 0; j < 4; ++j) { va[j] = vb[j]; vb[j] = vc[j]; } }
}

__device__ __forceinline__ void ph_mla(const Frame& F, const Args& a, int l) {
    unsigned char* const ws = WSP(F);
    const bf16* U = (const bf16*)(ws + WS_U); bf16* Qb = (bf16*)(ws + WS_Q); bf16* Kb = (bf16*)(ws + WS_K); bf16* Vb = (bf16*)(ws + WS_V); const float* RT = (const float*)(ws + WS_ROPE);
    LAS float* rs = (LAS float*)(F.lds + RING_BYTES + 4096);
    pg8::StaticOrder S; S.init(T, 512, F.G, (int)blockIdx.x);
    for (int ui = 0; ; ++ui) {
        pg8::Unit u; if (!S.next(ui, u)) break;
        { const int r = F.tid >> 1, hf = F.tid & 1, row = u.pm * 256 + r, b = row / SEQ, s = row % SEQ; const bf16* ur = U + (size_t)row * D_INP;
          float sq = 0.f, sk = 0.f;
#pragma unroll
          for (int j = 0; j < 16; ++j) { const v4u w = *(const v4u*)(ur + U_CQ + hf * 128 + j * 8); sq += bflo(w.x) * bflo(w.x) + bfhi(w.x) * bfhi(w.x) + bflo(w.y) * bflo(w.y) + bfhi(w.y) * bfhi(w.y) + bflo(w.z) * bflo(w.z) + bfhi(w.z) * bfhi(w.z) + bflo(w.w) * bflo(w.w) + bfhi(w.w) * bfhi(w.w); }
#pragma unroll
          for (int j = 0; j < 8; ++j) { const v4u w = *(const v4u*)(ur + U_CKV + hf * 64 + j * 8); sk += bflo(w.x) * bflo(w.x) + bfhi(w.x) * bfhi(w.x) + bflo(w.y) * bflo(w.y) + bfhi(w.y) * bfhi(w.y) + bflo(w.z) * bflo(w.z) + bfhi(w.z) * bfhi(w.z) + bflo(w.w) * bflo(w.w) + bfhi(w.w) * bfhi(w.w); }
          sq += SWZ(sq, 1); sk += SWZ(sk, 1);
          if (hf == 0) { rs[r] = rsq_f(sq * (1.f / 256.f) + EPS); rs[256 + r] = rsq_f(sk * (1.f / 128.f) + EPS); }
          const v4u wa = *(const v4u*)(ur + U_KR + hf * 8), wb = *(const v4u*)(ur + U_KR + 16 + hf * 8);
          float t1[8] = {bflo(wa.x), bfhi(wa.x), bflo(wa.y), bfhi(wa.y), bflo(wa.z), bfhi(wa.z), bflo(wa.w), bfhi(wa.w)}, t2[8] = {bflo(wb.x), bfhi(wb.x), bflo(wb.y), bfhi(wb.y), bflo(wb.z), bfhi(wb.z), bflo(wb.w), bfhi(wb.w)};
          float o1[8], o2[8];
#pragma unroll
          for (int j = 0; j < 8; ++j) { const float cc = RT[((size_t)s * 16 + hf * 8 + j) * 2], sn = RT[((size_t)s * 16 + hf * 8 + j) * 2 + 1]; o1[j] = t1[j] * cc - t2[j] * sn; o2[j] = t2[j] * cc + t1[j] * sn; }
          v4u p1, p2; p1.x = pk2(o1[0], o1[1]); p1.y = pk2(o1[2], o1[3]); p1.z = pk2(o1[4], o1[5]); p1.w = pk2(o1[6], o1[7]); p2.x = pk2(o2[0], o2[1]); p2.y = pk2(o2[2], o2[3]); p2.z = pk2(o2[4], o2[5]); p2.w = pk2(o2[6], o2[7]);
#pragma unroll
          for (int h = 0; h < 4; ++h) { bf16* kp = Kb + ((size_t)(b * 4 + h) * SEQ + s) * 96 + 64 + hf * 8; *(v4u*)kp = p1; *(v4u*)(kp + 16) = p2; } }
        __syncthreads();
        if (ui > 0) break;
    }
    { pg8::Gemm g{U + U_CQ, (const bf16*)(ws + WS_WQ) + (size_t)l * 512 * 256, D_INP, 256};
      pg8::EpiMlaQ E{Qb, rs, RT, QSCALE, SEQ}; const Frame F2 = reframe(F);
      pg8::gemm_phase<pg8::EpiMlaQ, pg8::StaticOrder, true>(F2.lds, F2.tid, g, S, E); }
    { pg8::Gemm g{U + U_CKV, (const bf16*)(ws + WS_WKV) + (size_t)l * 512 * 128, D_INP, 128};
      pg8::EpiMlaKV E{Kb, Vb, rs, SEQ}; const Frame F3 = reframe(F);
      pg8::gemm_phase<pg8::EpiMlaKV, pg8::StaticOrder, true>(F3.lds, F3.tid, g, S, E); }
    __syncthreads();
}
__device__ __forceinline__ void ph_mla_prep_naive(const Frame& F, const Args& a, int l) {
    unsigned char* const ws = WSP(F);
    LAS float* xq = (LAS float*)F.lds;
    LAS float* xkv = xq + 32 * 256;
    LAS float* kr = xkv + 32 * 128;
    LAS float* cs = kr + 32 * 32;
    LAS float* qr = cs + 32 * 32;
    const bf16* U = (const bf16*)(ws + WS_U);
    bf16* Qb = (bf16*)(ws + WS_Q); bf16* Kb = (bf16*)(ws + WS_K); bf16* Vb = (bf16*)(ws + WS_V);
    const float* qn = P(F, 5) + l * 256; const float* wuq = P(F, 6) + (size_t)l * 256 * 384;
    const float* kvn = P(F, 7) + l * 128; const float* wukv = P(F, 8) + (size_t)l * 128 * 512;
    const int tid = F.tid;
    for (int blk = F.vcu; blk < T / 32; blk += F.G) {
        const int row0 = blk * 32, b = row0 / SEQ, s0 = row0 % SEQ;
        { const int r = tid >> 4, sub = tid & 15; const bf16* ur = U + (size_t)(row0 + r) * D_INP;
          float q[16]; float ss = 0.f;
#pragma unroll
          for (int i = 0; i < 16; ++i) { q[i] = bf2f(ur[U_CQ + sub * 16 + i]); ss += q[i] * q[i]; }
          ss = sum16(ss); float rs = rsq_f(ss * (1.f / 256.f) + EPS);
#pragma unroll
          for (int i = 0; i < 16; ++i) xq[r * 256 + sub * 16 + i] = q[i] * rs * qn[sub * 16 + i];
          float kv[8]; ss = 0.f;
#pragma unroll
          for (int i = 0; i < 8; ++i) { kv[i] = bf2f(ur[U_CKV + sub * 8 + i]); ss += kv[i] * kv[i]; }
          ss = sum16(ss); rs = rsq_f(ss * (1.f / 128.f) + EPS);
#pragma unroll
          for (int i = 0; i < 8; ++i) xkv[r * 128 + sub * 8 + i] = kv[i] * rs * kvn[sub * 8 + i];
          kr[r * 32 + sub * 2] = bf2f(ur[U_KR + sub * 2]); kr[r * 32 + sub * 2 + 1] = bf2f(ur[U_KR + sub * 2 + 1]);
          const float inv_freq = sub == 0 ? 1.0f : sub == 1 ? 0.5623413251903491f : sub == 2 ? 0.31622776601683794f : sub == 3 ? 0.1778279410038923f : sub == 4 ? 0.1f : sub == 5 ? 0.05623413251903491f
              : sub == 6 ? 0.031622776601683794f : sub == 7 ? 0.01778279410038923f : sub == 8 ? 0.01f : sub == 9 ? 0.005623413251903491f : sub == 10 ? 0.0031622776601683794f : sub == 11 ? 0.001778279410038923f
              : sub == 12 ? 0.001f : sub == 13 ? 0.0005623413251903491f : sub == 14 ? 0.00031622776601683794f : 0.0001778279410038923f;
          const float ang = (float)(s0 + r) * inv_freq;
          double rev = (double)ang * 0.15915494309189535; rev -= floor(rev); const float rf = (float)rev;
          cs[r * 32 + sub * 2] = __builtin_amdgcn_cosf(rf); cs[r * 32 + sub * 2 + 1] = __builtin_amdgcn_sinf(rf); }
        __syncthreads();
        float acc[32];
        if (tid < 384) {
#pragma unroll
            for (int r = 0; r < 32; ++r) acc[r] = 0.f;
            for (int k = 0; k < 256; k += 4) { const float w0 = wuq[(size_t)k * 384 + tid], w1 = wuq[(size_t)(k + 1) * 384 + tid], w2 = wuq[(size_t)(k + 2) * 384 + tid], w3 = wuq[(size_t)(k + 3) * 384 + tid];
#pragma unroll
                for (int r = 0; r < 32; ++r) { const f32x4 x4 = *(const LAS f32x4*)(xq + r * 256 + k); acc[r] += x4.x * w0 + x4.y * w1 + x4.z * w2 + x4.w * w3; } }
            const int h = tid / 96, d = tid % 96;
            if (d < 64) {
#pragma unroll
                for (int r = 0; r < 32; ++r) Qb[((size_t)(b * 4 + h) * SEQ + s0 + r) * 96 + d] = (bf16)f2bf(acc[r] * QSCALE);
            } else {
#pragma unroll
                for (int r = 0; r < 32; ++r) qr[r * 128 + h * 32 + (d - 64)] = acc[r];
            }
        }
        {
#pragma unroll
            for (int r = 0; r < 32; ++r) acc[r] = 0.f;
            for (int k = 0; k < 128; k += 4) { const float w0 = wukv[(size_t)k * 512 + tid], w1 = wukv[(size_t)(k + 1) * 512 + tid], w2 = wukv[(size_t)(k + 2) * 512 + tid], w3 = wukv[(size_t)(k + 3) * 512 + tid];
#pragma unroll
                for (int r = 0; r < 32; ++r) { const f32x4 x4 = *(const LAS f32x4*)(xkv + r * 128 + k); acc[r] += x4.x * w0 + x4.y * w1 + x4.z * w2 + x4.w * w3; } }
            const int h = tid / 128, d = tid % 128;
            if (d < 64) {
#pragma unroll
                for (int r = 0; r < 32; ++r) Kb[((size_t)(b * 4 + h) * SEQ + s0 + r) * 96 + d] = (bf16)f2bf(acc[r]);
            } else {
#pragma unroll
                for (int r = 0; r < 32; ++r) Vb[((size_t)(b * 4 + h) * SEQ + s0 + r) * 64 + (d - 64)] = (bf16)f2bf(acc[r]);
            }
        }
        __syncthreads();
        for (int p = tid; p < 2048; p += NTHR) { const int r = p >> 6, h = (p >> 4) & 3, i = p & 15;
            const float t1 = qr[r * 128 + h * 32 + i], t2 = qr[r * 128 + h * 32 + i + 16], cc = cs[r * 32 + 2 * i], sn = cs[r * 32 + 2 * i + 1];
            bf16* qp = Qb + ((size_t)(b * 4 + h) * SEQ + s0 + r) * 96 + 64;
            qp[i] = (bf16)f2bf((t1 * cc - t2 * sn) * QSCALE); qp[i + 16] = (bf16)f2bf((t2 * cc + t1 * sn) * QSCALE); }
        { const int r = tid >> 4, i = tid & 15; const float t1 = kr[r * 32 + i], t2 = kr[r * 32 + i + 16], cc = cs[r * 32 + 2 * i], sn = cs[r * 32 + 2 * i + 1];
          const bf16 k1 = (bf16)f2bf(t1 * cc - t2 * sn), k2 = (bf16)f2bf(t2 * cc + t1 * sn);
#pragma unroll
          for (int h = 0; h < 4; ++h) { bf16* kp = Kb + ((size_t)(b * 4 + h) * SEQ + s0 + r) * 96 + 64; kp[i] = k1; kp[i + 16] = k2; } }
        __syncthreads();
    }
}
__device__ __forceinline__ f32x4 conv4_silu(const bf16* U, int m, int s, int ucol, int c, const float* cw  , const float* cb) {
    f32x4 acc = *(const f32x4*)(cb + c);
#pragma unroll
    for (int j = 0; j < 4; ++j) { const int ds = 3 - j; if (s - ds >= 0) { const v2u w = *(const v2u*)(U + (size_t)(m - ds) * D_INP + ucol + c);
            const f32x4 wv = *(const f32x4*)(cw + j * 768 + c);
            acc.x += wv.x * bflo(w.x); acc.y += wv.y * bfhi(w.x); acc.z += wv.z * bflo(w.y); acc.w += wv.w * bfhi(w.y); } }
    acc.x = silu_f(acc.x); acc.y = silu_f(acc.y); acc.z = silu_f(acc.z); acc.w = silu_f(acc.w);
    return acc;
}
constexpr size_t GF_UNIT = 40960;
__device__ __forceinline__ int gfrag_off(int row, int col) { return ((((row >> 4) * 2 + (col >> 5)) * 64 + (((col & 15) >> 2) * 16) + (row & 15)) * 8) + ((col & 31) >> 4) * 4 + (col & 3); }
__device__ __forceinline__ constexpr int gf_rp_r(int row) { return ((row >> 4) * 128 + (row & 15)) * 8; }
__device__ __forceinline__ constexpr int gf_lp_c(int col) { return ((col >> 5) * 64 + ((col & 15) >> 2) * 16) * 8 + ((col & 31) >> 4) * 4 + (col & 3); }
typedef float f32x16 __attribute__((ext_vector_type(16)));
__device__ __forceinline__ int crow16(int r, int hi) { return (r & 3) + 8 * (r >> 2) + 4 * hi; }

__device__ __forceinline__ void ph_gdn_prep(const Frame& F, const Args& a, int l) {
    unsigned char* const ws = WSP(F);
    const bf16* U = (const bf16*)(ws + WS_U); unsigned char* GF = ws + WS_GF; float* GL = (float*)(ws + WS_BG);
    const float* gcw = P(F, 15) + (size_t)l * 4 * 768; const float* gcb = P(F, 16) + l * 768; const float* gdtb = P(F, 17) + l * 4; const float* galog = P(F, 18) + l * 4;
    LAS unsigned char* Kc = F.lds + F.wave * 16384;
    LAS unsigned char* Qc = Kc + 8192;
    LAS float* sm = (LAS float*)(F.lds + RING_BYTES + 4096 + F.wave * 1024);
    LAS float* bet = sm; LAS float* gcs = sm + 64; LAS float* tmp = sm + 128;
    for (int unit = F.gw; unit < BATCH * 4 * (SEQ / 64); unit += F.NGW) {
        int lane = F.lane; asm volatile("" : "+v"(lane));
        const int r32 = lane & 31, hi = lane >> 5, fn = lane & 15, fg = lane >> 4;
        const int bh = unit / (SEQ / 64), c = unit % (SEQ / 64), b = bh >> 2, h = bh & 3; const int m0 = b * SEQ + c * 64;
        bf16* KCp = (bf16*)(GF + (size_t)unit * GF_UNIT);
        bf16* fragp = KCp + lane * 8; asm volatile("" : "+v"(fragp));
        { const bf16* ur = U + (size_t)(m0 + lane) * D_INP; const float bb = bf2f(ur[U_GB + h]), aa = bf2f(ur[U_GA + h]);
          const float g = -exp_f(galog[h]) * softplus_f(aa + gdtb[h]);
          bet[lane] = sigmoid_f(bb); tmp[lane] = g; LDS_WAIT(); asm volatile("" ::: "memory");
          float gc = 0.f;
#pragma unroll 8
          for (int j = 0; j < 64; ++j) { const float gj = tmp[j]; gc += (j <= lane) ? gj : 0.f; }
          gcs[lane] = gc; LDS_WAIT(); asm volatile("" ::: "memory"); }
        const float gc63 = gcs[63];
        if (lane == 0) GL[unit] = exp_f(gc63);
#define GDN_CONV(x, chan) do { const int ch_ = (chan); const float c0_ = gcw[ch_], c1_ = gcw[768 + ch_], c2_ = gcw[2 * 768 + ch_], c3_ = gcw[3 * 768 + ch_], cb_ = gcb[ch_]; \
            const bf16* ub_ = U + (size_t)m0 * D_INP + U_GQKV; float h0_ = 0.f, h1_ = 0.f, h2_ = 0.f;        \
            _Pragma("unroll") for (int i_ = 63; i_ >= 0; --i_) x[i_] = bf2f((ub_ + (size_t)i_ * D_INP)[ch_]);        \
            if (c > 0) { h2_ = bf2f((ub_ - 1 * D_INP)[ch_]); h1_ = bf2f((ub_ - 2 * D_INP)[ch_]); h0_ = bf2f((ub_ - 3 * D_INP)[ch_]); } \
            _Pragma("unroll") for (int i_ = 63; i_ >= 0; --i_) { const float a_ = (i_ >= 3) ? x[i_ - 3] : (i_ == 2 ? h2_ : i_ == 1 ? h1_ : h0_), b_ = (i_ >= 2) ? x[i_ - 2] : (i_ == 1 ? h2_ : h1_), d_ = (i_ >= 1) ? x[i_ - 1] : h2_; \
                x[i_] = silu_f(cb_ + c0_ * a_ + c1_ * b_ + c2_ * d_ + c3_ * x[i_]); } } while (0)
#define GDN_ROWNORM(img, scale, rn) do { const LAS unsigned char* rp_ = (img) + lane * 16; float ss_ = 0.f; bf16x8 v_[8]; \
            _Pragma("unroll") for (int ck_ = 0; ck_ < 8; ++ck_) { v_[ck_] = *(const LAS bf16x8*)(rp_ + ck_ * 1024); _Pragma("unroll") for (int e_ = 0; e_ < 8; ++e_) { const float t_ = bf2f((unsigned short)v_[ck_][e_]); ss_ += t_ * t_; } } \
            rn = rsq_f(ss_ + EPS) * (scale); \
            _Pragma("unroll") for (int ck_ = 0; ck_ < 8; ++ck_) { v4u o_; \
                o_.x = pk2(bf2f((unsigned short)v_[ck_][0]) * rn, bf2f((unsigned short)v_[ck_][1]) * rn); o_.y = pk2(bf2f((unsigned short)v_[ck_][2]) * rn, bf2f((unsigned short)v_[ck_][3]) * rn); \
                o_.z = pk2(bf2f((unsigned short)v_[ck_][4]) * rn, bf2f((unsigned short)v_[ck_][5]) * rn); o_.w = pk2(bf2f((unsigned short)v_[ck_][6]) * rn, bf2f((unsigned short)v_[ck_][7]) * rn); \
                *(LAS v4u*)((img) + lane * 16 + ck_ * 1024) = o_; } } while (0)
        { float x[64]; GDN_CONV(x, h * 64 + lane);
          { LAS bf16* qw = (LAS bf16*)(Qc + (lane >> 3) * 1024 + (lane & 7) * 2); asm volatile("" : "+v"(qw));
#pragma unroll
            for (int i = 0; i < 64; ++i) qw[i * 8] = (bf16)f2bf(x[i]); }
          LDS_WAIT(); asm volatile("" ::: "memory");
          float rn; GDN_ROWNORM(Qc, 0.125f, rn); (void)rn;
          LDS_WAIT(); asm volatile("" ::: "memory"); }
        const float gcj0 = gcs[r32], gcj1 = gcs[32 + r32];
#pragma unroll 1
        for (int half = 0; half < 2; ++half) {
            LAS float* gcs_l = gcs; LAS float* bet_l = bet; asm volatile("" : "+v"(gcs_l), "+v"(bet_l));
            float w[64];
            GDN_CONV(w, (1 + half) * 256 + h * 64 + lane);
            if (half == 0) {
                { LAS bf16* kw = (LAS bf16*)(Kc + (lane >> 3) * 1024 + (lane & 7) * 2); asm volatile("" : "+v"(kw));
#pragma unroll
                  for (int i = 0; i < 64; ++i) kw[i * 8] = (bf16)f2bf(w[i]); }
                LDS_WAIT(); asm volatile("" ::: "memory");
                float rnk; GDN_ROWNORM(Kc, 1.0f, rnk);
                tmp[lane] = bet_l[lane] * exp_f(gcs_l[lane]) * rnk;
                LDS_WAIT(); asm volatile("" ::: "memory");
                { LAS float* tp = tmp; asm volatile("" : "+v"(tp));
#pragma unroll
                  for (int i = 0; i < 64; ++i) w[i] *= tp[i]; }
            } else {
#pragma unroll
                for (int i = 0; i < 64; ++i) w[i] *= bet_l[i];
            }
            if (half == 0) {
                LDS_WAIT(); asm volatile("" ::: "memory");
                bf16* fqd = fragp + 4096; bf16* fkt = fragp + 12288;
#pragma unroll
                for (int f = 0; f < 8; ++f) { const int mt = f >> 1, ks = f & 1; asm volatile("" : "+v"(fqd), "+v"(fkt));
                    { const int row = 16 * mt + fn; const float e = exp_f(gcs_l[row]); const LAS unsigned char* qp = Qc + (4 * ks + (fg >> 1)) * 1024 + row * 16 + (fg & 1) * 8;
                      const v2u lo = *(const LAS v2u*)qp, hh2 = *(const LAS v2u*)(qp + 2048);
                      v4u o; o.x = pk2(bflo(lo.x) * e, bfhi(lo.x) * e); o.y = pk2(bflo(lo.y) * e, bfhi(lo.y) * e); o.z = pk2(bflo(hh2.x) * e, bfhi(hh2.x) * e); o.w = pk2(bflo(hh2.y) * e, bfhi(hh2.y) * e);
                      *(v4u*)fqd = o; fqd += 512; }
                    { const int ch = 16 * mt + fn, L0 = 32 * ks + 4 * fg; const LAS unsigned char* kp = Kc + (ch >> 3) * 1024 + (ch & 7) * 2 + L0 * 16;
                      const f32x4 ga = *(const LAS f32x4*)(gcs_l + L0), gb = *(const LAS f32x4*)(gcs_l + L0 + 16);
                      float v[8];
#pragma unroll
                      for (int j = 0; j < 4; ++j) { v[j] = bf2f(*(const LAS bf16*)(kp + j * 16)) * exp_f(gc63 - ga[j]); v[4 + j] = bf2f(*(const LAS bf16*)(kp + (16 + j) * 16)) * exp_f(gc63 - gb[j]); }
                      v4u o; o.x = pk2(v[0], v[1]); o.y = pk2(v[2], v[3]); o.z = pk2(v[4], v[5]); o.w = pk2(v[6], v[7]);
                      *(v4u*)fkt = o; fkt += 512; } }
#pragma unroll
                for (int which = 0; which < 2; ++which) {
                    const LAS unsigned char* Am = which ? Kc : Qc; f32x16 acc[3];
#pragma unroll
                    for (int t = 0; t < 3; ++t) { const int it = (t + 1) >> 1, jt = t >> 1; acc[t] = f32x16{};
#pragma unroll
                        for (int d0 = 0; d0 < 4; ++d0) { const bf16x8 af = *(const LAS bf16x8*)(Am + (2 * d0 + hi) * 1024 + (32 * it + r32) * 16), bfr = *(const LAS bf16x8*)(Kc + (2 * d0 + hi) * 1024 + (32 * jt + r32) * 16);
                            acc[t] = __builtin_amdgcn_mfma_f32_32x32x16_bf16(af, bfr, acc[t], 0, 0, 0); } }
                    LDS_WAIT(); asm volatile("" ::: "memory");
                    {
                        LAS bf16* dst = (LAS bf16*)(which ? Kc : Qc) + 4 * hi * 64 + r32; LAS float* gr = gcs_l + 4 * hi; LAS float* br = bet_l + 4 * hi; int dd = r32 - 4 * hi;
                        asm volatile("" : "+v"(dst), "+v"(gr), "+v"(br), "+v"(dd));
#pragma unroll
                        for (int t = 0; t < 3; ++t) { const int it = (t + 1) >> 1, jt = t >> 1; const float gcj = jt ? gcj1 : gcj0;
#pragma unroll
                            for (int r = 0; r < 16; ++r) { const int c0 = crow16(r, 0), i0 = 32 * it + c0; const float dec = exp_f(gr[i0] - gcj);
                                const bool keep = (it != jt) || (which ? (c0 > dd) : (c0 >= dd));
                                const float v = which ? br[i0] * acc[t][r] * dec : acc[t][r] * dec;
                                dst[i0 * 64 + 32 * jt] = (bf16)(keep ? f2bf(v) : 0u); } }
                        if (which == 0) {
#pragma unroll
                            for (int r = 0; r < 16; ++r) dst[crow16(r, 0) * 64 + 32] = (bf16)0; }
                    }
                }
                LDS_WAIT(); asm volatile("" ::: "memory");
                { bf16* fqk = fragp + 8192;
#pragma unroll
                for (int f = 0; f < 8; ++f) { const int mt = f >> 1, ks = f & 1; const LAS unsigned char* sp = Qc + ((16 * mt + fn) * 64 + 32 * ks + 4 * fg) * 2; asm volatile("" : "+v"(fqk));
                    const v2u lo = *(const LAS v2u*)sp, hh2 = *(const LAS v2u*)(sp + 32); v4u o; o.x = lo.x; o.y = lo.y; o.z = hh2.x; o.w = hh2.y; *(v4u*)fqk = o; fqk += 512; } }
                LDS_WAIT(); asm volatile("" ::: "memory");
            }
            { unsigned wp[32];
#pragma unroll
              for (int i = 1; i < 64; ++i) { float s0 = 0.f, s1 = 0.f;
                if ((i & 1) == 1) wp[i >> 1] = pk2(w[i - 1], 0.f);
#pragma unroll
                for (int j = 0; j < i; j += 4) { const v2u a2 = *(const LAS v2u*)(Kc + (i * 64 + j) * 2); float& s = ((j >> 2) & 1) ? s1 : s0;
                    const unsigned ax = a2.x, ay = a2.y;
                    s = __builtin_amdgcn_fdot2_f32_bf16(__builtin_bit_cast(pk_b2v, ax), __builtin_bit_cast(pk_b2v, wp[j >> 1]), s, false);
                    if (j + 2 < i) s = __builtin_amdgcn_fdot2_f32_bf16(__builtin_bit_cast(pk_b2v, ay), __builtin_bit_cast(pk_b2v, wp[(j >> 1) + 1]), s, false); }
                w[i] -= s0 + s1;
                if ((i & 1) == 1) wp[i >> 1] = pk2(w[i - 1], w[i]);
                if ((i & 7) == 7) __builtin_amdgcn_sched_barrier(0); } }
            { LAS bf16* stw = (LAS bf16*)Qc + lane; asm volatile("" : "+v"(stw));
#pragma unroll
              for (int i = 0; i < 64; ++i) stw[i * 64] = (bf16)f2bf(half == 0 ? -w[i] : w[i]); }
            LDS_WAIT(); asm volatile("" ::: "memory");
            if (half == 0) {
                bf16* fkc = fragp;
#pragma unroll
                for (int f = 0; f < 8; ++f) { const int mt = f >> 1, ks = f & 1; const LAS unsigned char* sp = Qc + ((16 * mt + fn) * 64 + 32 * ks + 4 * fg) * 2; asm volatile("" : "+v"(fkc));
                    const v2u lo = *(const LAS v2u*)sp, hh2 = *(const LAS v2u*)(sp + 32); v4u o; o.x = lo.x; o.y = lo.y; o.z = hh2.x; o.w = hh2.y; *(v4u*)fkc = o; fkc += 512; }
            } else {
                bf16* uvp = KCp + 16384 + lane * 4; asm volatile("" : "+v"(uvp));
#pragma unroll
                for (int q = 0; q < 16; ++q) { const int vs = q >> 2, mt = q & 3; const LAS bf16* sp = (const LAS bf16*)Qc + (16 * mt + 4 * fg) * 64 + 16 * vs + fn; asm volatile("" : "+v"(uvp));
                    v2u o; o.x = (unsigned)sp[0] | ((unsigned)sp[64] << 16); o.y = (unsigned)sp[128] | ((unsigned)sp[192] << 16); *(v2u*)uvp = o; uvp += 256; }
            }
            LDS_WAIT(); asm volatile("" ::: "memory");
        }
    }
}
__device__ __forceinline__ void gdn_chain(const Frame& F, int bh) {
    typedef float f4 __attribute__((ext_vector_type(4)));
    unsigned char* const ws = WSP(F);
    const unsigned char* GF = ws + WS_GF; const float* GL = (const float*)(ws + WS_BG); float* OR = (float*)(ws + WS_OR);
    const int lane = F.lane, n = lane & 15, g = lane >> 4, b = bh >> 2, h = bh & 3, vs = F.wave & 3; const bool comp = F.wave < 4;
    constexpr int NC = SEQ / 64, SLOT = 40960;
    const char* ub = (const char*)GF + (size_t)bh * NC * GF_UNIT + (size_t)F.wave * 5120;
    const unsigned lds0 = (unsigned)(uintptr_t)F.lds, ldw = lds0 + F.wave * 5120;
#define GDN_DMA(cc) do { const int cu_ = (cc) < NC ? (cc) : NC - 1; const unsigned sl_ = ldw + ((cc) % 3) * SLOT; const char* src_ = ub + (size_t)cu_ * GF_UNIT; \
        _Pragma("unroll") for (int i_ = 0; i_ < 5; ++i_) pg8::glds_sv_t<0>(src_ + i_ * 1024, (unsigned)lane * 16u, (unsigned)__builtin_amdgcn_readfirstlane(sl_ + i_ * 1024)); } while (0)
    LAS float* gls = (LAS float*)(F.lds + 3 * SLOT);
    if (F.tid < NC) gls[F.tid] = GL[bh * NC + F.tid];
    asm volatile("s_waitcnt vmcnt(0) lgkmcnt(0)\n\ts_barrier" ::: "memory");
    GDN_DMA(0); GDN_DMA(1);
    asm volatile("s_waitcnt vmcnt(5)" ::: "memory");
    f4 S[4];
#pragma unroll
    for (int mt = 0; mt < 4; ++mt) S[mt] = (f4){0.f, 0.f, 0.f, 0.f};
    for (int c = 0; c < NC; ++c) {
        if (comp) asm volatile("s_waitcnt vmcnt(21) lgkmcnt(0)\n\ts_barrier" ::: "memory"); else asm volatile("s_waitcnt vmcnt(5) lgkmcnt(0)\n\ts_barrier" ::: "memory");
        GDN_DMA(c + 2);
        if (comp) {
            const LAS unsigned char* sl = F.lds + (c % 3) * SLOT + lane * 16;
            const float gl = gls[c];
#define GDN_FR(moff, f) (*(const LAS bf16x8*)(sl + (moff) + (f) * 1024))
            bf16x8 sf[2], vf[2]; f4 vn[4], o[4];
#pragma unroll
            for (int ks = 0; ks < 2; ++ks) { v4u w; w.x = pk2(S[2 * ks][0], S[2 * ks][1]); w.y = pk2(S[2 * ks][2], S[2 * ks][3]); w.z = pk2(S[2 * ks + 1][0], S[2 * ks + 1][1]); w.w = pk2(S[2 * ks + 1][2], S[2 * ks + 1][3]); sf[ks] = __builtin_bit_cast(bf16x8, w); }
#pragma unroll
            for (int mt = 0; mt < 4; ++mt) { const v2u uv = *(const LAS v2u*)(F.lds + (c % 3) * SLOT + 32768 + ((vs * 4 + mt) * 64 + lane) * 8);
                vn[mt] = (f4){bflo(uv.x), bfhi(uv.x), bflo(uv.y), bfhi(uv.y)}; o[mt] = (f4){0.f, 0.f, 0.f, 0.f}; }
            bf16x8 fa[8], fb[8];
#pragma unroll
            for (int f = 0; f < 8; ++f) fa[f] = GDN_FR(0, f);
#pragma unroll
            for (int f = 0; f < 8; ++f) fb[f] = GDN_FR(8192, f);
#pragma unroll
            for (int mt = 0; mt < 4; ++mt)
#pragma unroll
                for (int ks = 0; ks < 2; ++ks) vn[mt] = __builtin_amdgcn_mfma_f32_16x16x32_bf16(fa[mt * 2 + ks], sf[ks], vn[mt], 0, 0, 0);
#pragma unroll
            for (int f = 0; f < 8; ++f) fa[f] = GDN_FR(24576, f);
#pragma unroll
            for (int mt = 0; mt < 4; ++mt)
#pragma unroll
                for (int ks = 0; ks < 2; ++ks) o[mt] = __builtin_amdgcn_mfma_f32_16x16x32_bf16(fb[mt * 2 + ks], sf[ks], o[mt], 0, 0, 0);
#pragma unroll
            for (int f = 0; f < 8; ++f) fb[f] = GDN_FR(16384, f);
#pragma unroll
            for (int ks = 0; ks < 2; ++ks) { v4u w; w.x = pk2(vn[2 * ks][0], vn[2 * ks][1]); w.y = pk2(vn[2 * ks][2], vn[2 * ks][3]); w.z = pk2(vn[2 * ks + 1][0], vn[2 * ks + 1][1]); w.w = pk2(vn[2 * ks + 1][2], vn[2 * ks + 1][3]); vf[ks] = __builtin_bit_cast(bf16x8, w); }
#pragma unroll
            for (int mt = 0; mt < 4; ++mt) { S[mt] = S[mt] * gl;
#pragma unroll
                for (int ks = 0; ks < 2; ++ks) S[mt] = __builtin_amdgcn_mfma_f32_16x16x32_bf16(fa[mt * 2 + ks], vf[ks], S[mt], 0, 0, 0); }
#pragma unroll
            for (int mt = 0; mt < 4; ++mt)
#pragma unroll
                for (int ks = 0; ks < 2; ++ks) o[mt] = __builtin_amdgcn_mfma_f32_16x16x32_bf16(fb[mt * 2 + ks], vf[ks], o[mt], 0, 0, 0);
            { float* op = OR + ((size_t)b * SEQ + c * 64 + 4 * g) * 256 + h * 64 + vs * 16 + n;
#pragma unroll
              for (int mt = 0; mt < 4; ++mt)
#pragma unroll
                  for (int i = 0; i < 4; ++i) op[(size_t)(mt * 16 + i) * 256] = o[mt][i]; }
#undef GDN_FR
        }
    }
    asm volatile("s_waitcnt vmcnt(0) lgkmcnt(0)\n\ts_barrier" ::: "memory");
#undef GDN_DMA
}
__device__ __forceinline__ void ph_ssd_chunk(const Frame& F, const Args& a, int l) {
    unsigned char* const ws = WSP(F);
    const bf16* U = (const bf16*)(ws + WS_U); float* Y = (float*)(ws + WS_H); float* ST = (float*)(ws + WS_SST); float* EA = (float*)(ws + WS_DT); bf16* CS = (bf16*)(ws + WS_CS);
    const float* cw = P(F, 9) + (size_t)l * 4 * 768; const float* cb = P(F, 10) + l * 768; const float* dtb = P(F, 11) + l * 8;
    LAS float* Bs = (LAS float*)F.lds;
    LAS float* Cs = Bs + 2 * 128 * 64;
    LAS float* dts = (LAS float*)(F.lds + RING_BYTES + 4096);
    const int lane = F.lane, h = F.wave;
    for (int unit = F.vcu; unit < BATCH * (SEQ / 128); unit += F.G) {
        const int b = unit / (SEQ / 128), c = unit % (SEQ / 128); const int m0 = b * SEQ + c * 128, s0 = c * 128;
        for (int qd = F.tid; qd < 128 * 64; qd += NTHR) { const int r = qd >> 6, cc = (qd & 63) * 4;
            const f32x4 v = conv4_silu(U, m0 + r, s0 + r, U_XBC, 512 + cc, cw, cb);
            const int which = cc >> 7, g = (cc >> 6) & 1, n = cc & 63;
            *(LAS f32x4*)((which ? Cs : Bs) + (g * 128 + r) * 64 + n) = v;
            if (which) { v2u w; w.x = pk2(v.x, v.y); w.y = pk2(v.z, v.w); *(v2u*)(CS + (size_t)(m0 + r) * 128 + (cc - 128)) = w; } }
        for (int i = F.tid; i < 8 * 128; i += NTHR) { const int hh = i >> 7, r = i & 127; dts[i] = softplus_f(bf2f(U[(size_t)(m0 + r) * D_INP + U_DT + hh]) + dtb[hh]); }
        __syncthreads();
        {
            const int ch = h * 64 + lane, g = h >> 2; const float A = -exp_f(P(F, 12)[l * 8 + h]), Dh = P(F, 13)[l * 8 + h];
            const float w0 = cw[ch], w1 = cw[768 + ch], w2 = cw[2 * 768 + ch], w3 = cw[3 * 768 + ch], bb = cb[ch];
            const bf16* up = U + (size_t)m0 * D_INP + U_XBC + ch;
            float x0 = 0.f, x1 = 0.f, x2 = 0.f;
            if (s0 > 0) { x0 = bf2f(up[-3 * D_INP]); x1 = bf2f(up[-2 * D_INP]); x2 = bf2f(up[-1 * D_INP]); }
            float hn[64];
#pragma unroll
            for (int n = 0; n < 64; ++n) hn[n] = 0.f;
            float acum = 0.f;
            const LAS float* Bg = Bs + g * 128 * 64; const LAS float* Cg = Cs + g * 128 * 64;
            for (int lb = 0; lb < 128; lb += 16) {
                float xr[16];
#pragma unroll
                for (int i = 0; i < 16; ++i) xr[i] = bf2f(up[(size_t)(lb + i) * D_INP]);
#pragma unroll
                for (int i = 0; i < 16; ++i) { const float xin = xr[i]; const int r = lb + i;
                    const float cv = bb + w0 * x0 + w1 * x1 + w2 * x2 + w3 * xin; x0 = x1; x1 = x2; x2 = xin;
                    const float xs = silu_f(cv), dtv = dts[h * 128 + r], da = dtv * A, dA = exp_f(da), coef = dtv * xs; acum += da; float y = 0.f;
#pragma unroll
                    for (int n = 0; n < 64; n += 4) { const f32x4 b4 = *(const LAS f32x4*)(Bg + r * 64 + n), c4 = *(const LAS f32x4*)(Cg + r * 64 + n);
                        hn[n] = hn[n] * dA + coef * b4.x; y += c4.x * hn[n]; hn[n + 1] = hn[n + 1] * dA + coef * b4.y; y += c4.y * hn[n + 1];
                        hn[n + 2] = hn[n + 2] * dA + coef * b4.z; y += c4.z * hn[n + 2]; hn[n + 3] = hn[n + 3] * dA + coef * b4.w; y += c4.w * hn[n + 3]; }
                    Y[(size_t)(m0 + r) * 512 + ch] = y + Dh * xs;
                    if (lane == 0) EA[(size_t)(m0 + r) * 8 + h] = exp_f(acum); }
            }
            float* sp = ST + ((size_t)(unit * 8 + h) * 64 + lane) * 64;
#pragma unroll
            for (int n = 0; n < 64; n += 4) *(f32x4*)(sp + n) = (f32x4){hn[n], hn[n + 1], hn[n + 2], hn[n + 3]};
        }
        __syncthreads();
    }
}
__device__ __forceinline__ void ph_ssd_scan(const Frame& F, const Args& a, bool dummy = false) {
    unsigned char* const ws = WSP(F);
    float* ST = (float*)(ws + (dummy ? WS_H : WS_SST)); const float* EA = (const float*)(ws + WS_DT);
    for (int id = F.vcu * NTHR + F.tid; id < BATCH * 8 * 4096; id += F.G * NTHR) {
        const int b = id / (8 * 4096), r = id % (8 * 4096), h = r / 4096, e = r % 4096;
        float* sp = ST + ((size_t)(b * 128) * 8 + h) * 4096 + e; const float* ep = EA + ((size_t)b * SEQ + 127) * 8 + h;
        float hp = 0.f;
        for (int c0 = 0; c0 < 128; c0 += 8) { float st[8], dc[8];
#pragma unroll
            for (int i = 0; i < 8; ++i) { st[i] = sp[(size_t)(c0 + i) * 8 * 4096]; dc[i] = ep[(size_t)(c0 + i) * 128 * 8]; }
#pragma unroll
            for (int i = 0; i < 8; ++i) { sp[(size_t)(c0 + i) * 8 * 4096] = hp; hp = hp * dc[i] + st[i]; } }
    }
}
__device__ __forceinline__ void ph_ssd_out(const Frame& F, const Args& a, int l) {
    unsigned char* const ws = WSP(F);
    const bf16* U = (const bf16*)(ws + WS_U); float* Y = (float*)(ws + WS_H); const float* ST = (const float*)(ws + WS_SST); const float* EA = (const float*)(ws + WS_DT);
    const bf16* CS = (const bf16*)(ws + WS_CS); bf16* O = (bf16*)(ws + WS_O); const float* nw = P(F, 14) + l * 512;
    LAS float* Cs = (LAS float*)F.lds;
    LAS float* ssq = Cs + 2 * 128 * 64;
    const int lane = F.lane, h = F.wave;
    for (int unit = F.vcu; unit < BATCH * (SEQ / 128); unit += F.G) {
        const int b = unit / (SEQ / 128), c = unit % (SEQ / 128); const int m0 = b * SEQ + c * 128;
        for (int qd = F.tid; qd < 128 * 32; qd += NTHR) { const int r = qd >> 5, cc = (qd & 31) * 4; const v2u w = *(const v2u*)(CS + (size_t)(m0 + r) * 128 + cc);
            *(LAS f32x4*)(Cs + ((cc >> 6) * 128 + r) * 64 + (cc & 63)) = (f32x4){bflo(w.x), bfhi(w.x), bflo(w.y), bfhi(w.y)}; }
        if (F.tid < 256) ssq[F.tid] = 0.f;
        __syncthreads();
        {
            const int ch = h * 64 + lane, g = h >> 2; float pv[64];
            const float* sp = ST + ((size_t)(unit * 8 + h) * 64 + lane) * 64;
#pragma unroll
            for (int n = 0; n < 64; n += 4) { const f32x4 v = *(const f32x4*)(sp + n); pv[n] = v.x; pv[n + 1] = v.y; pv[n + 2] = v.z; pv[n + 3] = v.w; }
            const LAS float* Cg = Cs + g * 128 * 64;
            for (int lb = 0; lb < 128; lb += 8) { float yd[8], zz[8], ea[8];
#pragma unroll
                for (int i = 0; i < 8; ++i) { const size_t m = (size_t)(m0 + lb + i); yd[i] = Y[m * 512 + ch]; zz[i] = bf2f(U[m * D_INP + U_Z + ch]); ea[i] = EA[m * 8 + h]; }
#pragma unroll
                for (int i = 0; i < 8; ++i) { const int r = lb + i; float yo = 0.f;
#pragma unroll
                    for (int n = 0; n < 64; n += 4) { const f32x4 c4 = *(const LAS f32x4*)(Cg + r * 64 + n); yo += c4.x * pv[n] + c4.y * pv[n + 1] + c4.z * pv[n + 2] + c4.w * pv[n + 3]; }
                    const float y = (yd[i] + ea[i] * yo) * silu_f(zz[i]);
                    Y[(size_t)(m0 + r) * 512 + ch] = y;
                    const float s2 = wave_sum(y * y);
                    if (lane == 0) atomicAdd((float*)(ssq + g * 128 + r), s2); }
            }
        }
        __syncthreads();
        for (int qd = F.tid; qd < 128 * 128; qd += NTHR) { const int r = qd >> 7, cc = (qd & 127) * 4; const size_t m = (size_t)(m0 + r);
            f32x4 y = *(const f32x4*)(Y + m * 512 + cc); const float rs = rsq_f(ssq[(cc >> 8) * 128 + r] * (1.f / 256.f) + EPS); const f32x4 n4 = *(const f32x4*)(nw + cc);
            y = y * rs * n4; v2u w; w.x = pk2(y.x, y.y); w.y = pk2(y.z, y.w); *(v2u*)(O + m * DM + 256 + cc) = w; }
        __syncthreads();
    }
}

#define CONV_ROWS_BEGIN(NR_, U_, m0_, s0_, ch_, cw_, cb_, r0_, r1_) { \
    const f32x4 w0_ = *(const f32x4*)((cw_) + (ch_)), w1_ = *(const f32x4*)((cw_) + 768 + (ch_)), w2_ = *(const f32x4*)((cw_) + 2 * 768 + (ch_)), w3_ = *(const f32x4*)((cw_) + 3 * 768 + (ch_)), bb_ = *(const f32x4*)((cb_) + (ch_)); \
    const bf16* up_ = (U_) + (size_t)((m0_) + (r0_)) * D_INP + U_XBC + (ch_); v2u raw_[NR_ + 3]; \
    _Pragma("unroll") for (int k_ = 0; k_ < NR_ + 3; ++k_) { const int rr_ = (r0_) - 3 + k_; raw_[k_] = ((s0_) + rr_ >= 0 && rr_ < (r1_)) ? *(const v2u*)(up_ + (long)(k_ - 3) * D_INP) : (v2u){0u, 0u}; }     \
    f32x4 x0_ = {bflo(raw_[0].x), bfhi(raw_[0].x), bflo(raw_[0].y), bfhi(raw_[0].y)}, x1_ = {bflo(raw_[1].x), bfhi(raw_[1].x), bflo(raw_[1].y), bfhi(raw_[1].y)}, x2_ = {bflo(raw_[2].x), bfhi(raw_[2].x), bflo(raw_[2].y), bfhi(raw_[2].y)}; \
    _Pragma("unroll") for (int k_ = 0; k_ < NR_; ++k_) { const int r = (r0_) + k_; if (r < (r1_)) { const v2u w_ = raw_[k_ + 3]; const f32x4 xin_ = {bflo(w_.x), bfhi(w_.x), bflo(w_.y), bfhi(w_.y)}; \
        f32x4 v = bb_ + w0_ * x0_ + w1_ * x1_ + w2_ * x2_ + w3_ * xin_; x0_ = x1_; x1_ = x2_; x2_ = xin_; v.x = silu_f(v.x); v.y = silu_f(v.y); v.z = silu_f(v.z); v.w = silu_f(v.w);
#define CONV_ROWS_END } } }
#define CONV_ROWS_LOAD(NR_, raw_, U_, m0_, s0_, ch_, r0_, r1_) { const bf16* up_ = (U_) + (size_t)((m0_) + (r0_)) * D_INP + U_XBC + (ch_); \
    _Pragma("unroll") for (int k_ = 0; k_ < NR_ + 3; ++k_) { const int rr_ = (r0_) - 3 + k_; raw_[k_] = ((s0_) + rr_ >= 0 && rr_ < (r1_)) ? *(const v2u*)(up_ + (long)(k_ - 3) * D_INP) : (v2u){0u, 0u}; } }
#define CONV_ROWS_COMPUTE_BEGIN(NR_, raw_, ch_, cw_, cb_, r0_, r1_) { \
    const f32x4 w0_ = *(const f32x4*)((cw_) + (ch_)), w1_ = *(const f32x4*)((cw_) + 768 + (ch_)), w2_ = *(const f32x4*)((cw_) + 2 * 768 + (ch_)), w3_ = *(const f32x4*)((cw_) + 3 * 768 + (ch_)), bb_ = *(const f32x4*)((cb_) + (ch_)); \
    f32x4 x0_ = {bflo(raw_[0].x), bfhi(raw_[0].x), bflo(raw_[0].y), bfhi(raw_[0].y)}, x1_ = {bflo(raw_[1].x), bfhi(raw_[1].x), bflo(raw_[1].y), bfhi(raw_[1].y)}, x2_ = {bflo(raw_[2].x), bfhi(raw_[2].x), bflo(raw_[2].y), bfhi(raw_[2].y)}; \
    _Pragma("unroll") for (int k_ = 0; k_ < NR_; ++k_) { const int r = (r0_) + k_; if (r < (r1_)) { const v2u w_ = raw_[k_ + 3]; const f32x4 xin_ = {bflo(w_.x), bfhi(w_.x), bflo(w_.y), bfhi(w_.y)}; \
        f32x4 v = bb_ + w0_ * x0_ + w1_ * x1_ + w2_ * x2_ + w3_ * xin_; x0_ = x1_; x1_ = x2_; x2_ = xin_; v.x = silu_f(v.x); v.y = silu_f(v.y); v.z = silu_f(v.z); v.w = silu_f(v.w);
namespace ssdm {
typedef __attribute__((address_space(3))) const char* lcp;
typedef float f32x16 __attribute__((ext_vector_type(16)));
typedef short s16x4 __attribute__((ext_vector_type(4)));
constexpr int XI_OFF = 0, BK_OFF = 65536, CK_OFF = 81920, SM_OFF = 98304, PV_OFF = 106496, PV3_OFF = 132096;
constexpr int XI_OFF_UNUSED = 0;
__device__ __forceinline__ int crow(int r, int hi) { return (r & 3) + 8 * (r >> 2) + 4 * hi; }
__device__ __forceinline__ s16x4 vtr(lcp p) { return __builtin_bit_cast(s16x4, __builtin_amdgcn_ds_read_tr16_b64_v4i16((__attribute__((address_space(3))) attn_body::v4i16_t*)p)); }
__device__ __forceinline__ bf16x8 join(s16x4 lo, s16x4 hi) { return (bf16x8){lo[0], lo[1], lo[2], lo[3], hi[0], hi[1], hi[2], hi[3]}; }
template <int CTRL, int RMASK> __device__ __forceinline__ float dpp0f(float v) { return __builtin_bit_cast(float, __builtin_amdgcn_update_dpp(0, __builtin_bit_cast(int, v), CTRL, RMASK, 0xf, false)); }
__device__ __forceinline__ float wave_incl_scan(float v) {
    v += dpp0f<0x111, 0xf>(v); v += dpp0f<0x112, 0xf>(v); v += dpp0f<0x114, 0xf>(v); v += dpp0f<0x118, 0xf>(v);
    v += dpp0f<0x142, 0xa>(v); v += dpp0f<0x143, 0xc>(v); return v; }
__device__ __forceinline__ void dt_cumsum(const Frame& F, const bf16* U, int m0, int g, const float* dtb, const float* alog, LAS float* dts, LAS float* acs) {
    const int hh = F.tid >> 7, r = F.tid & 127, h = g * 4 + hh;
    const float dtv = softplus_f(bf2f(U[(size_t)(m0 + r) * D_INP + U_DT + h]) + dtb[h]); const float x = dtv * -exp_f(alog[h]);
    LAS float* tot = acs + 512 + 128;
    float sc = wave_incl_scan(x);
    if ((F.wave & 1) == 0 && F.lane == 63) tot[hh] = sc;
    dts[F.tid] = dtv;
    __syncthreads();
    if (F.wave & 1) sc += tot[hh];
    acs[F.tid] = sc;
    __syncthreads();
}
}

__device__ __forceinline__ void ph_ssd_states(const Frame& F, const Args& a, int l) {
    using namespace ssdm;
    unsigned char* const ws = WSP(F);
    const bf16* U = (const bf16*)(ws + WS_U); float* ST = (float*)(ws + WS_SST); float* EA = (float*)(ws + WS_DT);
    const float* cw = P(F, 9) + (size_t)l * 4 * 768; const float* cb = P(F, 10) + l * 768; const float* dtb = P(F, 11) + l * 8; const float* alog = P(F, 12) + l * 8;
    LAS unsigned char* XI = F.lds + XI_OFF; LAS unsigned char* BT = F.lds + BK_OFF; LAS float* dts = (LAS float*)(F.lds + SM_OFF); LAS float* acs = dts + 512;
    const int lane = F.lane, r32 = lane & 31, hi = lane >> 5, hh = F.wave & 3, ph = F.wave >> 2;
    for (int unit = F.vcu; unit < BATCH * (SEQ / 128) * 2; unit += F.G) {
        const int g = unit & 1, bc = unit >> 1, b = bc / (SEQ / 128), c = bc % (SEQ / 128); const int m0 = b * SEQ + c * 128, s0 = c * 128;
        dt_cumsum(F, U, m0, g, dtb, alog, dts, acs);
        if (F.tid < 480) { const int j = F.tid % 80, rg = F.tid / 80, r0 = rg * 22, r1 = (r0 + 22 < 128) ? r0 + 22 : 128;
            if (j < 64) { const int cc = j * 4, hx = cc >> 6; const float aend = acs[hx * 128 + 127]; LAS unsigned char* xp = XI + (cc >> 5) * 8192 + (cc & 31) * 2;
                CONV_ROWS_BEGIN(22, U, m0, s0, g * 256 + cc, cw, cb, r0, r1)
                    v = v * (dts[hx * 128 + r] * exp_f(aend - acs[hx * 128 + r])); v2u pk; pk.x = pk2(v.x, v.y); pk.y = pk2(v.z, v.w); *(LAS v2u*)(xp + r * 64) = pk;
                CONV_ROWS_END }
            else { const int n = (j - 64) * 4; LAS unsigned char* bp = BT + (n >> 5) * 8192 + (n & 31) * 2;
                CONV_ROWS_BEGIN(22, U, m0, s0, 512 + g * 64 + n, cw, cb, r0, r1)
                    v2u pk; pk.x = pk2(v.x, v.y); pk.y = pk2(v.z, v.w); *(LAS v2u*)(bp + r * 64) = pk;
                CONV_ROWS_END } }
        if (F.tid < 4) EA[(size_t)(m0 + 127) * 8 + g * 4 + F.tid] = exp_f(acs[F.tid * 128 + 127]);
        __syncthreads();
        {
            f32x16 acc[2]; acc[0] = f32x16{}; acc[1] = f32x16{};
            const int trl = (8 * hi + ((lane & 15) >> 2)) * 64 + ((lane >> 4) & 1) * 32 + (lane & 3) * 8;
            const lcp xa = (lcp)(XI + (hh * 2 + ph) * 8192 + trl); const lcp b0p = (lcp)(BT + trl), b1p = (lcp)(BT + 8192 + trl);
#pragma unroll
            for (int ks = 0; ks < 8; ++ks) { const bf16x8 af = join(vtr(xa + ks * 1024), vtr(xa + ks * 1024 + 256)), bf0 = join(vtr(b0p + ks * 1024), vtr(b0p + ks * 1024 + 256)), bf1 = join(vtr(b1p + ks * 1024), vtr(b1p + ks * 1024 + 256));
                acc[0] = __builtin_amdgcn_mfma_f32_32x32x16_bf16(af, bf0, acc[0], 0, 0, 0); acc[1] = __builtin_amdgcn_mfma_f32_32x32x16_bf16(af, bf1, acc[1], 0, 0, 0); }
            float* sp = ST + ((size_t)(bc * 8 + g * 4 + hh) * 64 + 32 * ph) * 64 + r32;
#pragma unroll
            for (int nt = 0; nt < 2; ++nt)
#pragma unroll
                for (int r = 0; r < 16; ++r) sp[crow(r, hi) * 64 + 32 * nt] = acc[nt][r];
        }
        __syncthreads();
    }
}
__device__ __forceinline__ void ph_ssd_y(const Frame& F, const Args& a, int l) {
    using namespace ssdm;
    unsigned char* const ws = WSP(F);
    const bf16* U = (const bf16*)(ws + WS_U); const float* ST = (const float*)(ws + WS_SST); bf16* O = (bf16*)(ws + WS_O);
    const float* cw = P(F, 9) + (size_t)l * 4 * 768; const float* cb = P(F, 10) + l * 768; const float* dtb = P(F, 11) + l * 8; const float* alog = P(F, 12) + l * 8; const float* nw = P(F, 14) + l * 512;
    LAS unsigned char* XI = F.lds + XI_OFF; LAS unsigned char* BK = F.lds + BK_OFF; LAS unsigned char* CK = F.lds + CK_OFF;
    LAS float* dts = (LAS float*)(F.lds + SM_OFF); LAS float* acs = dts + 512; LAS float* ssq = acs + 512;
    const int lane = F.lane, r32 = lane & 31, hi = lane >> 5, hh = F.wave & 3, half = F.wave >> 2;
    for (int unit = F.vcu; unit < BATCH * (SEQ / 128) * 2; unit += F.G) {
        const int g = unit & 1, bc = unit >> 1, b = bc / (SEQ / 128), c = bc % (SEQ / 128); const int m0 = b * SEQ + c * 128, s0 = c * 128, h = g * 4 + hh;
        f32x4 pv[8];
        { const float* pp = ST + ((size_t)(bc * 8 + g * 4 + (F.tid >> 7)) * 64 + ((F.tid & 127) >> 1)) * 64 + 32 * (F.tid & 1);
#pragma unroll
          for (int q = 0; q < 8; ++q) pv[q] = *(const f32x4*)(pp + 4 * q); }
        dt_cumsum(F, U, m0, g, dtb, alog, dts, acs);
        if (F.tid < 128) ssq[F.tid] = 0.f;
        if (F.tid < 480) { const int j = F.tid % 96, rg = F.tid / 96, r0 = rg * 26, r1 = (r0 + 26 < 128) ? r0 + 26 : 128;
            if (j < 64) { const int cc = j * 4; LAS unsigned char* xp = XI + (cc >> 5) * 8192 + (cc & 31) * 2;
                CONV_ROWS_BEGIN(26, U, m0, s0, g * 256 + cc, cw, cb, r0, r1)
                    v2u pk; pk.x = pk2(v.x, v.y); pk.y = pk2(v.z, v.w); *(LAS v2u*)(xp + r * 64) = pk;
                CONV_ROWS_END }
            else { const int n = ((j < 80) ? (j - 64) : (j - 80)) * 4; LAS unsigned char* kp = ((j < 80) ? BK : CK) + (n >> 3) * 2048 + (n & 7) * 2;
                CONV_ROWS_BEGIN(26, U, m0, s0, ((j < 80) ? 512 : 640) + g * 64 + n, cw, cb, r0, r1)
                    v2u pk; pk.x = pk2(v.x, v.y); pk.y = pk2(v.z, v.w); *(LAS v2u*)(kp + r * 16) = pk;
                CONV_ROWS_END } }
        { const int hq = F.tid >> 7, p = (F.tid & 127) >> 1, nh = F.tid & 1;
          LAS unsigned char* pd = F.lds + ((hq < 3) ? PV_OFF + hq * 8192 : PV3_OFF) + ((4 * nh) * 64 + p) * 16;
#pragma unroll
          for (int q = 0; q < 4; ++q) { v4u o; o.x = pk2(pv[2 * q].x, pv[2 * q].y); o.y = pk2(pv[2 * q].z, pv[2 * q].w); o.z = pk2(pv[2 * q + 1].x, pv[2 * q + 1].y); o.w = pk2(pv[2 * q + 1].z, pv[2 * q + 1].w);
              *(LAS v4u*)(pd + q * 1024) = o; } }
        __syncthreads();
        const float Dh = P(F, 13)[l * 8 + h];
        f32x16 yk[2][2];
        const int trv = (4 * hi + ((lane & 15) >> 2)) * 64 + ((lane >> 4) & 1) * 32 + (lane & 3) * 8;
#pragma unroll
        for (int li = 0; li < 2; ++li) { const int lt = half ? 1 + li : 3 * li;
            bf16x8 cq[4];
#pragma unroll
            for (int d0 = 0; d0 < 4; ++d0) cq[d0] = *(const LAS bf16x8*)(CK + (2 * d0 + hi) * 2048 + (32 * lt + r32) * 16);
            f32x16 o[2]; o[0] = f32x16{}; o[1] = f32x16{};
            const float al = acs[hh * 128 + 32 * lt + r32];
            for (int st = 0; st <= lt; ++st) {
                f32x16 gt = f32x16{};
#pragma unroll
                for (int d0 = 0; d0 < 4; ++d0) { const bf16x8 kf = *(const LAS bf16x8*)(BK + (2 * d0 + hi) * 2048 + (32 * st + r32) * 16); gt = __builtin_amdgcn_mfma_f32_32x32x16_bf16(kf, cq[d0], gt, 0, 0, 0); }
                unsigned pw[8];
                int dd = r32 - 4 * hi; LAS float* ap = acs + hh * 128 + 32 * st + 4 * hi; LAS float* dp = dts + hh * 128 + 32 * st + 4 * hi;
                asm volatile("" : "+v"(dd), "+v"(ap), "+v"(dp));
#pragma unroll
                for (int r = 0; r < 16; r += 2) { float pv[2];
#pragma unroll
                    for (int e = 0; e < 2; ++e) { const int c0 = crow(r + e, 0); const float as = ap[c0], dv = dp[c0];
                        float v = gt[r + e] * exp_f(al - as) * dv;
                        if (st == lt) { v = (c0 <= dd) ? v : 0.f; v += (c0 == dd) ? Dh : 0.f; }
                        pv[e] = v; }
                    pw[r >> 1] = pk2(pv[0], pv[1]); }
                const bf16x8 pa0 = __builtin_bit_cast(bf16x8, (v4u){pw[0], pw[1], pw[2], pw[3]}), pa1 = __builtin_bit_cast(bf16x8, (v4u){pw[4], pw[5], pw[6], pw[7]});
#pragma unroll
                for (int pt = 0; pt < 2; ++pt) { const lcp vp = (lcp)(XI + (hh * 2 + pt) * 8192 + (32 * st) * 64 + trv);
                    const bf16x8 v0 = join(vtr(vp), vtr(vp + 512)), v1 = join(vtr(vp + 1024), vtr(vp + 1024 + 512));
                    o[pt] = __builtin_amdgcn_mfma_f32_32x32x16_bf16(pa0, v0, o[pt], 0, 0, 0); o[pt] = __builtin_amdgcn_mfma_f32_32x32x16_bf16(pa1, v1, o[pt], 0, 0, 0); }
            }
            f32x16 o2[2]; o2[0] = f32x16{}; o2[1] = f32x16{};
            { const LAS unsigned char* pvh = F.lds + ((hh < 3) ? PV_OFF + hh * 8192 : PV3_OFF) + r32 * 16 + hi * 1024;
#pragma unroll
              for (int pt = 0; pt < 2; ++pt)
#pragma unroll
                for (int d0 = 0; d0 < 4; ++d0) { const bf16x8 pb = *(const LAS bf16x8*)(pvh + (2 * d0) * 1024 + pt * 512);
                    o2[pt] = __builtin_amdgcn_mfma_f32_32x32x16_bf16(cq[d0], pb, o2[pt], 0, 0, 0); } }
            { LAS float* ep = acs + hh * 128 + 32 * lt + 4 * hi; LAS float* qp = ssq + 32 * lt + 4 * hi; const bf16* zb = U + (size_t)(m0 + 32 * lt + 4 * hi) * D_INP + U_Z + h * 64 + r32;
              asm volatile("" : "+v"(ep), "+v"(qp), "+v"(zb));
#pragma unroll
              for (int r = 0; r < 16; ++r) { const int c0 = crow(r, 0); const float ea = exp_f(ep[c0]); const bf16* zp = zb + (size_t)c0 * D_INP;
                const float y0 = (o[0][r] + ea * o2[0][r]) * silu_f(bf2f(zp[0])), y1 = (o[1][r] + ea * o2[1][r]) * silu_f(bf2f(zp[32]));
                yk[li][0][r] = y0; yk[li][1][r] = y1; }
              float s2[16];
#pragma unroll
              for (int r = 0; r < 16; ++r) s2[r] = sum16(yk[li][0][r] * yk[li][0][r] + yk[li][1][r] * yk[li][1][r]);
              if ((lane & 15) == 0) {
#pragma unroll
                  for (int r = 0; r < 16; ++r) atomicAdd((float*)(qp + crow(r, 0)), s2[r]); } }
        }
        __syncthreads();
#pragma unroll
        for (int li = 0; li < 2; ++li) { const int lt = half ? 1 + li : 3 * li;
            LAS float* qp = ssq + 32 * lt + 4 * hi; LAS bf16* ot = (LAS bf16*)XI + (32 * lt + 4 * hi) * 256 + hh * 64 + r32; asm volatile("" : "+v"(qp), "+v"(ot));
            const float n0 = nw[h * 64 + r32], n1 = nw[h * 64 + 32 + r32];
#pragma unroll
            for (int r = 0; r < 16; ++r) { const int c0 = crow(r, 0); const float rs = rsq_f(qp[c0] * (1.f / 256.f) + EPS);
                ot[c0 * 256] = (bf16)f2bf(yk[li][0][r] * rs * n0); ot[c0 * 256 + 32] = (bf16)f2bf(yk[li][1][r] * rs * n1); } }
        __syncthreads();
        { const LAS unsigned char* ot = XI + (F.tid >> 5) * 512 + (F.tid & 31) * 16; bf16* ob = O + (size_t)(m0 + (F.tid >> 5)) * DM + 256 + g * 256 + (F.tid & 31) * 8; asm volatile("" : "+v"(ot), "+v"(ob));
#pragma unroll
          for (int i = 0; i < 8; ++i) { const v4u v = *(const LAS v4u*)(ot + i * 16 * 512); *(GAS v4u*)(ob + (size_t)(16 * i) * DM) = v; } }
        __syncthreads();
    }
}
__device__ __forceinline__ void ph_seq_naive(const Frame& F, const Args& a, int l, int qsel, int parts = 3) {
    unsigned char* const ws = WSP(F);
    const int lane = F.lane;
    if ((parts & 1) && F.vcu < 8) gdn_chain(F, F.vcu);
    __syncthreads();
    if (parts & 2) {
        const Frame Fa = reframe(F);
        const attn_body::bf16* Qb = (const attn_body::bf16*)(ws + WS_Q); const attn_body::bf16* Kb = (const attn_body::bf16*)(ws + WS_K); const attn_body::bf16* Vb = (const attn_body::bf16*)(ws + WS_V);
        attn_body::bf16* O = (attn_body::bf16*)(ws + WS_O);
        unsigned* qhead = (unsigned*)(ws + WS_CTL) + CW_ATTQ + 64 * l + 128 * qsel;
        for (;;) {
            if (F.tid == 0) F.MISC[48] = __hip_atomic_fetch_add(qhead, 1u, RLX_AGENT);
            __syncthreads();
            const int it = (int)F.MISC[48];
            __syncthreads();
            if (it >= 8 * 64) break;
            const int qb = 63 - (it >> 3), bh = it & 7;
            attn_body::attn_unit<8>(Fa.tid, bh >> 2, bh & 3, qb, Qb, Kb, Vb, O, (char*)Fa.lds);
        }
    }
}
__device__ __forceinline__ void ph_post_naive(const Frame& F, const Args& a, int l) {
    unsigned char* const ws = WSP(F);
    const bf16* U = (const bf16*)(ws + WS_U); const float* Y = (const float*)(ws + WS_H); const float* OR = (const float*)(ws + WS_OR); bf16* O = (bf16*)(ws + WS_O);
    const float* snw = P(F, 14) + l * 512; const float* gnw = P(F, 19) + l * 64; const int lane = F.lane;
    for (int m = F.gw; m < T; m += F.NGW) {
        { const int c = 4 * lane; f32x4 o = *(const f32x4*)(OR + (size_t)m * 256 + c); const float ss = sum16((o.x * o.x + o.y * o.y) + (o.z * o.z + o.w * o.w));
          const float rs = rsq_f(ss * (1.f / 64.f) + EPS); const f32x4 nw = *(const f32x4*)(gnw + (c & 63)); const v2u zw = *(const v2u*)(U + (size_t)m * D_INP + U_GZ + c);
          o = o * rs * nw; o.x *= silu_f(bflo(zw.x)); o.y *= silu_f(bfhi(zw.x)); o.z *= silu_f(bflo(zw.y)); o.w *= silu_f(bfhi(zw.y));
          v2u w; w.x = pk2(o.x, o.y); w.y = pk2(o.z, o.w); if ((PROBE_SKIP >> (4 + 3 * l)) & 4) { w.x = 0; w.y = 0; } *(v2u*)(O + (size_t)m * DM + 768 + c) = w;
          if ((PROBE_SKIP >> (4 + 3 * l)) & 1) { v2u z; z.x = 0; z.y = 0; *(v2u*)(O + (size_t)m * DM + c) = z; } }
    }
}

constexpr int CW_CHK = 1024;
__device__ __forceinline__ int chk_row(int i) { return i == 0 ? 0 : i == 1 ? 1 : i == 2 ? 255 : i == 3 ? 256 : i == 4 ? 16383 : i == 5 ? 16384 : i == 6 ? 24999 : 32767; }
__device__ __forceinline__ void chk_commit(const Frame& F, int k, float err, float nrm) {
    LAS float* red = (LAS float*)(F.lds + 120000);
    if (F.tid < 2) red[F.tid] = 0.f;
    __syncthreads();
    atomicAdd((float*)(red + 0), err); atomicAdd((float*)(red + 1), nrm);
    __syncthreads();
    if (F.tid == 0) { float* slot = (float*)(WSP(F) + WS_CTL) + CW_CHK + 2 * k; slot[0] = red[0]; slot[1] = red[1]; }
    __syncthreads();
}
__device__ __forceinline__ void chk_rows(const Frame& F, int k, int mode, const bf16* A, int lda, int K, const float* W, const float* W2, int N, const bf16* C, int ldc,
                                         const float* outp, const float* base, int base_ld, bool base_sampled, const float* gate) {
    if (F.vcu != 0) return;
    float err = 0.f, nrm = 0.f;
    for (int col = F.tid; col < N; col += NTHR)
        for (int i = 0; i < 8; ++i) { const int row = chk_row(i); const bf16* ar = A + (size_t)row * lda; float d = 0.f, d2 = 0.f;
            for (int kk = 0; kk < K; ++kk) { const float av = bf2f(ar[kk]); d += av * W[(size_t)kk * N + col]; if (mode == 2) d2 += av * W2[(size_t)kk * N + col]; }
            float ref, got;
            if (mode == 0) { ref = d; got = bf2f(C[(size_t)row * ldc + col]); }
            else if (mode == 1) { const float bs = base_sampled ? base[(size_t)i * base_ld + col] : base[(size_t)row * base_ld + col]; ref = bs + gate[(row / SEQ) * 6144 + col] * d; got = outp[(size_t)row * 1024 + col]; ref -= bs; got -= bs; }
            else { ref = silu_f(d) * d2; got = bf2f(C[(size_t)row * ldc + col]); }
            err += (ref - got) * (ref - got); nrm += ref * ref; }
    chk_commit(F, k, err, nrm);
}

#if PROBE_CHECK
__device__ __forceinline__ void chk_gdn(const Frame& F, int l, int hh) {
    if (F.vcu != 0) return;
    unsigned char* const ws = WSP(F);
    const bf16* U = (const bf16*)(ws + WS_U); const float* OR = (const float*)(ws + WS_OR);
    const float* gcw = P(F, 15) + (size_t)l * 4 * 768; const float* gcb = P(F, 16) + l * 768; const float* gdtb = P(F, 17) + l * 4; const float* galog = P(F, 18) + l * 4;
    LAS float* ks = (LAS float*)(F.lds + 4096); LAS float* qs = ks + 64;
    float e0 = 0.f, n0 = 0.f, e1 = 0.f, n1 = 0.f;
    if (F.wave == 0) {
        const int lane = F.lane; float S[64];
#pragma unroll
        for (int k = 0; k < 64; ++k) S[k] = 0.f;
        float xw[3][3], cwt[3][5];
#pragma unroll
        for (int pz = 0; pz < 3; ++pz) { xw[pz][0] = 0.f; xw[pz][1] = 0.f; xw[pz][2] = 0.f; const int ch = pz * 256 + hh * 64 + lane;
            cwt[pz][0] = gcw[ch]; cwt[pz][1] = gcw[768 + ch]; cwt[pz][2] = gcw[2 * 768 + ch]; cwt[pz][3] = gcw[3 * 768 + ch]; cwt[pz][4] = gcb[ch]; }
        const float gA = -exp_f(galog[hh]), gB = gdtb[hh];
#pragma unroll 1
        for (int t = 0; t < 128; ++t) { const bf16* ur = U + (size_t)t * D_INP; float cvv[3];
#pragma unroll
            for (int pz = 0; pz < 3; ++pz) { const int ch = pz * 256 + hh * 64 + lane; const float xin = bf2f(ur[U_GQKV + ch]);
                const float cv = cwt[pz][4] + cwt[pz][0] * xw[pz][0] + cwt[pz][1] * xw[pz][1] + cwt[pz][2] * xw[pz][2] + cwt[pz][3] * xin;
                xw[pz][0] = xw[pz][1]; xw[pz][1] = xw[pz][2]; xw[pz][2] = xin; cvv[pz] = silu_f(cv); }
            const float qn = cvv[0] * rsq_f(wave_sum(cvv[0] * cvv[0]) + EPS) * 0.125f, kn = cvv[1] * rsq_f(wave_sum(cvv[1] * cvv[1]) + EPS);
            const float beta = sigmoid_f(bf2f(ur[U_GB + hh])), al = exp_f(gA * softplus_f(bf2f(ur[U_GA + hh]) + gB));
            ks[lane] = kn; qs[lane] = qn; LDS_WAIT(); asm volatile("" ::: "memory");
            float kS = 0.f; LAS float* ksv = ks; asm volatile("" : "+v"(ksv));
#pragma unroll
            for (int k = 0; k < 64; k += 4) { const f32x4 k4 = *(const LAS f32x4*)(ksv + k);
                S[k] *= al; kS += k4.x * S[k]; S[k + 1] *= al; kS += k4.y * S[k + 1]; S[k + 2] *= al; kS += k4.z * S[k + 2]; S[k + 3] *= al; kS += k4.w * S[k + 3]; }
            const float vn = beta * (cvv[2] - kS); float o = 0.f;
#pragma unroll
            for (int k = 0; k < 64; k += 4) { const f32x4 k4 = *(const LAS f32x4*)(ksv + k), q4 = *(const LAS f32x4*)(ksv + 64 + k);
                S[k] += k4.x * vn; o += q4.x * S[k]; S[k + 1] += k4.y * vn; o += q4.y * S[k + 1]; S[k + 2] += k4.z * vn; o += q4.z * S[k + 2]; S[k + 3] += k4.w * vn; o += q4.w * S[k + 3]; }
            LDS_WAIT(); asm volatile("" ::: "memory");
            const float got = OR[(size_t)t * 256 + hh * 64 + lane];
            if (t < 64) { e0 += (o - got) * (o - got); n0 += o * o; } else { e1 += (o - got) * (o - got); n1 += o * o; }
        }
    }
    chk_commit(F, 6, e0, n0); chk_commit(F, 7, e1, n1);
}
#endif

#if PROBE_CHECK
__device__ __forceinline__ void chk_gdn2(const Frame& F, int l, int hh) {
    if (F.vcu != 0) return;
    unsigned char* const ws = WSP(F);
    const bf16* U = (const bf16*)(ws + WS_U);
    const bf16* KCp = (const bf16*)(ws + WS_GF + (size_t)(hh * (SEQ / 64)) * GF_UNIT); const bf16* QDp = KCp + 4096; const bf16* QKp = KCp + 8192; const bf16* KTp = KCp + 12288; const bf16* UVp = KCp + 16384;
    const float* gcw = P(F, 15) + (size_t)l * 4 * 768; const float* gcb = P(F, 16) + l * 768; const float* gdtb = P(F, 17) + l * 4; const float* galog = P(F, 18) + l * 4;
    LAS float* qs = (LAS float*)F.lds; LAS float* ks = qs + 4096; LAS float* vs = ks + 4096; LAS float* W1 = vs + 4096; LAS float* W2 = W1 + 4096; LAS float* bt = W2 + 4096; LAS float* gcm = bt + 64;
    float e[5] = {0.f, 0.f, 0.f, 0.f, 0.f}, nn[5] = {0.f, 0.f, 0.f, 0.f, 0.f};
    if (F.wave == 0) {
        int lane = F.lane; asm volatile("" : "+v"(lane));
        float xw[3][3], cwt[3][5];
#pragma unroll
        for (int pz = 0; pz < 3; ++pz) { xw[pz][0] = 0.f; xw[pz][1] = 0.f; xw[pz][2] = 0.f; const int ch = pz * 256 + hh * 64 + lane;
            cwt[pz][0] = gcw[ch]; cwt[pz][1] = gcw[768 + ch]; cwt[pz][2] = gcw[2 * 768 + ch]; cwt[pz][3] = gcw[3 * 768 + ch]; cwt[pz][4] = gcb[ch]; }
        const float gA = -exp_f(galog[hh]), gB = gdtb[hh]; float gsum = 0.f;
#pragma unroll 1
        for (int t = 0; t < 64; ++t) { const bf16* ur = U + (size_t)t * D_INP; float cvv[3];
#pragma unroll
            for (int pz = 0; pz < 3; ++pz) { const int ch = pz * 256 + hh * 64 + lane; const float xin = bf2f(ur[U_GQKV + ch]);
                const float cv = cwt[pz][4] + cwt[pz][0] * xw[pz][0] + cwt[pz][1] * xw[pz][1] + cwt[pz][2] * xw[pz][2] + cwt[pz][3] * xin;
                xw[pz][0] = xw[pz][1]; xw[pz][1] = xw[pz][2]; xw[pz][2] = xin; cvv[pz] = silu_f(cv); }
            qs[t * 64 + lane] = cvv[0] * rsq_f(wave_sum(cvv[0] * cvv[0]) + EPS) * 0.125f; ks[t * 64 + lane] = cvv[1] * rsq_f(wave_sum(cvv[1] * cvv[1]) + EPS); vs[t * 64 + lane] = cvv[2];
            gsum += gA * softplus_f(bf2f(ur[U_GA + hh]) + gB);
            if (lane == 0) { bt[t] = sigmoid_f(bf2f(ur[U_GB + hh])); gcm[t] = gsum; } }
        LDS_WAIT(); asm volatile("" ::: "memory");
        const float g63 = gcm[63];
#pragma unroll 1
        for (int i = 0; i < 64; ++i) { const float gi = gcm[i], bi = bt[i];
            { const float ref = qs[i * 64 + lane] * exp_f(gi), got = bf2f(QDp[gfrag_off(i, lane)]); e[0] += (ref - got) * (ref - got); nn[0] += ref * ref; }
            { const float ref = ks[i * 64 + lane] * exp_f(g63 - gi), got = bf2f(KTp[gfrag_off(lane, i)]); e[1] += (ref - got) * (ref - got); nn[1] += ref * ref; }
            { float d = 0.f; for (int k = 0; k < 64; ++k) d += qs[i * 64 + k] * ks[lane * 64 + k];
              const float ref = (lane <= i) ? d * exp_f(gi - gcm[lane]) : 0.f, got = bf2f(QKp[gfrag_off(i, lane)]); e[2] += (ref - got) * (ref - got); nn[2] += ref * ref; }
            float w1 = bi * vs[i * 64 + lane], w2 = bi * exp_f(gi) * ks[i * 64 + lane];
#pragma unroll 1
            for (int j = 0; j < i; ++j) { const float aij = bi * wave_sum(ks[i * 64 + lane] * ks[j * 64 + lane]) * exp_f(gi - gcm[j]); w1 -= aij * W1[j * 64 + lane]; w2 -= aij * W2[j * 64 + lane]; }
            W1[i * 64 + lane] = w1; W2[i * 64 + lane] = w2; LDS_WAIT(); asm volatile("" ::: "memory");
            { const float got = bf2f(UVp[(((lane >> 4) * 4 + (i >> 4)) * 64 + ((i & 15) >> 2) * 16 + (lane & 15)) * 4 + (i & 3)]); e[3] += (w1 - got) * (w1 - got); nn[3] += w1 * w1; }
            { const float got = -bf2f(KCp[gfrag_off(i, lane)]); e[4] += (w2 - got) * (w2 - got); nn[4] += w2 * w2; } }
    }
#pragma unroll
    for (int k = 0; k < 5; ++k) chk_commit(F, 8 + k, e[k], nn[k]);
}
#endif
__device__ __forceinline__ void moe_load_tstart(const Frame& F, const Args& a) {
    unsigned char* const ws = WSP(F);
    if (F.tid == 0) { unsigned* ctl = (unsigned*)(ws + WS_CTL); unsigned acc = 0;
        for (int e = 0; e < 8; ++e) { const unsigned c = __hip_atomic_load(ctl + CW_MOECNT + 64 * e, RLX_AGENT); F.MISC[16 + e] = acc; F.MISC[32 + e] = c; acc += (c + 255u) >> 8; }
        F.MISC[16 + 8] = acc; }
    __syncthreads();
}
__device__ __forceinline__ void ph_moe_route(const Frame& F, const Args& a, int l) {
    unsigned char* const ws = WSP(F);
    const float* mod = (const float*)(ws + WS_MOD) + (size_t)l * 12288; bf16* H = (bf16*)(ws + WS_H);
    const float* Wr = P(F, 24); const void* src = ws + WS_H;
    int* ROWTOK = (int*)(ws + WS_ROWTOK); int* TOKSLOT = (int*)(ws + WS_TOKSLOT); float* TOKW = (float*)(ws + WS_TOKW);
    unsigned* ctl = (unsigned*)(ws + WS_CTL);
    LAS int* lcnt = (LAS int*)(F.lds + 65536); LAS int* lbase = lcnt + 8; LAS int* se = lcnt + 16; LAS float* sw = (LAS float*)(lcnt + 16 + 256);
    const int lane = F.lane;
    f32x4 wr[4][4][2];
#pragma unroll
    for (int j = 0; j < 4; ++j)
#pragma unroll
        for (int i = 0; i < 4; ++i) { const int col = 4 * lane + 256 * j + i; wr[j][i][0] = *(const f32x4*)(Wr + (size_t)col * 8); wr[j][i][1] = *(const f32x4*)(Wr + (size_t)col * 8 + 4); }
    for (int blk = F.vcu; blk < T / 128; blk += F.G) {
        if (F.tid < 8) lcnt[F.tid] = 0;
        __syncthreads();
        f32x4 xa[4], xb[4];
        norm_row_load(src, (size_t)(blk * 128 + F.wave * 16), true, lane, xa);
#pragma unroll 1
        for (int rr = 0; rr < 16; ++rr) { const int r = F.wave * 16 + rr, m = blk * 128 + r, b = m / SEQ; f32x4 hv[4];
            if (rr + 1 < 16) norm_row_load(src, (size_t)(m + 1), true, lane, xb);
            norm_mod_apply<false>(xa, H + (size_t)m * DM, mod + b * 6144 + 3072, mod + b * 6144 + 4096, lane, hv);
            { unsigned* h8 = (unsigned*)(ws + WS_H8 + (size_t)m * DM) + lane;
#pragma unroll
              for (int j = 0; j < 4; ++j) { int w8 = 0; w8 = __builtin_amdgcn_cvt_pk_fp8_f32(hv[j].x * FP8_SA, hv[j].y * FP8_SA, w8, false); w8 = __builtin_amdgcn_cvt_pk_fp8_f32(hv[j].z * FP8_SA, hv[j].w * FP8_SA, w8, true); h8[64 * j] = (unsigned)w8; } }
            float lg[8];
#pragma unroll
            for (int e = 0; e < 8; ++e) lg[e] = 0.f;
#pragma unroll
            for (int j = 0; j < 4; ++j)
#pragma unroll
                for (int i = 0; i < 4; ++i) { const f32x4 wa = wr[j][i][0], wb = wr[j][i][1]; const float x = hv[j][i];
                    lg[0] += x * wa.x; lg[1] += x * wa.y; lg[2] += x * wa.z; lg[3] += x * wa.w; lg[4] += x * wb.x; lg[5] += x * wb.y; lg[6] += x * wb.z; lg[7] += x * wb.w; }
#pragma unroll
            for (int j = 0; j < 4; ++j) xa[j] = xb[j];
#pragma unroll
            for (int e = 0; e < 8; ++e) lg[e] = wave_sum(lg[e]);
            int e0 = 0; float v0 = lg[0];
#pragma unroll
            for (int e = 1; e < 8; ++e) if (lg[e] > v0) { v0 = lg[e]; e0 = e; }
            int e1 = -1; float v1 = -INFINITY;
#pragma unroll
            for (int e = 0; e < 8; ++e) if (e != e0 && lg[e] > v1) { v1 = lg[e]; e1 = e; }
            const float w0 = rcp_f(1.0f + exp_f(v1 - v0)), w1 = 1.0f - w0;
            if (lane == 0) { const int s0 = atomicAdd((int*)(lcnt + e0), 1), s1 = atomicAdd((int*)(lcnt + e1), 1);
                se[r * 2] = (e0 << 16) | s0; se[r * 2 + 1] = (e1 << 16) | s1; sw[r * 2] = w0; sw[r * 2 + 1] = w1; }
        }
        __syncthreads();
        if (F.tid < 8) lbase[F.tid] = (int)__hip_atomic_fetch_add(ctl + CW_MOECNT + 64 * F.tid, (unsigned)lcnt[F.tid], RLX_AGENT);
        __syncthreads();
        if (F.tid < 256) { const int r = F.tid >> 1, k = F.tid & 1, v = se[F.tid], e = v >> 16, idx = lbase[e] + (v & 0xffff), m = blk * 128 + r;
            ROWTOK[e * 32768 + idx] = m; TOKSLOT[m * 2 + k] = (e << 20) | idx; TOKW[m * 2 + k] = sw[F.tid]; }
        __syncthreads();
    }
}
__device__ __forceinline__ void ph_scale_w(const Frame& F, const float* modl, int which, const bf16* Wt, int N, bf16* Wo, float* bias, bool f8) {
    const int lane = F.lane;
    for (int n = F.gw; n < N; n += F.NGW) {
        const v4u wa = *(const v4u*)(Wt + (size_t)n * 1024 + lane * 16), wb = *(const v4u*)(Wt + (size_t)n * 1024 + lane * 16 + 8);
        float w[16] = {bflo(wa.x), bfhi(wa.x), bflo(wa.y), bfhi(wa.y), bflo(wa.z), bfhi(wa.z), bflo(wa.w), bfhi(wa.w), bflo(wb.x), bfhi(wb.x), bflo(wb.y), bfhi(wb.y), bflo(wb.z), bfhi(wb.z), bflo(wb.w), bfhi(wb.w)};
#pragma unroll
        for (int b = 0; b < 2; ++b) { const float* sh = modl + b * 6144 + which * 3072 + lane * 16; const float* sc = sh + 1024; float dot = 0.f; float o[16];
#pragma unroll
            for (int q = 0; q < 4; ++q) { const f32x4 s4 = *(const f32x4*)(sh + 4 * q), c4 = *(const f32x4*)(sc + 4 * q);
#pragma unroll
                for (int e = 0; e < 4; ++e) { o[4 * q + e] = w[4 * q + e] * (1.0f + c4[e]); dot += s4[e] * w[4 * q + e]; } }
            v4u oa, ob; oa.x = pk2(o[0], o[1]); oa.y = pk2(o[2], o[3]); oa.z = pk2(o[4], o[5]); oa.w = pk2(o[6], o[7]); ob.x = pk2(o[8], o[9]); ob.y = pk2(o[10], o[11]); ob.z = pk2(o[12], o[13]); ob.w = pk2(o[14], o[15]);
            if (f8) { v4u o8;
#pragma unroll
                for (int q = 0; q < 4; ++q) { int w8 = 0; w8 = __builtin_amdgcn_cvt_pk_fp8_f32(o[4 * q] * FP8_SW, o[4 * q + 1] * FP8_SW, w8, false); w8 = __builtin_amdgcn_cvt_pk_fp8_f32(o[4 * q + 2] * FP8_SW, o[4 * q + 3] * FP8_SW, w8, true); o8[q] = (unsigned)w8; }
                *(v4u*)((unsigned char*)Wo + ((size_t)b * N + n) * 1024 + lane * 16) = o8; }
            else { bf16* dst = Wo + ((size_t)b * N + n) * 1024 + lane * 16; *(v4u*)dst = oa; *(v4u*)(dst + 8) = ob; }
            dot = wave_sum(dot); if (lane == 0) bias[b * N + n] = dot; }
    }
}
__device__ __forceinline__ void ph_moe_conv(const Frame& F, const Args& a, int ci, int cn) {
    _Pragma("unroll 1") for (int r2 = 0; r2 < DUPN(13); ++r2) {
        unsigned char* const ws = WSP(F); const int lane = F.lane;
        constexpr int NBLK = 8 * 3 * 112;
        const int rh = lane >> 5, n4 = lane & 31;
        f32x4 cur[16], nxt[16];
#define MOE_BLK(b_, Wp_, ldw_, WTp_, ldt_) \
        const int e_ = (b_) / 336; int r_ = (b_) % 336; const int which_ = r_ / 112; r_ %= 112; \
        const float* Wp_; int ldw_, ldt_; unsigned char* WTp_; \
        if (which_ < 2) { const int kb_ = r_ / 28, nb_ = r_ % 28; Wp_ = P(F, 25 + which_) + (size_t)e_ * 1024 * DFFE + (size_t)(kb_ * 256) * DFFE + nb_ * 128; ldw_ = DFFE; \
            WTp_ = ws + WS_MUP + (size_t)e_ * 7168 * 1024 + (size_t)(256 * nb_ + 128 * which_) * 1024 + kb_ * 256; ldt_ = 1024; } \
        else { const int kb_ = r_ / 8, nb_ = r_ % 8; Wp_ = P(F, 27) + (size_t)e_ * DFFE * 1024 + (size_t)(kb_ * 256) * 1024 + nb_ * 128; ldw_ = 1024; \
            WTp_ = ws + WS_MDN + (size_t)e_ * 1024 * DFFE + (size_t)(nb_ * 128) * DFFE + kb_ * 256; ldt_ = DFFE; }
        int blkc = ci, buf = 0;
        if (blkc < NBLK) { MOE_BLK(blkc, W0, ldw0, WT0, ldt0) (void)WT0; (void)ldt0;
            const float* wp = W0 + (size_t)(32 * F.wave + 16 * rh) * ldw0 + 4 * n4;
#pragma unroll
            for (int j = 0; j < 16; ++j) cur[j] = *(const f32x4*)(wp + (size_t)j * ldw0); }
        for (; blkc < NBLK; blkc += cn) {
            const int bn = blkc + cn;
            if (bn < NBLK) { MOE_BLK(bn, W1, ldw1, WT1, ldt1) (void)WT1; (void)ldt1;
                const float* wp = W1 + (size_t)(32 * F.wave + 16 * rh) * ldw1 + 4 * n4;
#pragma unroll
                for (int j = 0; j < 16; ++j) nxt[j] = *(const f32x4*)(wp + (size_t)j * ldw1); }
            MOE_BLK(blkc, Wc, ldwc, WTc, ldtc) (void)Wc; (void)ldwc;
            LAS unsigned char* img = F.lds + buf * 32768;
#pragma unroll
            for (int i = 0; i < 4; ++i) { v4u o;
#pragma unroll
                for (int q = 0; q < 4; ++q) { int w8 = 0; w8 = __builtin_amdgcn_cvt_pk_fp8_f32(cur[4 * q][i] * FP8_SW, cur[4 * q + 1][i] * FP8_SW, w8, false); w8 = __builtin_amdgcn_cvt_pk_fp8_f32(cur[4 * q + 2][i] * FP8_SW, cur[4 * q + 3][i] * FP8_SW, w8, true); o[q] = (unsigned)w8; }
                *(LAS v4u*)(img + (4 * n4 + i) * 256 + (((2 * F.wave + rh) ^ (n4 & 15)) << 4)) = o; }
            __syncthreads();
            { const int chunk = F.tid & 15, rb = F.tid >> 4;
#pragma unroll
              for (int i = 0; i < 4; ++i) { const int row = rb + 32 * i; const v4u v = *(const LAS v4u*)(img + row * 256 + ((chunk ^ ((row >> 2) & 15)) << 4));
                  *(GAS v4u*)(WTc + (size_t)row * ldtc + chunk * 16) = v; } }
#pragma unroll
            for (int j = 0; j < 16; ++j) cur[j] = nxt[j];
            buf ^= 1;
        }
#undef MOE_BLK
        __syncthreads();
    }
}
template <bool GATHER_> struct MoeOrder {
    static constexpr bool GATHER = GATHER_;
    int ntile, nN, G, c, tile0; volatile LAS unsigned* ts; const int* rowtok;
    __device__ __forceinline__ bool next(int i, pg8::Unit& u) const {
        int pm, pcol;
        if ((G & 7) == 0) { const int NG = ((nN & 3) == 0 && nN >= 8) ? 4 : 1, XPG = 8 / NG, ncg = nN / NG, x = c & 7, gq = x / XPG, sub = x % XPG;
            const int nrt = (ntile > sub) ? (ntile - sub + XPG - 1) / XPG : 0, k = i * (G >> 3) + (c >> 3);
            if (k >= nrt * ncg) return false;
            pm = tile0 + (k / ncg) * XPG + sub; pcol = gq * ncg + k % ncg; }
        else { const int L = i * G + c; if (L >= ntile * nN) return false; pm = tile0 + L / nN; pcol = L % nN; }
        int e = 0;
#pragma unroll
        for (int j = 1; j < 8; ++j) e += (pm >= (int)ts[j]) ? 1 : 0;
        const int lt = pm - (int)ts[e];
        u.pm = pm; u.pn = e * nN + pcol; u.ab = e * 32768 + lt * 256; u.av = (int)ts[16 + e] - lt * 256; return true; }
    __device__ __forceinline__ int arow(const pg8::Unit& u, int r) const {
        if constexpr (!GATHER_) return (u.pm - tile0) * 256 + r;
        else { const int rc = r < u.av ? r : u.av - 1; return rowtok[u.ab + rc]; } }
};
__device__ __forceinline__ void ph_final(const Frame& F, const Args& a) {
    unsigned char* const ws = WSP(F);
    moe_load_tstart(F, a);
    const float* mod = (const float*)(ws + WS_MOD) + (size_t)1 * 12288; const bf16* Y = (const bf16*)(ws + WS_Y);
    const int* TOKSLOT = (const int*)(ws + WS_TOKSLOT); const float* TOKW = (const float*)(ws + WS_TOKW); const float* fn = P(F, 28); float* out = OUTP(F);
    const bf16* xs = (const bf16*)(ws + WS_H);
    const int lane = F.lane, m0 = F.gw, st = F.NGW;
    int sA0 = 0, sA1 = 0, sB0 = 0, sB1 = 0; float wA0 = 0.f, wA1 = 0.f, wB0 = 0.f, wB1 = 0.f;
    v2u xc[4], xn[4]; v2u yac[4], ybc[4], yan[4], ybn[4];
#define FIN_IDX(m_, s0_, s1_, w0_, w1_) { s0_ = TOKSLOT[(m_) * 2]; s1_ = TOKSLOT[(m_) * 2 + 1]; w0_ = TOKW[(m_) * 2]; w1_ = TOKW[(m_) * 2 + 1]; }
#define FIN_ROWS(m_, s0_, s1_, x_, ya_, yb_) { const size_t r0 = (size_t)F.MISC[16 + ((s0_) >> 20)] * 256 + ((s0_) & 0xfffff), r1 = (size_t)F.MISC[16 + ((s1_) >> 20)] * 256 + ((s1_) & 0xfffff); \
        _Pragma("unroll") for (int j = 0; j < 4; ++j) { const int c = 4 * lane + 256 * j; x_[j] = *(const v2u*)(xs + (size_t)(m_) * DM + c); ya_[j] = *(const v2u*)(Y + r0 * DM + c); yb_[j] = *(const v2u*)(Y + r1 * DM + c); } }
    if (m0 < T) { FIN_IDX(m0, sA0, sA1, wA0, wA1) FIN_ROWS(m0, sA0, sA1, xc, yac, ybc) }
    if (m0 + st < T) FIN_IDX(m0 + st, sB0, sB1, wB0, wB1)
#pragma unroll 1
    for (int m = m0; m < T; m += st) { const int b = m / SEQ;
        const float w0 = wA0, w1 = wA1;
        if (m + st < T) FIN_ROWS(m + st, sB0, sB1, xn, yan, ybn)
        sA0 = sB0; sA1 = sB1; wA0 = wB0; wA1 = wB1;
        if (m + 2 * st < T) FIN_IDX(m + 2 * st, sB0, sB1, wB0, wB1)
        f32x4 v[4]; float ss = 0.f;
#pragma unroll
        for (int j = 0; j < 4; ++j) { const int c = 4 * lane + 256 * j; const f32x4 x = {bflo(xc[j].x), bfhi(xc[j].x), bflo(xc[j].y), bfhi(xc[j].y)}; const f32x4 g2 = *(const f32x4*)(mod + b * 6144 + 5120 + c);
            const v2u ya = yac[j], yb = ybc[j];
            f32x4 f; f.x = w0 * bflo(ya.x) + w1 * bflo(yb.x); f.y = w0 * bfhi(ya.x) + w1 * bfhi(yb.x); f.z = w0 * bflo(ya.y) + w1 * bflo(yb.y); f.w = w0 * bfhi(ya.y) + w1 * bfhi(yb.y);
            v[j] = (PROBE_SKIP & 1) ? x : x + g2 * f; ss += (v[j].x * v[j].x + v[j].y * v[j].y) + (v[j].z * v[j].z + v[j].w * v[j].w); }
        const float rs = rsq_f(wave_sum(ss) * (1.f / 1024.f) + EPS);
        { float* orow = out + (size_t)m * DM;
#pragma unroll
          for (int j = 0; j < 4; ++j) { const int c = 4 * lane + 256 * j; const f32x4 nw = *(const f32x4*)(fn + c); *(f32x4*)(orow + c) = v[j] * rs * nw; } }
#pragma unroll
        for (int j = 0; j < 4; ++j) { xc[j] = xn[j]; yac[j] = yan[j]; ybc[j] = ybn[j]; }
    }
#undef FIN_IDX
#undef FIN_ROWS
}


#if PROBE_CHECK
__device__ __forceinline__ void chk_moe(const Frame& F) {
    if (F.vcu != 0) return;
    unsigned char* const ws = WSP(F);
    const bf16* H = (const bf16*)(ws + WS_H); const bf16* Y = (const bf16*)(ws + WS_Y);
    const int* TOKSLOT = (const int*)(ws + WS_TOKSLOT); const float* TOKW = (const float*)(ws + WS_TOKW);
    const float* Wr = P(F, 24); const float* Wg = P(F, 25); const float* Wu = P(F, 26); const float* Wd = P(F, 27);
    LAS float* hrow = (LAS float*)F.lds; LAS float* hid = hrow + 1024; LAS float* yacc = hid + 3584; LAS float* lg = yacc + 1024;
    float err = 0.f, nrm = 0.f, rerr = 0.f;
    for (int i = 0; i < 8; ++i) { const int tok = chk_row(i);
        for (int k = F.tid; k < 1024; k += NTHR) { hrow[k] = bf2f(H[(size_t)tok * 1024 + k]); yacc[k] = 0.f; }
        __syncthreads();
        if (F.tid < 8) { float s = 0.f; for (int k = 0; k < 1024; ++k) s += hrow[k] * Wr[k * 8 + F.tid]; lg[F.tid] = s; }
        __syncthreads();
        const int s0 = TOKSLOT[tok * 2], s1 = TOKSLOT[tok * 2 + 1]; const float w0 = TOKW[tok * 2], w1 = TOKW[tok * 2 + 1];
        if (F.tid == 0) { int e0 = 0; for (int e = 1; e < 8; ++e) if (lg[e] > lg[e0]) e0 = e; int e1 = -1; for (int e = 0; e < 8; ++e) if (e != e0 && (e1 < 0 || lg[e] > lg[e1])) e1 = e;
            const float nw0 = rcp_f(1.f + exp_f(lg[e1] - lg[e0]));
            if ((s0 >> 20) != e0 || (s1 >> 20) != e1 || fabsf(nw0 - w0) > 0.02f || fabsf(w0 + w1 - 1.f) > 1e-3f) rerr += 1.f; }
        for (int kx = 0; kx < 2; ++kx) { const int e = (kx ? s1 : s0) >> 20; const float w = kx ? w1 : w0;
            const float* wg = Wg + (size_t)e * 1024 * DFFE; const float* wu = Wu + (size_t)e * 1024 * DFFE; const float* wd = Wd + (size_t)e * DFFE * 1024;
            for (int j = F.tid; j < DFFE; j += NTHR) { float g = 0.f, u = 0.f; for (int k = 0; k < 1024; ++k) { const float hv = hrow[k]; g += hv * wg[(size_t)k * DFFE + j]; u += hv * wu[(size_t)k * DFFE + j]; } hid[j] = silu_f(g) * u; }
            __syncthreads();
            for (int c = F.tid; c < 1024; c += NTHR) { float y = 0.f; for (int j = 0; j < DFFE; ++j) y += hid[j] * wd[(size_t)j * 1024 + c]; yacc[c] += w * y; }
            __syncthreads(); }
        const size_t r0 = (size_t)F.MISC[16 + (s0 >> 20)] * 256 + (s0 & 0xfffff), r1 = (size_t)F.MISC[16 + (s1 >> 20)] * 256 + (s1 & 0xfffff);
        for (int c = F.tid; c < 1024; c += NTHR) { const float f = w0 * bf2f(Y[r0 * 1024 + c]) + w1 * bf2f(Y[r1 * 1024 + c]); err += (yacc[c] - f) * (yacc[c] - f); nrm += yacc[c] * yacc[c]; }
        __syncthreads();
    }
    chk_commit(F, 4, err, nrm); chk_commit(F, 5, rerr, 1.f);
}
__device__ __forceinline__ void ph_probe_scale(const Frame& F) {
    const float* slot = (const float*)(WSP(F) + WS_CTL) + CW_CHK; float code;
    if (PROBE_CHECK == 1) { int mask = 0; for (int k = 0; k < 5; ++k) { const float e = slot[2 * (PROBE_BASE + k)], n = slot[2 * (PROBE_BASE + k) + 1]; if (!(n > 0.f) || !(e <= 1e-3f * n)) mask |= 1 << k; } code = 10.f + (float)mask; }
    else { const int k = PROBE_CHECK - 2; const float e = slot[2 * k], n = slot[2 * k + 1]; float r = (n > 0.f) ? (k == 5 ? e * 0.125f : sqrtf(e / n)) : 1.f; if (!(r <= 1.f)) r = 1.f; code = 10.f + 30.f * r; }
    if (PROBE_CHECK == 100) code = wave_sum((float)F.lane + 1.0f) * (1.0f / 32.5f);
    if (PROBE_CHECK == 101) code = wave_max((float)F.lane) + sum16((float)(F.lane & 15)) * 0.1f;
    float* out = OUTP(F);
    for (int m = F.gw; m < T; m += F.NGW)
#pragma unroll
        for (int j = 0; j < 4; ++j) { f32x4* p4 = (f32x4*)(out + (size_t)m * DM + 4 * F.lane + 256 * j); *p4 = *p4 * (1.f + code); }
}
#endif
#ifndef MK_MULTI
#define MK_MULTI 0
#endif
constexpr int N_PHASES = 21 + (PROBE_CHECK ? 1 : 0);
__global__ void __launch_bounds__(NTHR, 2) mega_fwd(Args args) {
    extern __shared__ __attribute__((aligned(16))) unsigned char lds[];
    Frame F;
    F.lds = (LAS unsigned char*)lds; F.MISC = (volatile LAS unsigned*)(F.lds + MISC_OFF);
    F.tid = threadIdx.x; F.lane = F.tid & 63; F.wave = __builtin_amdgcn_readfirstlane(F.tid >> 6);
    F.G = gridDim.x; { const int bx = blockIdx.x; F.vcu = (F.G % 8 == 0) ? (bx % 8) * (F.G / 8) + bx / 8 : bx; }
    F.gw = F.vcu * NWAVES + F.wave; F.NGW = F.G * NWAVES;
    for (int u = F.tid; u < (LDS_BYTES - RING_BYTES) / 4; u += NTHR) ((LAS unsigned*)(F.lds + RING_BYTES))[u] = 0u;
    __syncthreads();
#pragma unroll
    for (int i = 0; i < 29; ++i) if (F.tid == i) { const unsigned long long v = (unsigned long long)args.in[i]; F.MISC[64 + 2 * i] = (unsigned)v; F.MISC[65 + 2 * i] = (unsigned)(v >> 32); }
    if (F.tid == 29) { const unsigned long long v = (unsigned long long)args.ws; F.MISC[64 + 58] = (unsigned)v; F.MISC[65 + 58] = (unsigned)(v >> 32); }
    if (F.tid == 30) { const unsigned long long v = (unsigned long long)args.out; F.MISC[64 + 60] = (unsigned)v; F.MISC[65 + 60] = (unsigned)(v >> 32); }
    __syncthreads();
    XcdBarrier bar; bar.bar = (unsigned*)(WSP(F) + WS_CTL) + CW_BAR; bar.x = 0; bar.st = nullptr;
    if (!MK_MULTI) bar = xcd_barrier_post((unsigned*)(WSP(F) + WS_CTL) + CW_BAR, F.MISC + 8);
    const int lo = args.ph_lo, hi = args.ph_hi; int pid = 0;
#define PH_ON (pid >= opq(lo) && pid < opq(hi))
#define PH_END do { if (!MK_MULTI && pid >= opq(lo) && pid + 1 < opq(hi)) xcd_barrier(bar); ++pid; } while (0)
#define PH_PTRS const Frame Fp = reframe(F); unsigned char* const ws = WSP(Fp); const float* const mod = (const float*)(ws + WS_MOD); bf16* const H = (bf16*)(ws + WS_H); bf16* const U = (bf16*)(ws + WS_U); bf16* const O = (bf16*)(ws + WS_O); (void)mod; (void)H; (void)U; (void)O

    if (PH_ON) { _Pragma("unroll 1") for (int rp = 0; rp < DUPN(5); ++rp) { const Frame Fp = reframe(F); ph_prologue(Fp, args); __syncthreads(); } }
    PH_END;
    for (int l = 0; l < 2; ++l) {
#if PROBE_CHECK
        if (PH_ON && l == 1) { const Frame Fp = reframe(F); unsigned char* const ws = WSP(Fp);
            chk_rows(Fp, 3, 1, (const bf16*)(ws + WS_U), DFF, DFF, P(Fp, 23), nullptr, 1024, nullptr, 0, OUTP(Fp), (const float*)(ws + WS_DT), 1024, true, (const float*)(ws + WS_MOD) + 5120); }
#endif
        if (l == 0) {
        if (PH_ON) { _Pragma("unroll 1") for (int rp = 0; rp < DUPN(6); ++rp) { const Frame Fp = reframe(F); ph_normmod(Fp, args, (const void*)P(Fp, 0), false, 0, 0); } }
        PH_END; }
        if (PH_ON) { _Pragma("unroll 1") for (int rp = 0; rp < DUPN(0); ++rp) {
            PH_PTRS; const int lp = opq(l);
            pg8::Gemm g{(lp == 0) ? (const bf16*)H : (const bf16*)OUTP(Fp), (lp == 0) ? (const bf16*)(ws + WS_WIN) : (const bf16*)(ws + WS_WINS), 1024, 1024};
            pg8::BatchOrder S; S.init(T, D_INP, Fp.G, (int)blockIdx.x, lp, SEQ);
            pg8::EpiStoreBf16 E{U, D_INP, D_INP / 256, 0, 1.0f, (lp == 0) ? (const float*)nullptr : (const float*)(ws + WS_PARTB), (const float*)(ws + WS_BIASW), D_INP, SEQ};
            pg8::gemm_phase<pg8::EpiStoreBf16, pg8::BatchOrder, true>(Fp.lds, Fp.tid, g, S, E);
        } }
        PH_END;
#if PROBE_CHECK
        if (PH_ON && l == 0) { const Frame Fp = reframe(F); unsigned char* const ws = WSP(Fp);
            chk_rows(Fp, 0, 0, (const bf16*)(ws + WS_H), 1024, 1024, P(Fp, 4), nullptr, D_IN, (const bf16*)(ws + WS_U), D_INP, nullptr, nullptr, 0, false, nullptr); }
#endif
        if (PH_ON) { _Pragma("unroll 1") for (int rp = 0; rp < DUPN(1); ++rp) { _Pragma("unroll 1") for (int r2 = 0; r2 < DUPN(7); ++r2) { const Frame Fp = reframe(F); ph_mla(Fp, args, opq(l)); }
            _Pragma("unroll 1") for (int r2 = 0; r2 < DUPN(8); ++r2) { const Frame Fp = reframe(F); ph_gdn_prep(Fp, args, opq(l)); __syncthreads(); }
            _Pragma("unroll 1") for (int r2 = 0; r2 < DUPN(9); ++r2) { const Frame Fp = reframe(F); ph_ssd_states(Fp, args, opq(l)); } } }
        PH_END;
        if (PH_ON) { { const Frame Fp = reframe(F); ph_ssd_scan(Fp, args); } if (DUPN(10) > 1) { const Frame Fp = reframe(F); ph_ssd_scan(Fp, args, true); } _Pragma("unroll 1") for (int rp = 0; rp < DUPN(2); ++rp) { const Frame Fp = reframe(F); ph_seq_naive(Fp, args, opq(l), opq(rp)); __syncthreads(); }
            if (DUPN(17) > 1) { const Frame Fp = reframe(F); ph_seq_naive(Fp, args, opq(l), 2, 1); __syncthreads(); }
            if (DUPN(18) > 1) { const Frame Fp = reframe(F); ph_seq_naive(Fp, args, opq(l), 3, 2); __syncthreads(); } }
        PH_END;
        #if PROBE_CHECK
        if (PH_ON && l == 0) { const Frame Fp = reframe(F); chk_gdn2(Fp, 0, PROBE_HEAD); __syncthreads(); }
#endif
        if (PH_ON) { _Pragma("unroll 1") for (int r2 = 0; r2 < DUPN(11); ++r2) { Frame Fp = reframe(F); const int lp = opq(l);
                if (lp == 1) { if (Fp.vcu >= CONV_NY) Fp.vcu = 1 << 20; Fp.G = CONV_NY; }
                ph_ssd_y(Fp, args, lp); }
            if (opq(l) == 1) { const Frame Fp = reframe(F); if (Fp.vcu >= CONV_NY) ph_moe_conv(Fp, args, Fp.vcu - CONV_NY, Fp.G - CONV_NY); __syncthreads(); } _Pragma("unroll 1") for (int r2 = 0; r2 < DUPN(12); ++r2) { const Frame Fp = reframe(F); ph_post_naive(Fp, args, opq(l)); }
            if (opq(l) == 0) {
                { const Frame Fp = reframe(F); unsigned char* const ws = WSP(Fp); ph_scale_w(Fp, (const float*)(ws + WS_MOD), 1, (const bf16*)(ws + WS_FUP), 2 * DFF, (bf16*)(ws + WS_FUPS), (float*)(ws + WS_BIASF), true); }
                { const Frame Fp = reframe(F); unsigned char* const ws = WSP(Fp); ph_scale_w(Fp, (const float*)(ws + WS_MOD) + 12288, 0, (const bf16*)(ws + WS_WIN) + (size_t)D_INP * 1024, D_INP, (bf16*)(ws + WS_WINS), (float*)(ws + WS_BIASW), false); } } }
        PH_END;
        if (PH_ON) { _Pragma("unroll 1") for (int r2 = 0; r2 < ((l == 0) ? DUPN(15) : 1); ++r2) {
            PH_PTRS; const int lp = opq(l); const void* xsrc = (lp == 0) ? (const void*)P(Fp, 0) : (const void*)OUTP(Fp);
            pg8::Gemm g{O, (const bf16*)(ws + WS_WOUT) + (size_t)lp * 1024 * 1024, 1024, 1024}; pg8::StaticOrder S; S.init(T, 1024, Fp.G, (int)blockIdx.x);
            pg8::EpiResGate E{xsrc, (lp == 0) ? (bf16*)OUTP(Fp) : (bf16*)(ws + WS_H), mod + (size_t)lp * 12288 + 2048, 6144, SEQ, lp == 0, (lp == 0) ? (unsigned char*)(ws + WS_H) : (unsigned char*)nullptr, FP8_SA, (lp == 0) ? (float*)(ws + WS_PARTA) : (float*)nullptr, (PG8_LAS float*)(Fp.lds + RING_BYTES + 4096)};
            pg8::gemm_phase<pg8::EpiResGate, pg8::StaticOrder, true>(Fp.lds, Fp.tid, g, S, E);
        } }
        PH_END;
        if (l == 0) {
#if PROBE_CHECK
            if (PH_ON) { const Frame Fp = reframe(F); unsigned char* const ws = WSP(Fp);
                chk_rows(Fp, 1, 1, (const bf16*)(ws + WS_O), 1024, 1024, P(Fp, 20), nullptr, 1024, nullptr, 0, OUTP(Fp), P(Fp, 0), 1024, false, (const float*)(ws + WS_MOD) + 2048); }
#endif
#if PROBE_CHECK
            if (PH_ON) { const Frame Fp = reframe(F); if (Fp.vcu == 0) { float* sv = (float*)(WSP(Fp) + WS_DT); const float* o = OUTP(Fp); for (int i = 0; i < 8; ++i) for (int c = Fp.tid; c < 1024; c += NTHR) sv[i * 1024 + c] = o[(size_t)chk_row(i) * 1024 + c]; } }
#endif
            if (PH_ON && !(PROBE_SKIP & 2)) { _Pragma("unroll 1") for (int rp = 0; rp < DUPN(3); ++rp) {
                PH_PTRS;
                pg8::Gemm g{(const bf16*)(ws + WS_H), (const bf16*)(ws + WS_FUPS), 512, 512}; pg8::BatchOrder S; S.init(T, 2 * DFF, Fp.G, (int)blockIdx.x, 1, SEQ);
                pg8::EpiSwiglu E{U, DFF, 2 * DFF / 256, 0, 1.0f / (FP8_SA * FP8_SW), 1.0f, (const float*)(ws + WS_PARTA), (const float*)(ws + WS_BIASF), 2 * DFF, SEQ};
                pg8::gemm_phase<pg8::EpiSwiglu, pg8::BatchOrder, true, true>(Fp.lds, Fp.tid, g, S, E);
            } }
            PH_END;
#if PROBE_CHECK
            if (PH_ON) { const Frame Fp = reframe(F); unsigned char* const ws = WSP(Fp);
                chk_rows(Fp, 2, 2, (const bf16*)(ws + WS_H), 1024, 1024, P(Fp, 21), P(Fp, 22), DFF, (const bf16*)(ws + WS_U), DFF, nullptr, nullptr, 0, false, nullptr); }
#endif
            if (PH_ON && !(PROBE_SKIP & 2)) {
                PH_PTRS; float* const outp = OUTP(Fp);
                pg8::Gemm g{U, (const bf16*)(ws + WS_FDN), DFF, DFF}; pg8::StaticOrder S; S.init(T, 1024, Fp.G, (int)blockIdx.x);
                pg8::EpiResGate E{outp, (bf16*)outp, mod + (size_t)opq(l) * 12288 + 5120, 6144, SEQ, false, (unsigned char*)nullptr, 1.0f, (float*)(ws + WS_PARTB), (PG8_LAS float*)(Fp.lds + RING_BYTES + 4096)};
                pg8::gemm_phase<pg8::EpiResGate, pg8::StaticOrder, true>(Fp.lds, Fp.tid, g, S, E);
            }
            PH_END;
        } else {
            if (PH_ON) { const Frame Fp = reframe(F); ph_moe_route(Fp, args, opq(l)); }
            PH_END;
            for (int st = 0; st < 5; ++st) {
                if (PH_ON && st >= 1) {
                    PH_PTRS; moe_load_tstart(Fp, args);
                    const int chq = opq(st) - 1, R = (int)Fp.MISC[24], tile0 = chq * 64, ntile = (chq == 3) ? ((R - tile0) > 0 ? (R - tile0) : 0) : ((R - tile0) < 64 ? ((R - tile0) > 0 ? (R - tile0) : 0) : 64);
                    pg8::Gemm g{(const bf16*)(ws + WS_HID + (size_t)(chq & 1) * HID_STRIDE), (const bf16*)(ws + WS_MDN), DFFE / 2, DFFE / 2};
                    MoeOrder<false> S{ntile, 4, Fp.G, (int)blockIdx.x, tile0, Fp.MISC + 16, (const int*)(ws + WS_ROWTOK)};
                    pg8::EpiStoreBf16 E{(bf16*)(ws + WS_Y), 1024, 4, 0, 1.0f / (FP8_SA * FP8_SW), nullptr, nullptr, 0, SEQ};
                    pg8::gemm_phase<pg8::EpiStoreBf16, MoeOrder<false>, true, true>(Fp.lds, Fp.tid, g, S, E);
                }
                if (PH_ON && st <= 3) { _Pragma("unroll 1") for (int rp = 0; rp < DUPN(4); ++rp) {
                    PH_PTRS; moe_load_tstart(Fp, args);
                    const int chq = opq(st), R = (int)Fp.MISC[24], tile0 = chq * 64, ntile = (chq == 3) ? ((R - tile0) > 0 ? (R - tile0) : 0) : ((R - tile0) < 64 ? ((R - tile0) > 0 ? (R - tile0) : 0) : 64);
                    pg8::Gemm g{(const bf16*)(ws + WS_H8), (const bf16*)(ws + WS_MUP), 512, 512};
                    MoeOrder<true> S{ntile, 28, Fp.G, (int)blockIdx.x, tile0, Fp.MISC + 16, (const int*)(ws + WS_ROWTOK)};
                    pg8::EpiSwigluT<true, false> E{(bf16*)(ws + WS_HID + (size_t)(chq & 1) * HID_STRIDE), DFFE, 28, tile0, 1.0f / (FP8_SA * FP8_SW), FP8_SA, nullptr, nullptr, 0, SEQ};
                    pg8::gemm_phase<pg8::EpiSwigluT<true, false>, MoeOrder<true>, true, true>(Fp.lds, Fp.tid, g, S, E);
                } }
                PH_END;
            }
        }
    }
    if (DUPN(14) > 1 && !MK_MULTI) { _Pragma("unroll 1") for (int r2 = 0; r2 < 32; ++r2) xcd_barrier(bar); }
    if (PH_ON) { const Frame Fp = reframe(F); ph_final(Fp, args); }
#if PROBE_CHECK
    if (PH_ON) { const Frame Fp = reframe(F); moe_load_tstart(Fp, args); chk_moe(Fp); }
#endif
    PH_END;
#if PROBE_CHECK
    if (PH_ON) { const Frame Fp = reframe(F); ph_probe_scale(Fp); }
    PH_END;
#endif
#undef PH_ON
#undef PH_END
}

extern "C" void kernel_launch(void* const* d_in, const int* in_sizes, int n_in, void* d_out, int out_size, void* d_ws, size_t ws_size, hipStream_t stream) {
    static int grid = 0;
    if (grid == 0) {
        if (n_in != 29 || out_size != T * DM || ws_size < WS_END) { fprintf(stderr, "kernel_launch: unexpected shapes/workspace (n_in %d out %d ws %zu need %zu)\n", n_in, out_size, ws_size, (size_t)WS_END); grid = -1; return; }
        int dev = 0, cus = 0, per_cu = 0;
        if (hipGetDevice(&dev) != hipSuccess || hipDeviceGetAttribute(&cus, hipDeviceAttributeMultiprocessorCount, dev) != hipSuccess) { grid = -1; return; }
        if (hipFuncSetAttribute((const void*)mega_fwd, hipFuncAttributeMaxDynamicSharedMemorySize, LDS_BYTES) != hipSuccess) { fprintf(stderr, "kernel_launch: hipFuncSetAttribute failed\n"); grid = -1; return; }
        if (hipOccupancyMaxActiveBlocksPerMultiprocessor(&per_cu, (const void*)mega_fwd, NTHR, LDS_BYTES) != hipSuccess || per_cu < 1) { fprintf(stderr, "kernel_launch: occupancy query says %d\n", per_cu); }
        (void)hipGetLastError();
        grid = cus;
    }
    if (grid < 0) return;
    if (hipMemsetAsync((char*)d_ws + WS_CTL, 0, CTL_ZERO_BYTES, stream) != hipSuccess) return;
    Args a{};
    for (int i = 0; i < 29; ++i) a.in[i] = (const float*)d_in[i];
    a.out = (float*)d_out; a.ws = (unsigned char*)d_ws;
#if MK_MULTI
    for (int p = 0; p < N_PHASES; ++p) { a.ph_lo = p; a.ph_hi = p + 1; hipLaunchKernelGGL(mega_fwd, dim3(grid), dim3(NTHR), LDS_BYTES, stream, a); }
#else
    a.ph_lo = 0; a.ph_hi = 1 << 30;
    hipLaunchKernelGGL(mega_fwd, dim3(grid), dim3(NTHR), LDS_BYTES, stream, a);
#endif
}
```
